# Optimizing an MI355X kernel written in HIP

```python
import jax, jax.numpy as jnp
from jax import lax
import numpy as np


D_MODEL = 2048
BATCH = 2
SEQ = 8192
DEPTH = 4
DEC_BATCH = 32
DEC_SEQ = 64
PAST_LEN = 1024

CHUNK = 64
HEAD_DIM = 128
BRANCH_WIDTH = D_MODEL // 2
N_BRANCH = 3
D_RNN = BRANCH_WIDTH
LRU_BLOCKS = 8
LRU_BLOCK = D_RNN // LRU_BLOCKS
CONV_W = 4
LRU_C = 8.0
SWA_HEADS = BRANCH_WIDTH // HEAD_DIM
SWA_KV_HEADS = 2
SWA_GROUP = SWA_HEADS // SWA_KV_HEADS
SWA_WINDOW = 128
SWA_PREV = SWA_WINDOW // CHUNK
CB_HEADS = BRANCH_WIDTH // HEAD_DIM
CB_PREV = 8
CB_REACH = CB_PREV * CHUNK
REL_CLIP = 128
D_FF = 4 * D_MODEL
EPS = 1e-6
NEG = -1e30
ATTN_SCALE = HEAD_DIM ** -0.5
IN_SPLITS = (D_RNN, D_RNN,
             SWA_HEADS * HEAD_DIM, SWA_KV_HEADS * HEAD_DIM, SWA_KV_HEADS * HEAD_DIM,
             CB_HEADS * HEAD_DIM, CB_HEADS * HEAD_DIM, CB_HEADS * HEAD_DIM,
             N_BRANCH * D_MODEL)
D_IN = sum(IN_SPLITS)

kernel_name = "hybrid_streaming_encoder_step"


def rms_norm(x, g):
    xf = x.astype(jnp.float32)
    y = xf * lax.rsqrt(jnp.mean(xf * xf, axis=-1, keepdims=True) + EPS)
    return (y * g.astype(jnp.float32)).astype(x.dtype)


def split_cols(z):
    outs, start = [], 0
    for w in IN_SPLITS:
        outs.append(z[..., start:start + w])
        start += w
    return outs


def causal_conv(u, buf, w, b):
    t = u.shape[1]
    up = jnp.concatenate([buf.astype(u.dtype), u], axis=1)
    y = b + up[:, 0:t] * w[0]
    for k in range(1, CONV_W):
        y = y + up[:, k:k + t] * w[k]
    return y, up[:, up.shape[1] - (CONV_W - 1):]


def rg_lru(u, h0, wa, ba, wx, bx, lam):
    bsz, t, _ = u.shape
    uf = u.astype(jnp.float32)
    ub = uf.reshape(bsz, t, LRU_BLOCKS, LRU_BLOCK)
    r = jax.nn.sigmoid(jnp.einsum('btnc,ncd->btnd', ub, wa.astype(jnp.float32)).reshape(bsz, t, D_RNN) + ba.astype(jnp.float32))
    i = jax.nn.sigmoid(jnp.einsum('btnc,ncd->btnd', ub, wx.astype(jnp.float32)).reshape(bsz, t, D_RNN) + bx.astype(jnp.float32))
    log_a = -LRU_C * r * jax.nn.softplus(-lam.astype(jnp.float32))
    a = jnp.exp(log_a)
    b = jnp.sqrt(-jnp.expm1(2.0 * log_a)) * (i * uf)
    b = b.at[:, 0].add(a[:, 0] * h0.astype(jnp.float32))

    def combine(e1, e2):
        a1, b1 = e1
        a2, b2 = e2
        return a1 * a2, a2 * b1 + b2

    _, h = lax.associative_scan(combine, (a, b), axis=1)
    return h, h[:, -1]


def band_chunks(xc, n_prev):
    bsz, nc = xc.shape[:2]
    pad = jnp.zeros((bsz, n_prev) + xc.shape[2:], xc.dtype)
    xp = jnp.concatenate([pad, xc], axis=1)
    band = jnp.stack([xp[:, o:o + nc] for o in range(n_prev + 1)], axis=2)
    return band.reshape((bsz, nc, (n_prev + 1) * xc.shape[2]) + xc.shape[3:])


def band_valid(nc, n_prev):
    j = jnp.arange((n_prev + 1) * CHUNK)
    return (jnp.arange(nc)[:, None] - n_prev + j[None, :] // CHUNK) >= 0


def softmax_with_sink(s, sink):
    m = jnp.maximum(jnp.max(s, axis=-1, keepdims=True), sink)
    e = jnp.exp(s - m)
    return e / (jnp.sum(e, axis=-1, keepdims=True) + jnp.exp(sink - m))


def rel_bias(table, n_q, n_k, offset):
    d = offset + jnp.arange(n_q)[:, None] - jnp.arange(n_k)[None, :]
    idx = jnp.clip(d, -REL_CLIP, REL_CLIP) + REL_CLIP
    return table.astype(jnp.float32)[:, idx]


def swa_prompt(q, k, v, sinks):
    bsz, s_len = q.shape[:2]
    nc = s_len // CHUNK
    qc = q.reshape(bsz, nc, CHUNK, SWA_KV_HEADS, SWA_GROUP, HEAD_DIM)
    kb = band_chunks(k.reshape(bsz, nc, CHUNK, SWA_KV_HEADS, HEAD_DIM), SWA_PREV)
    vb = band_chunks(v.reshape(bsz, nc, CHUNK, SWA_KV_HEADS, HEAD_DIM), SWA_PREV)
    s = jnp.einsum('bnikgd,bnjkd->bnkgij', qc, kb, preferred_element_type=jnp.float32) * ATTN_SCALE
    s = jnp.where(band_valid(nc, SWA_PREV)[None, :, None, None, None, :], s, NEG)
    p = softmax_with_sink(s, sinks.astype(jnp.float32).reshape(SWA_KV_HEADS, SWA_GROUP, 1, 1))
    o = jnp.einsum('bnkgij,bnjkd->bnikgd', p.astype(v.dtype), vb)
    return o.reshape(bsz, s_len, SWA_HEADS * HEAD_DIM)


def swa_step(q, k, v, sinks):
    bsz, t = q.shape[:2]
    s = jnp.einsum('bikgd,bjkd->bkgij', q, k, preferred_element_type=jnp.float32) * ATTN_SCALE
    p = softmax_with_sink(s, sinks.astype(jnp.float32).reshape(SWA_KV_HEADS, SWA_GROUP, 1, 1))
    o = jnp.einsum('bkgij,bjkd->bikgd', p.astype(v.dtype), v)
    return o.reshape(bsz, t, SWA_HEADS * HEAD_DIM)


def chunk_prompt(q, k, v, table):
    bsz, s_len = q.shape[:2]
    nc = s_len // CHUNK
    qc = q.reshape(bsz, nc, CHUNK, CB_HEADS, HEAD_DIM)
    kb = band_chunks(k.reshape(bsz, nc, CHUNK, CB_HEADS, HEAD_DIM), CB_PREV)
    vb = band_chunks(v.reshape(bsz, nc, CHUNK, CB_HEADS, HEAD_DIM), CB_PREV)
    n_k = (CB_PREV + 1) * CHUNK
    s = jnp.einsum('bnihd,bnjhd->bnhij', qc, kb, preferred_element_type=jnp.float32) * ATTN_SCALE
    s = s + rel_bias(table, CHUNK, n_k, CB_REACH)[None, None]
    s = jnp.where(band_valid(nc, CB_PREV)[None, :, None, None, :], s, NEG)
    p = jax.nn.softmax(s, axis=-1)
    o = jnp.einsum('bnhij,bnjhd->bnihd', p.astype(v.dtype), vb)
    return o.reshape(bsz, s_len, CB_HEADS * HEAD_DIM)


def chunk_step(q, k, v, table, n_past):
    bsz, t = q.shape[:2]
    s = jnp.einsum('bihd,bjhd->bhij', q, k, preferred_element_type=jnp.float32) * ATTN_SCALE
    s = s + rel_bias(table, t, k.shape[1], n_past)[None]
    p = jax.nn.softmax(s, axis=-1)
    o = jnp.einsum('bhij,bjhd->bihd', p.astype(v.dtype), v)
    return o.reshape(bsz, t, CB_HEADS * HEAD_DIM)


def trunk_layer(x, conv_buf, h0, caches, norm1, w_in, conv_w, conv_b, wa, ba, wx, bx, lam,
                sinks, table, w_branch, w_out, norm2, w_up, w_down):
    bsz, t, _ = x.shape
    xn = rms_norm(x, norm1)
    z = xn @ w_in
    a_x, a_gate, qb, kb, vb, qc, kc, vc, gates = split_cols(z)
    u, new_buf = causal_conv(a_x, conv_buf, conv_w, conv_b)
    h, h_last = rg_lru(u, h0, wa, ba, wx, bx, lam)
    out_a = h.astype(x.dtype) * jax.nn.gelu(a_gate)
    qb = qb.reshape(bsz, t, SWA_KV_HEADS, SWA_GROUP, HEAD_DIM)
    kb = kb.reshape(bsz, t, SWA_KV_HEADS, HEAD_DIM)
    vb = vb.reshape(bsz, t, SWA_KV_HEADS, HEAD_DIM)
    qc = qc.reshape(bsz, t, CB_HEADS, HEAD_DIM)
    kc = kc.reshape(bsz, t, CB_HEADS, HEAD_DIM)
    vc = vc.reshape(bsz, t, CB_HEADS, HEAD_DIM)
    if caches is None:
        out_b = swa_prompt(qb, kb, vb, sinks)
        out_c = chunk_prompt(qc, kc, vc, table)
        new_kv = (kb[:, -SWA_WINDOW:], vb[:, -SWA_WINDOW:], kc[:, -CB_REACH:], vc[:, -CB_REACH:])
    else:
        ck_b, cv_b, ck_c, cv_c = caches
        out_b = swa_step(qb, jnp.concatenate([ck_b.astype(kb.dtype), kb], axis=1),
                         jnp.concatenate([cv_b.astype(vb.dtype), vb], axis=1), sinks)
        out_c = chunk_step(qc, jnp.concatenate([ck_c.astype(kc.dtype), kc], axis=1),
                           jnp.concatenate([cv_c.astype(vc.dtype), vc], axis=1), table, ck_c.shape[1])
        new_kv = (kb, vb, kc, vc)
    branches = jnp.stack([out_a, out_b, out_c], axis=2)
    proj = jnp.einsum('btrw,rwd->btrd', branches, w_branch)
    g = jax.nn.sigmoid(gates.reshape(bsz, t, N_BRANCH, D_MODEL))
    mixed = jnp.einsum('btrd,btrd->btd', g, proj)
    x = x + mixed @ w_out
    hn = rms_norm(x, norm2)
    x = x + jnp.square(jax.nn.relu(hn @ w_up)) @ w_down
    return x, (new_buf, h_last.astype(x.dtype)) + new_kv


def setup_inputs(seed: int = 0) -> dict:
    key = jax.random.key(seed)
    ks = jax.random.split(key, 32)
    f32 = jnp.float32

    def nrm(k, shape, s):
        return jax.random.normal(k, shape, f32) * s

    p_swa = min(SWA_WINDOW, PAST_LEN)
    p_cb = min(CB_REACH, PAST_LEN)
    u = jax.random.uniform(ks[16], (DEPTH, D_RNN), f32, 0.9, 0.999)
    sa = u ** (1.0 / LRU_C)
    lam = jnp.log(sa) - jnp.log1p(-sa)
    return {
        'x_prompt': nrm(ks[0], (BATCH, SEQ, D_MODEL), 1.0),
        'x_sample': nrm(ks[1], (DEC_BATCH, DEC_SEQ, D_MODEL), 1.0),
        'state_conv': nrm(ks[2], (DEPTH, DEC_BATCH, CONV_W - 1, D_RNN), 1.0),
        'state_lru': nrm(ks[3], (DEPTH, DEC_BATCH, D_RNN), 0.5),
        'cache_swa_k': nrm(ks[4], (DEPTH, DEC_BATCH, p_swa, SWA_KV_HEADS, HEAD_DIM), 1.0),
        'cache_swa_v': nrm(ks[5], (DEPTH, DEC_BATCH, p_swa, SWA_KV_HEADS, HEAD_DIM), 1.0),
        'cache_cb_k': nrm(ks[6], (DEPTH, DEC_BATCH, p_cb, CB_HEADS, HEAD_DIM), 1.0),
        'cache_cb_v': nrm(ks[7], (DEPTH, DEC_BATCH, p_cb, CB_HEADS, HEAD_DIM), 1.0),
        'norm1_g': 1.0 + nrm(ks[8], (DEPTH, D_MODEL), 0.05),
        'w_in': nrm(ks[9], (DEPTH, D_MODEL, D_IN), D_MODEL ** -0.5),
        'conv_w': nrm(ks[10], (DEPTH, CONV_W, D_RNN), CONV_W ** -0.5),
        'conv_b': nrm(ks[11], (DEPTH, D_RNN), 0.01),
        'lru_wa': nrm(ks[12], (DEPTH, LRU_BLOCKS, LRU_BLOCK, LRU_BLOCK), LRU_BLOCK ** -0.5),
        'lru_ba': nrm(ks[13], (DEPTH, D_RNN), 0.01),
        'lru_wx': nrm(ks[14], (DEPTH, LRU_BLOCKS, LRU_BLOCK, LRU_BLOCK), LRU_BLOCK ** -0.5),
        'lru_bx': nrm(ks[15], (DEPTH, D_RNN), 0.01),
        'lru_lambda': lam,
        'attn_sinks': nrm(ks[17], (DEPTH, SWA_HEADS), 1.0),
        'rel_bias_table': nrm(ks[18], (DEPTH, CB_HEADS, 2 * REL_CLIP + 1), 0.5),
        'w_branch': nrm(ks[19], (DEPTH, N_BRANCH, BRANCH_WIDTH, D_MODEL), BRANCH_WIDTH ** -0.5),
        'w_out': nrm(ks[20], (DEPTH, D_MODEL, D_MODEL), D_MODEL ** -0.5),
        'norm2_g': 1.0 + nrm(ks[21], (DEPTH, D_MODEL), 0.05),
        'w_up': nrm(ks[22], (DEPTH, D_MODEL, D_FF), D_MODEL ** -0.5),
        'w_down': nrm(ks[23], (DEPTH, D_FF, D_MODEL), D_FF ** -0.5),
        'final_g': 1.0 + nrm(ks[24], (D_MODEL,), 0.05),
    }


def reference(x_prompt, x_sample, state_conv, state_lru, cache_swa_k, cache_swa_v, cache_cb_k,
              cache_cb_v, norm1_g, w_in, conv_w, conv_b, lru_wa, lru_ba, lru_wx, lru_bx,
              lru_lambda, attn_sinks, rel_bias_table, w_branch, w_out, norm2_g, w_up, w_down,
              final_g):
    yp, ys = x_prompt, x_sample
    p_conv, p_lru, p_swa_k, p_swa_v, p_cb_k, p_cb_v = [], [], [], [], [], []
    s_conv, s_lru, s_swa_k, s_swa_v, s_cb_k, s_cb_v = [], [], [], [], [], []
    nb = yp.shape[0]
    for l in range(DEPTH):
        lw = (norm1_g[l], w_in[l], conv_w[l], conv_b[l], lru_wa[l], lru_ba[l], lru_wx[l],
              lru_bx[l], lru_lambda[l], attn_sinks[l], rel_bias_table[l], w_branch[l], w_out[l],
              norm2_g[l], w_up[l], w_down[l])
        yp, st_p = trunk_layer(yp, jnp.zeros((nb, CONV_W - 1, D_RNN), yp.dtype),
                               jnp.zeros((nb, D_RNN), jnp.float32), None, *lw)
        ys, st_s = trunk_layer(ys, state_conv[l], state_lru[l],
                               (cache_swa_k[l], cache_swa_v[l], cache_cb_k[l], cache_cb_v[l]), *lw)
        p_conv.append(st_p[0]); p_lru.append(st_p[1]); p_swa_k.append(st_p[2])
        p_swa_v.append(st_p[3]); p_cb_k.append(st_p[4]); p_cb_v.append(st_p[5])
        s_conv.append(st_s[0]); s_lru.append(st_s[1]); s_swa_k.append(st_s[2])
        s_swa_v.append(st_s[3]); s_cb_k.append(st_s[4]); s_cb_v.append(st_s[5])
    y_prompt = rms_norm(yp, final_g)
    y_sample = rms_norm(ys, final_g)
    return (y_prompt, y_sample,
            jnp.stack(p_conv), jnp.stack(p_lru), jnp.stack(p_swa_k), jnp.stack(p_swa_v),
            jnp.stack(p_cb_k), jnp.stack(p_cb_v),
            jnp.stack(s_conv), jnp.stack(s_lru), jnp.stack(s_swa_k), jnp.stack(s_swa_v),
            jnp.stack(s_cb_k), jnp.stack(s_cb_v))
```

```cpp
#include <hip/hip_runtime.h>
#include <cstdio>
#include <cstdint>

#define LAS __attribute__((address_space(3)))
typedef unsigned short bf16_t;
typedef short bf16x8 __attribute__((ext_vector_type(8)));
typedef float f32x2 __attribute__((ext_vector_type(2)));
typedef float f32x4 __attribute__((ext_vector_type(4)));
typedef float f32x16 __attribute__((ext_vector_type(16)));
typedef unsigned u32x2 __attribute__((ext_vector_type(2)));
typedef unsigned u32x4 __attribute__((ext_vector_type(4)));
typedef __bf16 bf16v2 __attribute__((ext_vector_type(2)));
#define DI __device__ __forceinline__

constexpr int MP = 16384, MS = 2048, M = MP + MS, DM = 2048, DIN = 12800, DFF = 8192, BW = 1024, DEPTH = 4, NCHUNK = M / 64;
constexpr int ZLD = 6656;
constexpr int C_AX = 0, C_AG = 1024, C_QB = 2048, C_KB = 3072, C_VB = 3328, C_QC = 3584, C_KC = 4608, C_VC = 5632, C_G = 6656;
constexpr int NWAVES = 8, NTHR = 512;
constexpr float EPS = 1e-6f, LOG2E = 1.4426950408889634f;
constexpr size_t O_YP = 0, O_YS = O_YP + (size_t)MP * DM, O_PCONV = O_YS + (size_t)MS * DM, O_PLRU = O_PCONV + 4 * 2 * 3 * 1024, O_PSWAK = O_PLRU + 4 * 2 * 1024,
                 O_PSWAV = O_PSWAK + 4 * 2 * 128 * 256, O_PCBK = O_PSWAV + 4 * 2 * 128 * 256, O_PCBV = O_PCBK + (size_t)4 * 2 * 512 * 1024, O_SCONV = O_PCBV + (size_t)4 * 2 * 512 * 1024,
                 O_SLRU = O_SCONV + 4 * 32 * 3 * 1024, O_SSWAK = O_SLRU + 4 * 32 * 1024, O_SSWAV = O_SSWAK + (size_t)4 * 32 * 64 * 256, O_SCBK = O_SSWAV + (size_t)4 * 32 * 64 * 256,
                 O_SCBV = O_SCBK + (size_t)4 * 32 * 64 * 1024, O_END = O_SCBV + (size_t)4 * 32 * 64 * 1024;
constexpr size_t WL_IN = 0, WL_BR = WL_IN + (size_t)DIN * DM, WL_OUT = WL_BR + (size_t)3 * DM * BW, WL_UP = WL_OUT + (size_t)DM * DM, WL_DOWN = WL_UP + (size_t)DFF * DM, WL_SIZE = WL_DOWN + (size_t)DM * DFF;
constexpr size_t al256(size_t x) { return (x + 255) & ~(size_t)255; }
constexpr size_t WS_BAR = 0, WS_RS = 16384, WS_AGG = al256(WS_RS + (size_t)M * 4), WS_LRUW = al256(WS_AGG + (size_t)NCHUNK * 1024 * 2 * 4),
                 WS_W = al256(WS_LRUW + (size_t)DEPTH * 2 * 8 * 128 * 128 * 2), WS_ACT = al256(WS_W + (size_t)DEPTH * WL_SIZE * 2), WS_Z = al256(WS_ACT + (size_t)M * DM * 2),
                 WS_KCB = al256(WS_Z + (size_t)M * DFF * 2),
                 WS_VTCB = al256(WS_KCB + (size_t)32 * 128 * 256 * 2), WS_KCC = al256(WS_VTCB + (size_t)32 * 2 * 2 * 8192 * 2), WS_VTCC = al256(WS_KCC + (size_t)32 * 512 * 1024 * 2),
                 WS_R1 = al256(WS_VTCC + (size_t)32 * 8 * 8 * 8192 * 2), WS_BR = al256(WS_R1 + (size_t)2 * M * 1024 * 4), WS_SSQ = al256(WS_BR + (size_t)M * 3 * BW * 2),
                 WS_PART = al256(WS_SSQ + (size_t)MP * 32 * 4), WS_ACT2 = al256(WS_PART + (size_t)4 * MS * DM * 4), WS_GATE = al256(WS_ACT2 + (size_t)M * DM * 2), WS_END = al256(WS_GATE + (size_t)M * 3 * DM * 2);
constexpr int LDS_STAGE = 131072, LDS_MISC = LDS_STAGE, LDS_TBL = LDS_STAGE + 256, LDS_BYTES = LDS_STAGE + 256 + 8 * 260 * 4 + 64;


template <int OFF> DI unsigned long long karg64() { auto ka = __builtin_amdgcn_kernarg_segment_ptr(); unsigned long long p;
    asm volatile("s_load_dwordx2 %0, %1, %2\n\ts_waitcnt lgkmcnt(0)" : "=s"(p) : "s"(ka), "n"(OFF)); return p; }
template <int I> DI const float* kin() { return (const float*)karg64<I * 8>(); }
DI float* kout() { return (float*)karg64<200>(); }
DI unsigned char* kws() { return (unsigned char*)karg64<208>(); }
DI int launder_tid() { int t = threadIdx.x; asm volatile("" : "+v"(t)); return t; }
DI float bf2f(unsigned short b) { return __uint_as_float(((unsigned)b) << 16); }
DI float bflo(unsigned w) { return __uint_as_float(w << 16); }
DI float bfhi(unsigned w) { return __uint_as_float(w & 0xffff0000u); }
DI unsigned pk2(float a, float b) { f32x2 v = {a, b}; bf16v2 r = __builtin_convertvector(v, bf16v2); return __builtin_bit_cast(unsigned, r); }
DI float wave_sum(float v) {
#pragma unroll
    for (int o = 1; o < 64; o <<= 1) v += __shfl_xor(v, o);
    return v;
}
DI float sigmoidf_(float x) { return 1.0f / (1.0f + __expf(-x)); }
DI float gelu_tanh(float x) { const float u = 0.7978845608028654f * (x + 0.044715f * x * x * x); const float e = __expf(-2.0f * u); return x * (1.0f / (1.0f + e)); }

#define XB_TMO      128
#define XB_XCNT(j)  (256  + 64 * (j))
#define XB_XSUB(j)  (1280 + 64 * (j))
#define XB_XGEN(j)  (2304 + 64 * (j))
#define XB_TOP      3328
#define XB_TOPGEN   3392
#define XCD_BAR_WORDS 3456
#define XB_SPIN_CAP (1u << 20)
DI unsigned xb_ld(unsigned* p)              { return __hip_atomic_load(p, __ATOMIC_RELAXED, __HIP_MEMORY_SCOPE_AGENT); }
DI unsigned xb_add(unsigned* p, unsigned v) { return __hip_atomic_fetch_add(p, v, __ATOMIC_RELAXED, __HIP_MEMORY_SCOPE_AGENT); }
DI unsigned xb_xcc_id() { return (unsigned)__builtin_amdgcn_s_getreg((3 << 11) | 20) & 0xFu; }
#define XB_SPIN(cond, bar) do { unsigned _sp = 0; while (cond) { __builtin_amdgcn_s_sleep(1); \
    if ((++_sp & 255u) == 0u) { if (xb_ld(&(bar)[XB_TMO])) break; if (_sp > XB_SPIN_CAP) { atomicAdd(&(bar)[XB_TMO], 1u); break; } } } } while (0)
struct XcdBarrier { unsigned* bar; unsigned x; volatile LAS unsigned* st; };
DI XcdBarrier xcd_barrier_post(unsigned* bar, volatile LAS unsigned* st) {
    XcdBarrier b; b.bar = bar; b.x = xb_xcc_id(); b.st = st;
    if (threadIdx.x == 0) (void)xb_add(&bar[XB_XCNT(b.x)], 1u);
    return b;
}
DI void xcd_barrier_complete(unsigned* bar, unsigned x, unsigned& nloc, unsigned& nx) {
    const unsigned G = gridDim.x * gridDim.y * gridDim.z;
    unsigned sum, cnt, mine, sp = 0u;
    for (;;) {
        sum = 0u; cnt = 0u; mine = 0u;
#pragma unroll
        for (unsigned j = 0; j < 16; ++j) { const unsigned c = xb_ld(&bar[XB_XCNT(j)]); sum += c; cnt += (c > 0u) ? 1u : 0u; mine = (j == x) ? c : mine; }
        if (sum == G) break;
        __builtin_amdgcn_s_sleep(1);
        if ((++sp & 255u) == 0u) { if (xb_ld(&bar[XB_TMO])) break; if (sp > XB_SPIN_CAP) { atomicAdd(&bar[XB_TMO], 1u); break; } }
    }
    nloc = mine > 0u ? mine : 1u; nx = cnt > 0u ? cnt : 1u;
}
DI void xcd_barrier(const XcdBarrier& b) {
    asm volatile("s_waitcnt vmcnt(0)" ::: "memory");
    __syncthreads();
    if (threadIdx.x == 0) {
        unsigned* bar = b.bar;
        __builtin_amdgcn_s_waitcnt(0);
        unsigned nloc = b.st[0], nx = b.st[1];
        if (nloc == 0u) { xcd_barrier_complete(bar, b.x, nloc, nx); b.st[0] = nloc; b.st[1] = nx; }
        const unsigned old = xb_add(&bar[XB_XSUB(b.x)], 1u);
        const unsigned gen = old / nloc;
        if (old + 1u == (gen + 1u) * nloc) {
            __builtin_amdgcn_fence(__ATOMIC_RELEASE, "agent");
            asm volatile("s_waitcnt vmcnt(0)" ::: "memory");
            const unsigned og = xb_add(&bar[XB_TOP], 1u);
            const unsigned tg = og / nx;
            if (og + 1u == (tg + 1u) * nx) xb_add(&bar[XB_TOPGEN], 1u);
            else XB_SPIN(xb_ld(&bar[XB_TOPGEN]) == tg, bar);
            __builtin_amdgcn_fence(__ATOMIC_ACQUIRE, "agent");
            xb_add(&bar[XB_XGEN(b.x)], 1u);
            asm volatile("s_waitcnt vmcnt(0)" ::: "memory");
        } else {
            XB_SPIN(xb_ld(&bar[XB_XGEN(b.x)]) == gen, bar);
            __builtin_amdgcn_fence(__ATOMIC_ACQUIRE, "agent");
            asm volatile("s_waitcnt vmcnt(0)" ::: "memory");
        }
    }
    __syncthreads();
}

namespace pg8 {
constexpr int BM = 256, BK = 64, HALF = 128, HTB = HALF * BK * 2, STAGE_BYTES = 8 * HTB, NXCD = 8;
#ifndef WGM_FULL
#define WGM_FULL 8
#endif
#ifndef WGM_INPROJ
#define WGM_INPROJ 8
#endif
#ifndef WGM_SPLIT
#define WGM_SPLIT 4
#endif
DI int lds_byte(int r, int c) { const int st = (r >> 4) * 2 + (c >> 5), rr = r & 15, cc = c & 31, ob = rr * 64 + cc * 2; return st * 1024 + (ob ^ (((ob >> 9) & 1) << 5)); }
DI void stage_rc(int b, int& R, int& C) { const int st = b / 1024, sb = b % 1024, swz = sb ^ (((sb >> 9) & 1) << 5); R = (st >> 1) * 16 + swz / 64; C = (st & 1) * 32 + (swz % 64) / 2; }
DI int perm32(int rho) { const int n = rho >> 4, i = rho & 15; return 8 * (i >> 2) + 4 * n + (i & 3); }
struct Unit { int pm, pn, ks, nt; const char* a; const char* b; };
struct Geo { const bf16_t* A; const bf16_t* Bt; int lda, ldb; };
template <int WGM> DI void xcd_tile(int L, int nM, int nN, int& pm, int& pn) {
    const int nwg = nM * nN; int wgid = L; { const int q = nwg / NXCD, r = nwg % NXCD, xcd = wgid % NXCD, off = wgid / NXCD; wgid = (xcd < r ? xcd * (q + 1) : r * (q + 1) + (xcd - r) * q) + off; }
    const int nig = WGM * nN, gid = wgid / nig, fm = gid * WGM, gsz = (nM - fm) < WGM ? (nM - fm) : WGM;
    pm = fm + ((wgid % nig) % gsz); pn = (wgid % nig) / gsz;
}
struct FullOrder {
    Geo g; int nM, nN, G, c, nt;
    DI bool next(int i, Unit& u) const {
        const long L = (long)i * G + c; if (L >= (long)nM * nN) return false;
        xcd_tile<WGM_FULL>((int)L, nM, nN, u.pm, u.pn); u.ks = -1; u.nt = nt;
        u.a = (const char*)g.A + (size_t)u.pm * BM * g.lda * 2; u.b = (const char*)g.Bt + (size_t)u.pn * BM * g.ldb * 2; return true;
    }
};
struct InprojOrder {
    Geo g; int G, c;
    DI bool next(int i, Unit& u) const {
        const long L = (long)i * G + c;
        if (L < 3584) {
            if (L < 3550) xcd_tile<WGM_INPROJ>((int)L, 71, 50, u.pm, u.pn); else { const int idx = (int)L - 3550; u.pm = 71; u.pn = idx < 26 ? idx : idx + 16; }
            u.ks = -1; u.nt = DM / BK; u.a = (const char*)g.A + (size_t)u.pm * BM * g.lda * 2; u.b = (const char*)g.Bt + (size_t)u.pn * BM * g.ldb * 2; return true; }
        const long j = L - 3584; if (j >= 128) return false;
        u.pm = 71; u.pn = 26 + ((int)j & 15); u.ks = (int)(j >> 4); u.nt = 4;
        u.a = (const char*)g.A + ((size_t)u.pm * BM * g.lda + (size_t)u.ks * 256) * 2; u.b = (const char*)g.Bt + ((size_t)u.pn * BM * g.ldb + (size_t)u.ks * 256) * 2; return true;
    }
};
struct SplitOrder {
    Geo g; int G, c, ntFull, S, ntSplit;
    DI bool next(int i, Unit& u) const {
        const long L = (long)i * G + c;
        if (L < 512) { xcd_tile<WGM_SPLIT>((int)L, 64, 8, u.pm, u.pn); u.ks = -1; u.nt = ntFull;
            u.a = (const char*)g.A + (size_t)u.pm * BM * g.lda * 2; u.b = (const char*)g.Bt + (size_t)u.pn * BM * g.ldb * 2; return true; }
        const long j = L - 512; if (j >= 64 * S) return false;
        const int xq = (int)j & 7, sq = (int)j >> 3, combo = xq * S + (sq >> 3); u.pn = sq & 7; u.pm = 64 + (combo & 7); u.ks = combo >> 3; u.nt = ntSplit;
        u.a = (const char*)g.A + ((size_t)u.pm * BM * g.lda + (size_t)u.ks * ntSplit * BK) * 2; u.b = (const char*)g.Bt + ((size_t)u.pn * BM * g.ldb + (size_t)u.ks * ntSplit * BK) * 2; return true;
    }
};
template <class Epi, class Sched>
DI void gemm_phase(LAS unsigned char* lds, const Sched& S, const Epi& E) {
    const int tid = launder_tid(), wid = __builtin_amdgcn_readfirstlane(tid >> 6), lane = tid & 63, wr = wid >> 2, wc = wid & 3, fr = lane & 15, fq = lane >> 4;
    const int lda = S.g.lda, ldb = S.g.ldb;
    unsigned voffA[2], voffB[2];
#pragma unroll
    for (int i = 0; i < 2; ++i) { int R, C; stage_rc(tid * 16 + i * 8192, R, C); const int Rb = (R & ~31) + perm32(R & 31);
        voffA[i] = (unsigned)(R * lda + C) * 2u; voffB[i] = (unsigned)(Rb * ldb + C) * 2u; }
    const size_t kstep = (size_t)(BK * 2);
    const size_t hstepA = (size_t)HALF * lda * 2, hstepB = (size_t)HALF * ldb * 2;
    const unsigned ldsw = (unsigned)wid * 1024u;
    const int aoff = lds_byte(wr * 64 + fr, fq * 8), boff = lds_byte(wc * 32 + fr, fq * 8);
#define PG8_SA(b, h) (((b) * 2 + (h)) * HTB)
#define PG8_SB(b, h) ((4 + (b) * 2 + (h)) * HTB)
#define PG8_STAGE(bufoff, gbase, voff) do { _Pragma("unroll") for (int _i = 0; _i < 2; ++_i) \
        __builtin_amdgcn_global_load_lds((const unsigned*)((const char*)(gbase) + (voff)[_i]), (LAS unsigned*)(lds + (bufoff) + ldsw + _i * 8192), 16, 0, 0); } while (0)
#define PG8_LDA(dst, b, h) do { _Pragma("unroll") for (int m = 0; m < 4; ++m) _Pragma("unroll") for (int k = 0; k < 2; ++k) dst[m][k] = *(const LAS bf16x8*)(lds + PG8_SA(b, h) + aoff + m * 2048 + k * 1024); } while (0)
#define PG8_LDB(dst, b, h) do { _Pragma("unroll") for (int n = 0; n < 2; ++n) _Pragma("unroll") for (int k = 0; k < 2; ++k) dst[n][k] = *(const LAS bf16x8*)(lds + PG8_SB(b, h) + boff + n * 2048 + k * 1024); } while (0)
#define PG8_MMA(ai, bj, At, Bt) do { __builtin_amdgcn_s_setprio(1); _Pragma("unroll") for (int m = 0; m < 4; ++m) _Pragma("unroll") for (int n = 0; n < 2; ++n) _Pragma("unroll") for (int k = 0; k < 2; ++k) \
        acc[ai][bj][m][n] = __builtin_amdgcn_mfma_f32_16x16x32_bf16(Bt[n][k], At[m][k], acc[ai][bj][m][n], 0, 0, 0); __builtin_amdgcn_s_setprio(0); } while (0)
#define PG8_WAIT_V(n) asm volatile("s_waitcnt vmcnt(" #n ")" ::: "memory")
#define PG8_WAIT_L(n) asm volatile("s_waitcnt lgkmcnt(" #n ")" ::: "memory")
#define PG8_BAR __builtin_amdgcn_s_barrier()
#define PG8_SCHED __builtin_amdgcn_sched_barrier(0)
    Unit cur, nxt; int ui = 0;
    if (!S.next(0, cur)) return;
    f32x4 acc[2][2][4][2];
#pragma unroll
    for (int a = 0; a < 2; ++a)
#pragma unroll
        for (int b = 0; b < 2; ++b)
#pragma unroll
            for (int m = 0; m < 4; ++m)
#pragma unroll
                for (int n = 0; n < 2; ++n) acc[a][b][m][n] = (f32x4){0.f, 0.f, 0.f, 0.f};
    bf16x8 At[4][2], B0[2][2], B1[2][2];
    const char* cA = cur.a; const char* cB = cur.b;
#define PG8_RSDMA(unit_, par_) do { if constexpr (Epi::RSLDS) { if (wid < 4) __builtin_amdgcn_global_load_lds((const unsigned*)(E.rs + (unit_).pm * BM + wid * 64 + lane), \
        (LAS unsigned*)(lds + LDS_TBL + (par_) * 1024 + wid * 256), 4, 0, 0); } } while (0)
    PG8_RSDMA(cur, 0);
    PG8_STAGE(PG8_SB(0, 0), cB, voffB); PG8_STAGE(PG8_SB(0, 1), cB + hstepB, voffB); PG8_STAGE(PG8_SA(0, 0), cA, voffA); PG8_STAGE(PG8_SA(0, 1), cA + hstepA, voffA);
    if (wr == 1) PG8_BAR;
    PG8_WAIT_V(2); PG8_BAR;
    PG8_STAGE(PG8_SB(1, 0), cB + kstep, voffB); PG8_STAGE(PG8_SA(1, 0), cA + kstep, voffA); PG8_STAGE(PG8_SB(1, 1), cB + hstepB + kstep, voffB);
    PG8_WAIT_V(6); PG8_BAR;
    for (;;) {
        const bool has_next = S.next(ui + 1, nxt);
        const char* nA = has_next ? nxt.a : cA; const char* nB = has_next ? nxt.b : cB;
        const int nt = cur.nt;
        for (int t = 0; t < nt; t += 2) {
            const bool last = (t == nt - 2);
            const char* a1 = cA + (size_t)(t + 1) * kstep;
            const char* a2 = last ? nA : cA + (size_t)(t + 2) * kstep; const char* b2 = last ? nB : cB + (size_t)(t + 2) * kstep;
            const char* a3 = a2 + kstep; const char* b3 = b2 + kstep;
            if constexpr (Epi::HOOK) { if (cur.ks < 0 && (t == 16 || t == 32)) E.hook(acc, cur, t >> 4, wr, wc, fr, fq); }
            const int relax = __builtin_amdgcn_readfirstlane((t == 0 && ui > 0) ? 1 : 0);
#define PG8_WAIT_V8R() asm volatile("s_cmp_eq_u32 %0, 0\n\ts_cbranch_scc1 .Lrx%=\n\ts_waitcnt vmcnt(24)\n\ts_branch .Lry%=\n.Lrx%=:\n\ts_waitcnt vmcnt(8)\n.Lry%=:" :: "s"(relax) : "memory", "scc")
            PG8_LDB(B0, 0, 0); PG8_LDB(B1, 0, 1); PG8_SCHED; PG8_LDA(At, 0, 0); PG8_STAGE(PG8_SA(1, 1), a1 + hstepA, voffA);
            PG8_WAIT_V8R(); PG8_WAIT_L(0); PG8_BAR; PG8_MMA(0, 0, At, B0); PG8_MMA(0, 1, At, B1); PG8_BAR; PG8_SCHED;
            PG8_LDA(At, 0, 1); PG8_STAGE(PG8_SB(0, 0), b2, voffB); PG8_STAGE(PG8_SB(0, 1), b2 + hstepB, voffB); PG8_STAGE(PG8_SA(0, 0), a2, voffA);
            PG8_WAIT_V8R(); PG8_WAIT_L(0); PG8_BAR; PG8_MMA(1, 0, At, B0); PG8_MMA(1, 1, At, B1); PG8_BAR; PG8_SCHED;
            PG8_LDB(B0, 1, 0); PG8_LDB(B1, 1, 1); PG8_SCHED; PG8_LDA(At, 1, 0); PG8_STAGE(PG8_SA(0, 1), a2 + hstepA, voffA);
            PG8_WAIT_V(8); PG8_WAIT_L(0); PG8_BAR; PG8_MMA(0, 0, At, B0); PG8_MMA(0, 1, At, B1); PG8_BAR; PG8_SCHED;
            PG8_LDA(At, 1, 1); PG8_STAGE(PG8_SB(1, 0), b3, voffB); PG8_STAGE(PG8_SB(1, 1), b3 + hstepB, voffB); PG8_STAGE(PG8_SA(1, 0), a3, voffA);
            PG8_WAIT_V(8); PG8_WAIT_L(0); PG8_BAR; PG8_MMA(1, 0, At, B0); PG8_MMA(1, 1, At, B1); PG8_BAR; PG8_SCHED;
        }
        if (wr == 0) PG8_BAR;
        E(acc, cur, wr, wc, fr, fq, (const LAS float*)(lds + LDS_TBL + (ui & 1) * 1024));
        if (!has_next) break;
#pragma unroll
        for (int a = 0; a < 2; ++a)
#pragma unroll
            for (int b = 0; b < 2; ++b)
#pragma unroll
                for (int m = 0; m < 4; ++m)
#pragma unroll
                    for (int n = 0; n < 2; ++n) acc[a][b][m][n] = (f32x4){0.f, 0.f, 0.f, 0.f};
        cur = nxt; cA = nA; cB = nB; ++ui;
        PG8_RSDMA(cur, ui & 1);
        if (wr == 1) PG8_BAR;
    }
    PG8_WAIT_V(0);
    PG8_BAR;
#undef PG8_RSDMA
#undef PG8_WAIT_V8R
#undef PG8_SA
#undef PG8_SB
#undef PG8_STAGE
#undef PG8_LDA
#undef PG8_LDB
#undef PG8_MMA
#undef PG8_WAIT_V
#undef PG8_WAIT_L
#undef PG8_BAR
#undef PG8_SCHED
}

DI unsigned q8(float s) { const float t = fminf(fmaxf(s * 255.0f + 0.5f, 1.0f), 255.0f); return (unsigned)(int)t; }
DI unsigned pk4q8(const f32x4 v) {
    unsigned w = 0u;
    w = __builtin_amdgcn_cvt_pk_u8_f32(fmaxf(__builtin_rintf(v[0] * 255.0f), 1.0f), 0, w); w = __builtin_amdgcn_cvt_pk_u8_f32(fmaxf(__builtin_rintf(v[1] * 255.0f), 1.0f), 1, w);
    w = __builtin_amdgcn_cvt_pk_u8_f32(fmaxf(__builtin_rintf(v[2] * 255.0f), 1.0f), 2, w); w = __builtin_amdgcn_cvt_pk_u8_f32(fmaxf(__builtin_rintf(v[3] * 255.0f), 1.0f), 3, w);
    return w;
}
DI u32x2 packq8(const f32x4 v0, const f32x4 v1) { u32x2 w; w.x = pk4q8(v0); w.y = pk4q8(v1); return w; }
DI void unpackq8(const u32x2 w, f32x4& v0, f32x4& v1) {
    v0 = (f32x4){(float)(w.x & 0xffu), (float)((w.x >> 8) & 0xffu), (float)((w.x >> 16) & 0xffu), (float)(w.x >> 24)};
    v1 = (f32x4){(float)(w.y & 0xffu), (float)((w.y >> 8) & 0xffu), (float)((w.y >> 16) & 0xffu), (float)(w.y >> 24)}; }
DI u32x4 pack8(const f32x4 v0, const f32x4 v1) { u32x4 w; w.x = pk2(v0[0], v0[1]); w.y = pk2(v0[2], v0[3]); w.z = pk2(v1[0], v1[1]); w.w = pk2(v1[2], v1[3]); return w; }
DI void unpack8(const u32x4 w, f32x4& v0, f32x4& v1) { v0 = (f32x4){bflo(w.x), bfhi(w.x), bflo(w.y), bfhi(w.y)}; v1 = (f32x4){bflo(w.z), bfhi(w.z), bflo(w.w), bfhi(w.w)}; }
struct EpiInproj {
    static constexpr bool HOOK = false, RSLDS = true;
    bf16_t* Z; const float* rs; float* part; unsigned char* GT;
    DI void operator()(const f32x4 (&acc)[2][2][4][2], const Unit& u, int wr, int wc, int fr, int fq, const LAS float* rsl) const {
        const int row0 = u.pm * BM + wr * 64 + fr, col0 = u.pn * BM + wc * 32 + 8 * fq;
        const bool gate = u.pn >= C_G / BM;
#pragma unroll
        for (int ai = 0; ai < 2; ++ai)
#pragma unroll
            for (int m = 0; m < 4; ++m) {
                const int row = row0 + ai * HALF + m * 16;
                if (u.ks < 0) {
                    const float s = rsl[wr * 64 + fr + ai * HALF + m * 16];
                    bf16_t* rowp = Z + (size_t)row * ZLD + col0;
                    unsigned char* gq = GT + (((size_t)u.pm * 24 + (u.pn - 26)) * 256 + (row & 255)) * 256 + wc * 32 + 8 * fq;
#pragma unroll
                    for (int bj = 0; bj < 2; ++bj) {
                        f32x4 v0 = acc[ai][bj][m][0] * s, v1 = acc[ai][bj][m][1] * s;
                        if (gate) {
#pragma unroll
                            for (int j = 0; j < 4; ++j) { v0[j] = __builtin_amdgcn_rcpf(1.0f + __expf(-v0[j])); v1[j] = __builtin_amdgcn_rcpf(1.0f + __expf(-v1[j])); }
                            *(u32x2*)(gq + bj * HALF) = packq8(v0, v1);
                        } else *(u32x4*)(rowp + bj * HALF) = pack8(v0, v1);
                    }
                } else {
                    float* pp = part + (((size_t)u.ks * 16 + (u.pn - 26)) * 256 + (row - 71 * BM)) * 256 + wc * 32 + 8 * fq;
#pragma unroll
                    for (int bj = 0; bj < 2; ++bj) { *(f32x4*)(pp + bj * HALF) = acc[ai][bj][m][0]; *(f32x4*)(pp + bj * HALF + 4) = acc[ai][bj][m][1]; }
                }
            }
    }
};
struct EpiUp {
    static constexpr bool HOOK = false, RSLDS = true;
    bf16_t* H; const float* rs;
    DI void operator()(const f32x4 (&acc)[2][2][4][2], const Unit& u, int wr, int wc, int fr, int fq, const LAS float* rsl) const {
        const int row0 = u.pm * BM + wr * 64 + fr, col0 = u.pn * BM + wc * 32 + 8 * fq;
#pragma unroll
        for (int ai = 0; ai < 2; ++ai)
#pragma unroll
            for (int m = 0; m < 4; ++m) {
                const int row = row0 + ai * HALF + m * 16; const float s = rsl[wr * 64 + fr + ai * HALF + m * 16];
                bf16_t* rowp = H + (size_t)row * DFF + col0;
#pragma unroll
                for (int bj = 0; bj < 2; ++bj) {
                    f32x4 v0 = acc[ai][bj][m][0] * s, v1 = acc[ai][bj][m][1] * s;
#pragma unroll
                    for (int j = 0; j < 4; ++j) { v0[j] = fmaxf(v0[j], 0.f); v0[j] *= v0[j]; v1[j] = fmaxf(v1[j], 0.f); v1[j] *= v1[j]; }
                    *(u32x4*)(rowp + bj * HALF) = pack8(v0, v1);
                }
            }
    }
};
struct EpiD {
    static constexpr bool HOOK = true, RSLDS = false;
    const unsigned char* Z; bf16_t* act; float* part;
    DI void hook(f32x4 (&acc)[2][2][4][2], const Unit& u, int r, int wr, int wc, int fr_, int fq_) const {
        int fr = fr_, fq = fq_; asm volatile("" : "+v"(fr), "+v"(fq));
        const int row0 = u.pm * BM + wr * 64 + fr, col0 = u.pn * BM + wc * 32 + 8 * fq;
#pragma unroll
        for (int ai = 0; ai < 2; ++ai) {
#pragma unroll
            for (int m = 0; m < 4; ++m) {
                const unsigned char* gp = Z + (((size_t)u.pm * 24 + (r - 1) * 8 + u.pn) * 256 + (wr * 64 + fr + ai * HALF + m * 16)) * 256 + wc * 32 + 8 * fq;
#pragma unroll
                for (int bj = 0; bj < 2; ++bj) {
                    f32x4 n0, n1, d0, d1; unpackq8(*(const u32x2*)(gp + bj * HALF), n0, n1); unpackq8(*(const u32x2*)(gp + 8 * 65536 + bj * HALF), d0, d1);
#pragma unroll
                    for (int j = 0; j < 4; ++j) { acc[ai][bj][m][0][j] *= n0[j] * __builtin_amdgcn_rcpf(d0[j]); acc[ai][bj][m][1][j] *= n1[j] * __builtin_amdgcn_rcpf(d1[j]); }
                }
            }
            asm volatile("" : "+v"(acc[ai][0][0][0]), "+v"(acc[ai][0][1][0]), "+v"(acc[ai][0][2][0]), "+v"(acc[ai][0][3][0]), "+v"(acc[ai][1][0][0]), "+v"(acc[ai][1][1][0]), "+v"(acc[ai][1][2][0]), "+v"(acc[ai][1][3][0]));
        }
    }
    DI void operator()(const f32x4 (&acc)[2][2][4][2], const Unit& u, int wr, int wc, int fr, int fq, const LAS float* rsl) const {
        const int row0 = u.pm * BM + wr * 64 + fr, col0 = u.pn * BM + wc * 32 + 8 * fq;
        const int r = u.ks < 0 ? 2 : u.ks;
#pragma unroll
        for (int ai = 0; ai < 2; ++ai)
#pragma unroll
            for (int m = 0; m < 4; ++m) {
                const int row = row0 + ai * HALF + m * 16;
                const unsigned char* gp = Z + (((size_t)u.pm * 24 + r * 8 + u.pn) * 256 + (row & 255)) * 256 + wc * 32 + 8 * fq;
#pragma unroll
                for (int bj = 0; bj < 2; ++bj) {
                    f32x4 s0, s1; unpackq8(*(const u32x2*)(gp + bj * HALF), s0, s1);
                    const f32x4 v0 = acc[ai][bj][m][0] * (s0 * (1.0f / 255.0f)), v1 = acc[ai][bj][m][1] * (s1 * (1.0f / 255.0f));
                    if (u.ks < 0) *(u32x4*)(act + (size_t)row * DM + col0 + bj * HALF) = pack8(v0, v1);
                    else { float* pp = part + ((size_t)u.ks * MS + (row - MP)) * DM + col0 + bj * HALF; *(f32x4*)pp = v0; *(f32x4*)(pp + 4) = v1; }
                }
            }
    }
};
template <bool XF32> struct EpiRes {
    static constexpr bool HOOK = false, RSLDS = false;
    const float* Xin; bf16_t* act; float* ssq; float* part;
    DI void operator()(const f32x4 (&acc)[2][2][4][2], const Unit& u, int wr, int wc, int fr, int fq, const LAS float* rsl) const {
        const int row0 = u.pm * BM + wr * 64 + fr, col0 = u.pn * BM + wc * 32 + 8 * fq;
        u32x4 xin[2][4][2];
        if (!XF32 && u.ks < 0) {
#pragma unroll
            for (int ai = 0; ai < 2; ++ai)
#pragma unroll
                for (int m = 0; m < 4; ++m)
#pragma unroll
                    for (int bj = 0; bj < 2; ++bj) xin[ai][m][bj] = *(const u32x4*)(act + (size_t)(row0 + ai * HALF + m * 16) * DM + col0 + bj * HALF);
        }
#pragma unroll
        for (int ai = 0; ai < 2; ++ai)
#pragma unroll
            for (int m = 0; m < 4; ++m) {
                const int row = row0 + ai * HALF + m * 16;
                if (u.ks < 0) {
                    const size_t off = (size_t)row * DM + col0; float sq = 0.f;
#pragma unroll
                    for (int bj = 0; bj < 2; ++bj) {
                        f32x4 x0, x1;
                        if (XF32) { x0 = *(const f32x4*)(Xin + off + bj * HALF); x1 = *(const f32x4*)(Xin + off + bj * HALF + 4); }
                        else unpack8(xin[ai][m][bj], x0, x1);
                        x0 += acc[ai][bj][m][0]; x1 += acc[ai][bj][m][1];
                        *(u32x4*)(act + off + bj * HALF) = pack8(x0, x1);
                        sq += (x0[0] * x0[0] + x0[1] * x0[1]) + (x0[2] * x0[2] + x0[3] * x0[3]) + (x1[0] * x1[0] + x1[1] * x1[1]) + (x1[2] * x1[2] + x1[3] * x1[3]);
                    }
                    sq += __shfl_xor(sq, 16); sq += __shfl_xor(sq, 32);
                    if (fq == 0) ssq[(size_t)row * 32 + u.pn * 4 + wc] = sq;
                } else {
#pragma unroll
                    for (int bj = 0; bj < 2; ++bj) { float* pp = part + ((size_t)u.ks * MS + (row - MP)) * DM + col0 + bj * HALF; *(f32x4*)pp = acc[ai][bj][m][0]; *(f32x4*)(pp + 4) = acc[ai][bj][m][1]; }
                }
            }
    }
};
}

DI void tr_item(const float* src, size_t sld, bf16_t* dst, size_t dld, const float* ksc, LAS unsigned* scr, int lane) {
    const int ng = lane & 15, kq = lane >> 4;
#pragma unroll
    for (int i = 0; i < 8; ++i) {
        const int k = 8 * i + 2 * kq;
        f32x4 a = *(const f32x4*)(src + (size_t)k * sld + 4 * ng);
        f32x4 b = *(const f32x4*)(src + (size_t)(k + 1) * sld + 4 * ng);
        if (ksc) { a *= ksc[k]; b *= ksc[k + 1]; }
        LAS unsigned* d = scr + (4 * ng) * 33 + 4 * i + kq;
        d[0] = pk2(a[0], b[0]); d[33] = pk2(a[1], b[1]); d[66] = pk2(a[2], b[2]); d[99] = pk2(a[3], b[3]);
    }
    asm volatile("s_waitcnt lgkmcnt(0)" ::: "memory");
#pragma unroll
    for (int j = 0; j < 8; ++j) {
        const int n = (lane >> 3) + 8 * j, c = lane & 7;
        const LAS unsigned* s = scr + n * 33 + 4 * c;
        u32x4 o; o.x = s[0]; o.y = s[1]; o.z = s[2]; o.w = s[3];
        *(u32x4*)(dst + (size_t)n * dld + 8 * c) = o;
    }
    asm volatile("s_waitcnt lgkmcnt(0)" ::: "memory");
}

struct Ctx {
    LAS unsigned char* lds;
    int tid, lane, wave, bid, G;
};
DI Ctx make_ctx(LAS unsigned char* lds) { Ctx c; c.lds = lds; c.tid = launder_tid(); c.lane = c.tid & 63; c.wave = __builtin_amdgcn_readfirstlane(c.tid >> 6); c.bid = blockIdx.x; c.G = gridDim.x; return c; }

DI void conv_matrix_item(const float* W, int K, int N, bf16_t* Wt, const float* ksc, int item, LAS unsigned* scr, int lane) {
    const int nb = N >> 6, kb = item / nb, nn = item - kb * nb;
    tr_item(W + (size_t)kb * 64 * N + nn * 64, (size_t)N, Wt + (size_t)nn * 64 * K + kb * 64, (size_t)K, ksc ? ksc + kb * 64 : nullptr, scr, lane);
}
DI void phase_prologue(const Ctx& c) {
    LAS unsigned* scr = (LAS unsigned*)(c.lds + c.wave * 16384);
    const int gw = c.bid * NWAVES + c.wave, NGW = c.G * NWAVES;
    constexpr int I_IN = 32 * 200, I_BR = 16 * 32, I_OUT = 32 * 32, I_UP = 32 * 128, I_DN = 128 * 32, I_LRU = 4, I_L = I_IN + 3 * I_BR + I_OUT + I_UP + I_DN + 16 * I_LRU;
    bf16_t* Wall = (bf16_t*)(kws() + WS_W); bf16_t* lruw = (bf16_t*)(kws() + WS_LRUW);
    for (int it = gw; it < DEPTH * I_L; it += NGW) {
        const int l = it / I_L; int r = it - l * I_L;
        bf16_t* Wl = Wall + (size_t)l * WL_SIZE;
        if (r < I_IN) { conv_matrix_item(kin<9>() + (size_t)l * DM * DIN, DM, DIN, Wl + WL_IN, kin<8>() + l * DM, r, scr, c.lane); continue; } r -= I_IN;
        if (r < 3 * I_BR) { const int b = r / I_BR, it2 = r - b * I_BR, kb = it2 / (DM / 64), nn = it2 - kb * (DM / 64);
            tr_item(kin<19>() + ((size_t)l * 3 + b) * BW * DM + (size_t)kb * 64 * DM + nn * 64, (size_t)DM, Wl + WL_BR + (size_t)nn * 64 * (3 * BW) + b * BW + kb * 64, (size_t)(3 * BW), nullptr, scr, c.lane); continue; } r -= 3 * I_BR;
        if (r < I_OUT) { conv_matrix_item(kin<20>() + (size_t)l * DM * DM, DM, DM, Wl + WL_OUT, nullptr, r, scr, c.lane); continue; } r -= I_OUT;
        if (r < I_UP) { conv_matrix_item(kin<22>() + (size_t)l * DM * DFF, DM, DFF, Wl + WL_UP, kin<21>() + l * DM, r, scr, c.lane); continue; } r -= I_UP;
        if (r < I_DN) { conv_matrix_item(kin<23>() + (size_t)l * DFF * DM, DFF, DM, Wl + WL_DOWN, nullptr, r, scr, c.lane); continue; } r -= I_DN;
        { const int wsel = r / (8 * I_LRU), rr = r - wsel * 8 * I_LRU, blk = rr / I_LRU, sub = rr - blk * I_LRU;
          conv_matrix_item((wsel ? kin<14>() : kin<12>()) + ((size_t)l * 8 + blk) * 16384, 128, 128, lruw + (((size_t)l * 2 + wsel) * 8 + blk) * 16384, nullptr, sub, scr, c.lane); }
    }
}

DI void phase_norm(const Ctx& c, const float* xP, const float* xS) {
    const int gw = c.bid * NWAVES + c.wave, NGW = c.G * NWAVES;
    bf16_t* act = (bf16_t*)(kws() + WS_ACT); float* rs = (float*)(kws() + WS_RS);
    for (int row = gw; row < M; row += NGW) {
        const f32x4* xr = (const f32x4*)((row < MP ? xP : xS) + (size_t)row * DM) + c.lane;
        f32x4 v[8]; float s = 0.f;
#pragma unroll
        for (int j = 0; j < 8; ++j) { v[j] = xr[64 * j]; s += (v[j][0] * v[j][0] + v[j][1] * v[j][1]) + (v[j][2] * v[j][2] + v[j][3] * v[j][3]); }
        s = wave_sum(s);
        if (c.lane == 0) rs[row] = 1.0f / sqrtf(s * (1.0f / DM) + EPS);
        u32x2* o = (u32x2*)(act + (size_t)row * DM) + c.lane;
#pragma unroll
        for (int j = 0; j < 8; ++j) { u32x2 w; w.x = pk2(v[j][0], v[j][1]); w.y = pk2(v[j][2], v[j][3]); o[64 * j] = w; }
    }
}
DI void phase_final(const Ctx& c) {
    const int gw = c.bid * NWAVES + c.wave, NGW = c.G * NWAVES;
    const f32x4* gp = (const f32x4*)kin<24>() + c.lane; const float* rs = (const float*)(kws() + WS_RS); const bf16_t* act = (const bf16_t*)(kws() + WS_ACT);
    f32x4 gv[8];
#pragma unroll
    for (int j = 0; j < 8; ++j) gv[j] = gp[64 * j];
    for (int row = gw; row < M; row += NGW) {
        f32x4* yr = (f32x4*)(kout() + (size_t)row * DM) + c.lane; const u32x2* xr = (const u32x2*)(act + (size_t)row * DM) + c.lane; const float r = rs[row];
#pragma unroll
        for (int j = 0; j < 8; ++j) { const u32x2 w = xr[64 * j]; yr[64 * j] = (f32x4){bflo(w.x), bfhi(w.x), bflo(w.y), bfhi(w.y)} * r * gv[j]; }
    }
}
DI void cvt_f32_bf16(const float* s, bf16_t* d, size_t n8, size_t gt, size_t NT) {
    for (size_t i = gt; i < n8; i += NT) { const f32x4 a = ((const f32x4*)s)[2 * i], b = ((const f32x4*)s)[2 * i + 1]; u32x4 w; w.x = pk2(a[0], a[1]); w.y = pk2(a[2], a[3]); w.z = pk2(b[0], b[1]); w.w = pk2(b[2], b[3]); ((u32x4*)d)[i] = w; }
}
DI void phase_cacheconv(const Ctx& c, int l, int pidx, int pcount) {
    const size_t gt = (size_t)pidx * NTHR + c.tid, NT = (size_t)pcount * NTHR;
    cvt_f32_bf16(kin<4>() + (size_t)l * 32 * 128 * 256, (bf16_t*)(kws() + WS_KCB), (size_t)32 * 128 * 256 / 8, gt, NT);
    cvt_f32_bf16(kin<5>() + (size_t)l * 32 * 128 * 256, (bf16_t*)(kws() + WS_VTCB), (size_t)32 * 128 * 256 / 8, gt, NT);
    cvt_f32_bf16(kin<6>() + (size_t)l * 32 * 512 * 1024, (bf16_t*)(kws() + WS_KCC), (size_t)32 * 512 * 1024 / 8, gt, NT);
    cvt_f32_bf16(kin<7>() + (size_t)l * 32 * 512 * 1024, (bf16_t*)(kws() + WS_VTCC), (size_t)32 * 512 * 1024 / 8, gt, NT);
}

DI void lru_local_phase(const Ctx& c, int l) {
    LAS float* uf = (LAS float*)c.lds;
    LAS unsigned char* ub = c.lds + 33792;
    LAS float* sa = (LAS float*)(c.lds + 33792 + 17408);
    LAS float* sb = sa + 8192;
    LAS float* tot = sb + 8192;
    const bf16_t* Z = (const bf16_t*)(kws() + WS_Z);
    const int nunits = NCHUNK * 8;
    int u = c.bid; if (u >= nunits) return;
    const int cg = c.tid & 15, tk = c.tid >> 4;
    const int fr = c.lane & 15, fq = c.lane >> 4, w = c.wave;
    const int chl = c.tid & 127, q = c.tid >> 7;
    int nblk_cur = -1;
    LAS float* cwl = tot + 1024;
    bf16x8 bwa[4], bwx[4]; float ba = 0.f, bx = 0.f, c8 = 0.f;
    u32x4 pre[2][4];
#define LRU_PREFETCH(uu) do { const int chunk_ = (uu) >> 3, nb_ = (uu) & 7; const bool smp_ = chunk_ >= 256, first_ = !smp_ && (chunk_ & 127) == 0; \
        _Pragma("unroll") for (int hh = 0; hh < 2; ++hh) _Pragma("unroll") for (int k = 0; k < 4; ++k) { const int ts = tk + 32 * hh - 3 + k; \
            if (ts >= 0 || (!smp_ && !first_)) pre[hh][k] = *(const u32x4*)(Z + (size_t)(chunk_ * 64 + ts) * ZLD + C_AX + nb_ * 128 + 8 * cg); } } while (0)
    LRU_PREFETCH(u);
    for (; u < nunits; u += c.G) {
        const int chunk = u >> 3, nblk = u & 7;
        const int row0 = chunk * 64, ch0 = nblk * 128; const bool smp = chunk >= 256; const bool first = !smp && (chunk & 127) == 0; const int bs = chunk - 256;
        if (nblk != nblk_cur) {
            nblk_cur = nblk;
            __syncthreads();
            for (int i = c.tid; i < 640; i += NTHR) { const int k = i >> 7, cc = i & 127; cwl[i] = k < 4 ? kin<10>()[(size_t)l * 4 * 1024 + k * 1024 + ch0 + cc] : kin<11>()[(size_t)l * 1024 + ch0 + cc]; }
            __syncthreads();
            const bf16_t* wat = (const bf16_t*)(kws() + WS_LRUW) + (((size_t)l * 2 + 0) * 8 + nblk) * 16384 + (size_t)(16 * w + fr) * 128 + 8 * fq;
            const bf16_t* wxt = wat + (size_t)8 * 16384;
#pragma unroll
            for (int ks = 0; ks < 4; ++ks) { bwa[ks] = *(const bf16x8*)(wat + 32 * ks); bwx[ks] = *(const bf16x8*)(wxt + 32 * ks); }
            const int ch = ch0 + 16 * w + fr;
            ba = kin<13>()[(size_t)l * 1024 + ch]; bx = kin<15>()[(size_t)l * 1024 + ch]; c8 = 8.0f * log1pf(expf(-kin<16>()[(size_t)l * 1024 + ch]));
        }
#pragma unroll
        for (int hh = 0; hh < 2; ++hh) {
            const int tt = tk + 32 * hh;
            f32x4 a0 = *(const LAS f32x4*)(cwl + 512 + 8 * cg), a1 = *(const LAS f32x4*)(cwl + 512 + 8 * cg + 4);
#pragma unroll
            for (int k = 0; k < 4; ++k) {
                const int ts = tt - 3 + k;
                f32x4 x0, x1;
                if (ts >= 0 || (!smp && !first)) { const u32x4 v = pre[hh][k];
                    x0 = (f32x4){bflo(v.x), bfhi(v.x), bflo(v.y), bfhi(v.y)}; x1 = (f32x4){bflo(v.z), bfhi(v.z), bflo(v.w), bfhi(v.w)};
                } else if (smp) {
                    const float* sp = kin<2>() + (((size_t)l * 32 + bs) * 3 + (3 + ts)) * 1024 + ch0 + 8 * cg;
                    x0 = *(const f32x4*)sp; x1 = *(const f32x4*)(sp + 4);
                } else { x0 = (f32x4){0.f, 0.f, 0.f, 0.f}; x1 = x0; }
                a0 += *(const LAS f32x4*)(cwl + k * 128 + 8 * cg) * x0; a1 += *(const LAS f32x4*)(cwl + k * 128 + 8 * cg + 4) * x1;
            }
            *(LAS f32x4*)(uf + tt * 132 + 8 * cg) = a0; *(LAS f32x4*)(uf + tt * 132 + 8 * cg + 4) = a1;
            u32x4 pw; pw.x = pk2(a0[0], a0[1]); pw.y = pk2(a0[2], a0[3]); pw.z = pk2(a1[0], a1[1]); pw.w = pk2(a1[2], a1[3]);
            *(LAS u32x4*)(ub + tt * 272 + 16 * cg) = pw;
        }
        if (u + c.G < nunits) LRU_PREFETCH(u + c.G);
        __syncthreads();
        {
            f32x4 ar[4], ai[4];
#pragma unroll
            for (int mt = 0; mt < 4; ++mt) { ar[mt] = (f32x4){0.f, 0.f, 0.f, 0.f}; ai[mt] = ar[mt]; }
#pragma unroll
            for (int ks = 0; ks < 4; ++ks)
#pragma unroll
                for (int mt = 0; mt < 4; ++mt) {
                    const bf16x8 af = *(const LAS bf16x8*)(ub + (mt * 16 + fr) * 272 + (ks * 32 + fq * 8) * 2);
                    ar[mt] = __builtin_amdgcn_mfma_f32_16x16x32_bf16(af, bwa[ks], ar[mt], 0, 0, 0);
                    ai[mt] = __builtin_amdgcn_mfma_f32_16x16x32_bf16(af, bwx[ks], ai[mt], 0, 0, 0);
                }
            const int chw = 16 * w + fr;
#pragma unroll
            for (int mt = 0; mt < 4; ++mt)
#pragma unroll
                for (int j = 0; j < 4; ++j) {
                    const int tok = mt * 16 + fq * 4 + j;
                    const float r = __builtin_amdgcn_rcpf(1.0f + __expf(-(ar[mt][j] + ba))), ig = __builtin_amdgcn_rcpf(1.0f + __expf(-(ai[mt][j] + bx)));
                    const float la = -c8 * r, a = __expf(la), x2 = 2.0f * la;
                    const float omt = -x2 * (1.0f + x2 * (0.5f + x2 * (0.16666667f + x2 * (0.041666668f + x2 * (0.0083333338f + x2 * 0.0013888889f)))));
                    const float om = x2 > -0.25f ? omt : 1.0f - a * a;
                    const float bb = __builtin_amdgcn_sqrtf(om) * (ig * uf[tok * 132 + chw]);
                    sa[tok * 128 + chw] = a; sb[tok * 128 + chw] = bb;
                }
        }
        __syncthreads();
        {
            float h = (smp && q == 0) ? kin<3>()[((size_t)l * 32 + bs) * 1024 + ch0 + chl] : 0.f, A = 1.f;
#pragma unroll 4
            for (int t = 16 * q; t < 16 * q + 16; ++t) { const float a = sa[t * 128 + chl], b = sb[t * 128 + chl]; h = a * h + b; A *= a; sb[t * 128 + chl] = h; sa[t * 128 + chl] = A; }
            tot[(q * 128 + chl) * 2] = A; tot[(q * 128 + chl) * 2 + 1] = h;
        }
        __syncthreads();
        {
            float cin = 0.f, Apre = 1.f;
            for (int qq = 0; qq < q; ++qq) { const float A = tot[(qq * 128 + chl) * 2], h = tot[(qq * 128 + chl) * 2 + 1]; cin = A * cin + h; Apre *= A; }
            unsigned* hc = (unsigned*)(kws() + WS_R1) + (size_t)row0 * 1024 + ch0 + chl;
            float h = 0.f, A = 1.f;
#pragma unroll 4
            for (int t = 16 * q; t < 16 * q + 16; ++t) { h = sb[t * 128 + chl] + sa[t * 128 + chl] * cin; A = sa[t * 128 + chl] * Apre; hc[(size_t)t * 1024] = pk2(h, A); }
            if (q == 3) { f32x2 ag = {A, h}; *(f32x2*)((float*)(kws() + WS_AGG) + ((size_t)chunk * 1024 + ch0 + chl) * 2) = ag; }
        }
        __syncthreads();
    }
#undef LRU_PREFETCH
}

DI void lru_fix_unit(const Ctx& c, int l, int chunk, int half) {
    const int cg4 = c.tid & 127, tq = c.tid >> 7, ch = half * 512 + 4 * cg4; const bool smp = chunk >= 256; const int n = smp ? 0 : (chunk & 127);
    f32x4 cr = {0.f, 0.f, 0.f, 0.f};
    const f32x4* ag = (const f32x4*)((const float*)(kws() + WS_AGG) + ((size_t)(chunk - n) * 1024 + ch) * 2);
    int i = 0;
    for (; i + 8 <= n; i += 8) {
        f32x4 a[8][2];
#pragma unroll
        for (int j = 0; j < 8; ++j) { a[j][0] = ag[(size_t)(i + j) * 512]; a[j][1] = ag[(size_t)(i + j) * 512 + 1]; }
#pragma unroll
        for (int j = 0; j < 8; ++j) { cr[0] = a[j][0][0] * cr[0] + a[j][0][1]; cr[1] = a[j][0][2] * cr[1] + a[j][0][3]; cr[2] = a[j][1][0] * cr[2] + a[j][1][1]; cr[3] = a[j][1][2] * cr[3] + a[j][1][3]; }
    }
    for (; i < n; ++i) { const f32x4 a0 = ag[(size_t)i * 512], a1 = ag[(size_t)i * 512 + 1]; cr[0] = a0[0] * cr[0] + a0[1]; cr[1] = a0[2] * cr[1] + a0[3]; cr[2] = a1[0] * cr[2] + a1[1]; cr[3] = a1[2] * cr[3] + a1[3]; }
    const unsigned* hc = (const unsigned*)(kws() + WS_R1) + (size_t)(chunk * 64 + tq) * 1024 + ch;
    const bf16_t* zg = (const bf16_t*)(kws() + WS_Z) + (size_t)(chunk * 64 + tq) * ZLD + C_AG + ch;
    bf16_t* br = (bf16_t*)(kws() + WS_BR) + (size_t)(chunk * 64 + tq) * 3072 + ch;
    u32x4 hv[16]; u32x2 gv[16];
#pragma unroll
    for (int k = 0; k < 16; ++k) { hv[k] = *(const u32x4*)(hc + (size_t)(4 * k) * 1024); gv[k] = *(const u32x2*)(zg + (size_t)(4 * k) * ZLD); }
    f32x4 h = {0.f, 0.f, 0.f, 0.f};
#pragma unroll
    for (int k = 0; k < 16; ++k) {
        h[0] = bflo(hv[k].x) + bfhi(hv[k].x) * cr[0]; h[1] = bflo(hv[k].y) + bfhi(hv[k].y) * cr[1]; h[2] = bflo(hv[k].z) + bfhi(hv[k].z) * cr[2]; h[3] = bflo(hv[k].w) + bfhi(hv[k].w) * cr[3];
        u32x2 w; w.x = pk2(h[0] * gelu_tanh(bflo(gv[k].x)), h[1] * gelu_tanh(bfhi(gv[k].x))); w.y = pk2(h[2] * gelu_tanh(bflo(gv[k].y)), h[3] * gelu_tanh(bfhi(gv[k].y)));
        *(u32x2*)(br + (size_t)(4 * k) * 3072) = w;
    }
    if (tq == 3) {
        if (smp) *(f32x4*)(kout() + O_SLRU + ((size_t)l * 32 + (chunk - 256)) * 1024 + ch) = h;
        else if (n == 127) *(f32x4*)(kout() + O_PLRU + ((size_t)l * 2 + (chunk >> 7)) * 1024 + ch) = h;
    }
}

#define MFMA32(a, b, cc) __builtin_amdgcn_mfma_f32_32x32x16_bf16((a), (b), (cc), 0, 0, 0)
typedef short s16x4 __attribute__((ext_vector_type(4)));
template <int MODE, class Src>
DI void attn_item(LAS unsigned char* lds, const Src& src, const bf16_t* Qp  , bf16_t* Op  , int nband, int jj0, float sink_l2, const LAS float* tbl, int qbase, int tid) {
    constexpr int NT = MODE ? 4 : 1, NL = 2 * NT;
    const int lane = tid & 63, w = __builtin_amdgcn_readfirstlane(tid >> 6), r = lane & 31, h = lane >> 5;
    const int hl = MODE ? (w >> 1) : 0;
    const int lq = lane >> 4, chp = lane & 15;
#define ATT_ISSUE(jj_, isV_) do { _Pragma("unroll") for (int i_ = 0; i_ < NL; ++i_) { \
        const int t_ = MODE ? (w >> 1) : 0, rowb_ = MODE ? ((w & 1) * 32 + 4 * i_) : (8 * w + 4 * i_); \
        const int row_ = rowb_ + lq, ch_ = chp ^ ((lq << 2) | ((rowb_ >> 2) & 3)); \
        const bf16_t* base_; int st_; src.get((jj_), t_, (isV_), base_, st_); \
        __builtin_amdgcn_global_load_lds((const unsigned*)(base_ + (size_t)row_ * st_ + ch_ * 8), (LAS unsigned*)(lds + ((isV_) ? 65536 : 0) + t_ * 16384 + rowb_ * 256), 16, 0, 0); } } while (0)
    bf16x8 qf[8];
#pragma unroll
    for (int ks = 0; ks < 8; ++ks) qf[ks] = *(const bf16x8*)(Qp + (size_t)r * ZLD + ks * 16 + h * 8);
    f32x16 o[4];
#pragma unroll
    for (int db = 0; db < 4; ++db)
#pragma unroll
        for (int i = 0; i < 16; ++i) o[db][i] = 0.f;
    float mrun = MODE == 0 ? sink_l2 : -1e30f, lrun = MODE == 0 ? 1.f : 0.f;
    const float sc = 0.08838834764831845f * LOG2E;
    const LAS unsigned char* Kt = lds + hl * 16384 + 256 * r;
    const int kx = 16 * (h ^ (((r & 3) << 2) | ((r >> 2) & 3)));
    const int blk = (lane >> 4) & 1, q = (lane & 15) >> 2, p = lane & 3;
    const LAS unsigned char* Vt = lds + 65536 + hl * 16384 + 256 * (4 * h + q) + 8 * (p & 1);
    const int vlo = 2 * blk + (p >> 1);
    ATT_ISSUE(jj0, false); ATT_ISSUE(jj0, true);
    for (int jj = jj0; jj < nband; ++jj) {
        const bool last = (jj == nband - 1);
        if (MODE) asm volatile("s_waitcnt vmcnt(8)" ::: "memory"); else asm volatile("s_waitcnt vmcnt(2)" ::: "memory");
        __builtin_amdgcn_s_barrier(); asm volatile("" ::: "memory");
        f32x16 s[2];
#pragma unroll
        for (int kb = 0; kb < 2; ++kb) {
#pragma unroll
            for (int i = 0; i < 16; ++i) s[kb][i] = 0.f;
#pragma unroll
            for (int ks = 0; ks < 8; ++ks) { const bf16x8 kf = *(const LAS bf16x8*)(Kt + 8192 * kb + ((32 * ks) ^ kx)); s[kb] = MFMA32(kf, qf[ks], s[kb]); }
        }
        asm volatile("s_waitcnt lgkmcnt(0)" ::: "memory"); __builtin_amdgcn_s_barrier(); asm volatile("" ::: "memory");
        if (!last) ATT_ISSUE(jj + 1, false);
#pragma unroll
        for (int kb = 0; kb < 2; ++kb) {
            if (MODE == 1) {
                if (jj <= 5) { const float bc = tbl[256];
#pragma unroll
                    for (int i = 0; i < 16; ++i) s[kb][i] = s[kb][i] * sc + bc;
                } else {
                    const int dbase = qbase + r - kb * 32 - 4 * h + (8 - jj) * 64 + 128;
#pragma unroll
                    for (int i = 0; i < 16; ++i) { int idx = dbase - ((i & 3) + 8 * (i >> 2)); idx = idx > 256 ? 256 : idx; idx = idx < 0 ? 0 : idx; s[kb][i] = s[kb][i] * sc + tbl[idx]; }
                }
            } else {
#pragma unroll
                for (int i = 0; i < 16; ++i) s[kb][i] *= sc;
            }
        }
        float bm = fmaxf(s[0][0], s[1][0]);
#pragma unroll
        for (int i = 1; i < 16; ++i) bm = fmaxf(bm, fmaxf(s[0][i], s[1][i]));
        bm = fmaxf(bm, __shfl_xor(bm, 32));
        const float mnew = fmaxf(mrun, bm), alpha = __builtin_amdgcn_exp2f(mrun - mnew);
        float ps = 0.f;
#pragma unroll
        for (int kb = 0; kb < 2; ++kb)
#pragma unroll
            for (int i = 0; i < 16; ++i) { s[kb][i] = __builtin_amdgcn_exp2f(s[kb][i] - mnew); ps += s[kb][i]; }
        ps += __shfl_xor(ps, 32);
        lrun = lrun * alpha + ps; mrun = mnew;
#pragma unroll
        for (int db = 0; db < 4; ++db)
#pragma unroll
            for (int i = 0; i < 16; ++i) o[db][i] *= alpha;
        if (last) asm volatile("s_waitcnt vmcnt(0)" ::: "memory"); else { if (MODE) asm volatile("s_waitcnt vmcnt(8)" ::: "memory"); else asm volatile("s_waitcnt vmcnt(2)" ::: "memory"); }
        __builtin_amdgcn_s_barrier(); asm volatile("" ::: "memory");
#pragma unroll
        for (int kb = 0; kb < 2; ++kb)
#pragma unroll
            for (int st = 0; st < 2; ++st) {
                u32x4 pp; pp.x = pk2(s[kb][8 * st + 0], s[kb][8 * st + 1]); pp.y = pk2(s[kb][8 * st + 2], s[kb][8 * st + 3]); pp.z = pk2(s[kb][8 * st + 4], s[kb][8 * st + 5]); pp.w = pk2(s[kb][8 * st + 6], s[kb][8 * st + 7]);
                const bf16x8 pf = __builtin_bit_cast(bf16x8, pp);
#pragma unroll
                for (int db = 0; db < 4; ++db) {
                    s16x4 v2[2];
#pragma unroll
                    for (int t = 0; t < 2; ++t) {
                        const int f = (q << 2) | ((2 * t + h) & 3);
                        v2[t] = __builtin_amdgcn_ds_read_tr16_b64_v4i16((LAS s16x4*)(Vt + 256 * (32 * kb + 16 * st + 8 * t) + 16 * ((4 * db + vlo) ^ f)));
                    }
                    const bf16x8 vf = __builtin_shufflevector(v2[0], v2[1], 0, 1, 2, 3, 4, 5, 6, 7);
                    o[db] = MFMA32(vf, pf, o[db]);
                }
            }
        asm volatile("s_waitcnt lgkmcnt(0)" ::: "memory"); __builtin_amdgcn_s_barrier(); asm volatile("" ::: "memory");
        if (!last) ATT_ISSUE(jj + 1, true);
    }
#undef ATT_ISSUE
    const float inv = 1.0f / lrun;
#pragma unroll
    for (int db = 0; db < 4; ++db)
#pragma unroll
        for (int g = 0; g < 4; ++g) {
            u32x2 wv; wv.x = pk2(o[db][4 * g] * inv, o[db][4 * g + 1] * inv); wv.y = pk2(o[db][4 * g + 2] * inv, o[db][4 * g + 3] * inv);
            *(u32x2*)(Op + (size_t)r * 3072 + db * 32 + 8 * g + 4 * h) = wv;
        }
}
DI void attn_quad(LAS unsigned char* lds, const bf16_t* Z, bf16_t* BR, int c0  , int head, const LAS float* tbl, int tid) {
    const int lane = tid & 63, w = __builtin_amdgcn_readfirstlane(tid >> 6), r = lane & 31, h = lane >> 5;
    const int qc = w >> 1, qh = w & 1;
    const int lq = lane >> 4, chp = lane & 15;
    const int n0 = c0 & 127, j0 = n0 < 8 ? 8 - n0 : 0;
    const bf16_t* Qp = Z + (size_t)((c0 + qc) * 64 + qh * 32) * ZLD + C_QC + head * 128;
    bf16_t* Op = BR + (size_t)((c0 + qc) * 64 + qh * 32) * 3072 + 2048 + head * 128;
#define AQ_ISSUE(j_) do { const bf16_t* kb_ = Z + (size_t)(c0 - 8 + (j_)) * 64 * ZLD + C_KC + head * 128; LAS unsigned char* st_ = lds + ((j_) & 3) * 32768; \
        _Pragma("unroll") for (int i_ = 0; i_ < 2; ++i_) { const int rowb_ = 8 * w + 4 * i_, row_ = rowb_ + lq, ch_ = chp ^ ((lq << 2) | ((rowb_ >> 2) & 3)); \
            __builtin_amdgcn_global_load_lds((const unsigned*)(kb_ + (size_t)row_ * ZLD + ch_ * 8), (LAS unsigned*)(st_ + rowb_ * 256), 16, 0, 0); \
            __builtin_amdgcn_global_load_lds((const unsigned*)(kb_ + (C_VC - C_KC) + (size_t)row_ * ZLD + ch_ * 8), (LAS unsigned*)(st_ + 16384 + rowb_ * 256), 16, 0, 0); } } while (0)
    bf16x8 qf[8];
#pragma unroll
    for (int ks = 0; ks < 8; ++ks) qf[ks] = *(const bf16x8*)(Qp + (size_t)r * ZLD + ks * 16 + h * 8);
    f32x16 o[4];
#pragma unroll
    for (int db = 0; db < 4; ++db)
#pragma unroll
        for (int i = 0; i < 16; ++i) o[db][i] = 0.f;
    float mrun = -1e30f, lrun = 0.f;
    const float sc = 0.08838834764831845f * LOG2E;
    const int kx = 16 * (h ^ (((r & 3) << 2) | ((r >> 2) & 3)));
    const int blk = (lane >> 4) & 1, q = (lane & 15) >> 2, p = lane & 3;
    const int vlo = 2 * blk + (p >> 1);
    const int qbase = qh * 32;
    AQ_ISSUE(j0); if (j0 + 1 < 12) AQ_ISSUE(j0 + 1); if (j0 + 2 < 12) AQ_ISSUE(j0 + 2);
    for (int j = j0; j < 12; ++j) {
        if (j + 2 < 12) asm volatile("s_waitcnt vmcnt(8)" ::: "memory"); else if (j + 1 < 12) asm volatile("s_waitcnt vmcnt(4)" ::: "memory"); else asm volatile("s_waitcnt vmcnt(0)" ::: "memory");
        asm volatile("s_waitcnt lgkmcnt(0)" ::: "memory"); __builtin_amdgcn_s_barrier(); asm volatile("" ::: "memory");
        if (j + 3 < 12) AQ_ISSUE(j + 3);
        const int jj = j - qc;
        if (jj < 0 || jj > 8) continue;
        const LAS unsigned char* Kt = lds + (j & 3) * 32768 + 256 * r;
        const LAS unsigned char* Vt = lds + (j & 3) * 32768 + 16384 + 256 * (4 * h + q) + 8 * (p & 1);
        f32x16 s[2];
#pragma unroll
        for (int kb = 0; kb < 2; ++kb) {
#pragma unroll
            for (int i = 0; i < 16; ++i) s[kb][i] = 0.f;
#pragma unroll
            for (int ks = 0; ks < 8; ++ks) { const bf16x8 kf = *(const LAS bf16x8*)(Kt + 8192 * kb + ((32 * ks) ^ kx)); s[kb] = MFMA32(kf, qf[ks], s[kb]); }
        }
#pragma unroll
        for (int kb = 0; kb < 2; ++kb) {
            if (jj <= 5) { const float bc = tbl[256];
#pragma unroll
                for (int i = 0; i < 16; ++i) s[kb][i] = s[kb][i] * sc + bc;
            } else {
                const int dbase = qbase + r - kb * 32 - 4 * h + (8 - jj) * 64 + 128;
#pragma unroll
                for (int i = 0; i < 16; ++i) { int idx = dbase - ((i & 3) + 8 * (i >> 2)); idx = idx > 256 ? 256 : idx; idx = idx < 0 ? 0 : idx; s[kb][i] = s[kb][i] * sc + tbl[idx]; }
            }
        }
        float bm = fmaxf(s[0][0], s[1][0]);
#pragma unroll
        for (int i = 1; i < 16; ++i) bm = fmaxf(bm, fmaxf(s[0][i], s[1][i]));
        bm = fmaxf(bm, __shfl_xor(bm, 32));
        const float mnew = fmaxf(mrun, bm), alpha = __builtin_amdgcn_exp2f(mrun - mnew);
        float ps = 0.f;
#pragma unroll
        for (int kb = 0; kb < 2; ++kb)
#pragma unroll
            for (int i = 0; i < 16; ++i) { s[kb][i] = __builtin_amdgcn_exp2f(s[kb][i] - mnew); ps += s[kb][i]; }
        ps += __shfl_xor(ps, 32);
        lrun = lrun * alpha + ps; mrun = mnew;
#pragma unroll
        for (int db = 0; db < 4; ++db)
#pragma unroll
            for (int i = 0; i < 16; ++i) o[db][i] *= alpha;
#pragma unroll
        for (int kb = 0; kb < 2; ++kb)
#pragma unroll
            for (int st = 0; st < 2; ++st) {
                u32x4 pp; pp.x = pk2(s[kb][8 * st + 0], s[kb][8 * st + 1]); pp.y = pk2(s[kb][8 * st + 2], s[kb][8 * st + 3]); pp.z = pk2(s[kb][8 * st + 4], s[kb][8 * st + 5]); pp.w = pk2(s[kb][8 * st + 6], s[kb][8 * st + 7]);
                const bf16x8 pf = __builtin_bit_cast(bf16x8, pp);
#pragma unroll
                for (int db = 0; db < 4; ++db) {
                    s16x4 v2[2];
#pragma unroll
                    for (int t = 0; t < 2; ++t) {
                        const int f = (q << 2) | ((2 * t + h) & 3);
                        v2[t] = __builtin_amdgcn_ds_read_tr16_b64_v4i16((LAS s16x4*)(Vt + 256 * (32 * kb + 16 * st + 8 * t) + 16 * ((4 * db + vlo) ^ f)));
                    }
                    const bf16x8 vf = __builtin_shufflevector(v2[0], v2[1], 0, 1, 2, 3, 4, 5, 6, 7);
                    o[db] = MFMA32(vf, pf, o[db]);
                }
            }
    }
#undef AQ_ISSUE
    asm volatile("s_waitcnt lgkmcnt(0)" ::: "memory"); __builtin_amdgcn_s_barrier(); asm volatile("" ::: "memory");
    const float inv = 1.0f / lrun;
#pragma unroll
    for (int db = 0; db < 4; ++db)
#pragma unroll
        for (int g = 0; g < 4; ++g) {
            u32x2 wv; wv.x = pk2(o[db][4 * g] * inv, o[db][4 * g + 1] * inv); wv.y = pk2(o[db][4 * g + 2] * inv, o[db][4 * g + 3] * inv);
            *(u32x2*)(Op + (size_t)r * 3072 + db * 32 + 8 * g + 4 * h) = wv;
        }
}
struct SrcSwa {
    const bf16_t* Z; const bf16_t* KcB; const bf16_t* VcB; int chunk, kv;
    DI void get(int jj, int t, bool isV, const bf16_t*& base, int& st) const {
        if (chunk < 256) { const int cc = chunk - 2 + jj; base = Z + (size_t)cc * 64 * ZLD + (isV ? C_VB : C_KB) + kv * 128; st = ZLD; return; }
        const int bs = chunk - 256;
        if (jj < 2) { base = (isV ? VcB : KcB) + (size_t)(bs * 128 + jj * 64) * 256 + kv * 128; st = 256; return; }
        base = Z + (size_t)chunk * 64 * ZLD + (isV ? C_VB : C_KB) + kv * 128; st = ZLD;
    }
};
struct SrcCb {
    const bf16_t* Z; const bf16_t* KcC; const bf16_t* VcC; int chunk, head0;
    DI void get(int jj, int t, bool isV, const bf16_t*& base, int& st) const {
        const int head = head0 + t;
        if (chunk < 256) { const int cc = chunk - 8 + jj; base = Z + (size_t)cc * 64 * ZLD + (isV ? C_VC : C_KC) + head * 128; st = ZLD; return; }
        const int bs = chunk - 256;
        if (jj < 8) { base = (isV ? VcC : KcC) + (size_t)(bs * 512 + jj * 64) * 1024 + head * 128; st = 1024; return; }
        base = Z + (size_t)chunk * 64 * ZLD + (isV ? C_VC : C_KC) + head * 128; st = ZLD;
    }
};

DI void copy_state(const Ctx& c, float* dst, int nb, int rows, int width, int row0, int bstride, int col) {
    const bf16_t* Z = (const bf16_t*)(kws() + WS_Z);
    const int w8 = width >> 3; const size_t total = (size_t)nb * rows * w8;
    for (size_t i = (size_t)c.bid * NTHR + c.tid; i < total; i += (size_t)c.G * NTHR) {
        const int e = (int)(i % w8); const size_t rt = i / w8; const int t = (int)(rt % rows), b = (int)(rt / rows);
        const u32x4 v = *(const u32x4*)(Z + (size_t)(row0 + b * bstride + t) * ZLD + col + 8 * e);
        f32x4* d = (f32x4*)(dst + ((size_t)(b * rows + t) * width + 8 * e));
        d[0] = (f32x4){bflo(v.x), bfhi(v.x), bflo(v.y), bfhi(v.y)}; d[1] = (f32x4){bflo(v.z), bfhi(v.z), bflo(v.w), bfhi(v.w)};
    }
}

DI void inproj_tail_combine(const Ctx& c) {
    const float* part = (const float*)(kws() + WS_PART); const float* rs = (const float*)(kws() + WS_RS); bf16_t* Z = (bf16_t*)(kws() + WS_Z);
    for (int i = c.bid * NTHR + c.tid; i < 16 * 8192; i += c.G * NTHR) {
        const int tile = i >> 13, e = i & 8191, r = e >> 5, c8 = (e & 31) * 8, row = 71 * 256 + r;
        const float* p = part + ((size_t)tile * 256 + r) * 256 + c8;
        f32x4 v0 = *(const f32x4*)p, v1 = *(const f32x4*)(p + 4);
#pragma unroll
        for (int ks = 1; ks < 8; ++ks) { v0 += *(const f32x4*)(p + (size_t)ks * 16 * 65536); v1 += *(const f32x4*)(p + (size_t)ks * 16 * 65536 + 4); }
        const float sc = rs[row];
#pragma unroll
        for (int j = 0; j < 4; ++j) { v0[j] = __builtin_amdgcn_rcpf(1.0f + __expf(-v0[j] * sc)); v1[j] = __builtin_amdgcn_rcpf(1.0f + __expf(-v1[j] * sc)); }
        *(u32x2*)((unsigned char*)(kws() + WS_GATE) + (((size_t)71 * 24 + tile) * 256 + r) * 256 + c8) = pg8::packq8(v0, v1);
    }
}
DI void phase_postD(const Ctx& c) {
    const float* part = (const float*)(kws() + WS_PART); bf16_t* act = (bf16_t*)(kws() + WS_ACT2) + (size_t)MP * DM;
    const size_t total = (size_t)MS * DM / 8;
    for (size_t i = (size_t)c.bid * NTHR + c.tid; i < total; i += (size_t)c.G * NTHR) {
        const f32x4* p = (const f32x4*)part + 2 * i; const size_t st = (size_t)MS * DM / 4;
        const f32x4 v0 = p[0] + p[st] + p[2 * st], v1 = p[1] + p[st + 1] + p[2 * st + 1];
        ((u32x4*)act)[i] = pg8::pack8(v0, v1);
    }
}
DI void phase_postRes(const Ctx& c, const float* xinS  ) {
    const int gw = c.bid * NWAVES + c.wave, NGW = c.G * NWAVES;
    bf16_t* act = (bf16_t*)(kws() + WS_ACT); float* rs = (float*)(kws() + WS_RS); const float* part = (const float*)(kws() + WS_PART);
    for (int row = MP + gw; row < M; row += NGW) {
        const f32x4* pr = (const f32x4*)(part + (size_t)(row - MP) * DM) + c.lane; const size_t st = (size_t)MS * DM / 4;
        u32x2* ao = (u32x2*)(act + (size_t)row * DM) + c.lane;
        float s = 0.f;
#pragma unroll
        for (int j = 0; j < 8; ++j) {
            f32x4 xi;
            if (xinS) xi = ((const f32x4*)(xinS + (size_t)(row - MP) * DM) + c.lane)[64 * j];
            else { const u32x2 w = ao[64 * j]; xi = (f32x4){bflo(w.x), bfhi(w.x), bflo(w.y), bfhi(w.y)}; }
            const f32x4 v = xi + ((pr[64 * j] + pr[st + 64 * j]) + (pr[2 * st + 64 * j] + pr[3 * st + 64 * j]));
            u32x2 w; w.x = pk2(v[0], v[1]); w.y = pk2(v[2], v[3]); ao[64 * j] = w;
            s += (v[0] * v[0] + v[1] * v[1]) + (v[2] * v[2] + v[3] * v[3]);
        }
        s = wave_sum(s);
        if (c.lane == 0) rs[row] = 1.0f / sqrtf(s * (1.0f / DM) + EPS);
    }
    const float* ssq = (const float*)(kws() + WS_SSQ);
    for (int row = c.bid * NTHR + c.tid; row < MP; row += c.G * NTHR) {
        const f32x4* q = (const f32x4*)(ssq + (size_t)row * 32); float s = 0.f;
#pragma unroll
        for (int j = 0; j < 8; ++j) { const f32x4 v = q[j]; s += (v[0] + v[1]) + (v[2] + v[3]); }
        rs[row] = 1.0f / sqrtf(s * (1.0f / DM) + EPS);
    }
}

struct Args { const float* in[25]; float* out; unsigned char* ws; int ph_lo, ph_hi; };
constexpr int PH_PER_LAYER = 11, PH_FINAL = 1 + DEPTH * PH_PER_LAYER, PH_COUNT = PH_FINAL + 1;

__global__ void __launch_bounds__(NTHR, 2) fwd_kernel(Args args) {
    extern __shared__ __attribute__((aligned(16))) unsigned char lds_raw[];
    LAS unsigned char* const lds = (LAS unsigned char*)lds_raw;
    volatile LAS unsigned* misc = (volatile LAS unsigned*)(lds + LDS_MISC);
    if (threadIdx.x < 4) misc[threadIdx.x] = 0u;
    __syncthreads();
    const int lo = args.ph_lo, hi = args.ph_hi;
    XcdBarrier bar; bar.bar = (unsigned*)(kws() + WS_BAR); bar.x = 0; bar.st = misc;
    if (hi - lo > 1) bar = xcd_barrier_post((unsigned*)(kws() + WS_BAR), misc);
#define IN(k) (lo <= (k) && (k) < hi)
#define SEAM(k) do { if ((k) + 1 < hi) { bar.bar = (unsigned*)(kws() + WS_BAR); xcd_barrier(bar); } } while (0)
#define WSP(T, off) ((T*)(kws() + (off)))
#ifndef PHMASK
#define PHMASK 0xFFFF
#endif
#define PHON(j) ((PHMASK >> (j)) & 1)
#ifndef PROBE_MASK
#define PROBE_MASK 0
#endif
#define REP(j) for (int rep_ = 0; rep_ < 1 + ((PROBE_MASK >> (j)) & 1); ++rep_)
    if (PHON(14) && IN(0)) { REP(14) { const Ctx c = make_ctx(lds); phase_prologue(c); } SEAM(0); }

    for (int l = 0; l < DEPTH; ++l) {
        const int pb = 1 + l * PH_PER_LAYER;
        if (PHON(0) && IN(pb + 0) && l == 0) {
            const Ctx c = make_ctx(lds);
            REP(0) phase_norm(c, kin<0>(), kin<1>() - (size_t)MP * DM); SEAM(pb + 0);
        }
        if (PHON(1) && IN(pb + 1)) {
            pg8::InprojOrder S{{WSP(bf16_t, WS_ACT), WSP(bf16_t, WS_W) + (size_t)l * WL_SIZE + WL_IN, DM, DM}, (int)gridDim.x, (int)blockIdx.x};
            pg8::EpiInproj E{WSP(bf16_t, WS_Z), WSP(float, WS_RS), WSP(float, WS_PART), WSP(unsigned char, WS_GATE)};
            REP(1) pg8::gemm_phase(lds, S, E);
            {
                const Ctx c = make_ctx(lds); const int extra = (3584 + 128) % c.G;
                if (extra == 0 || c.bid >= extra) phase_cacheconv(c, l, extra == 0 ? c.bid : c.bid - extra, extra == 0 ? c.G : c.G - extra);
            }
            SEAM(pb + 1);
        }
        if (PHON(2) && IN(pb + 2)) {
            const Ctx c = make_ctx(lds);
            inproj_tail_combine(c);
            REP(12) lru_local_phase(c, l);
            REP(13) for (int u = c.bid; u < (c.G >= 128 ? 512 : NCHUNK * 2); u += c.G) {
                const int chunk = u >> 1, kv = u & 1, head = kv * 4 + (c.wave >> 1), qh = c.wave & 1;
                const bf16_t* Z = WSP(bf16_t, WS_Z);
                SrcSwa src{Z, WSP(bf16_t, WS_KCB), WSP(bf16_t, WS_VTCB), chunk, kv};
                const int n = chunk & 127, jj0 = (chunk < 256 && n < 2) ? 2 - n : 0;
                attn_item<0>(c.lds, src, Z + (size_t)(chunk * 64 + qh * 32) * ZLD + C_QB + head * 128, WSP(bf16_t, WS_BR) + (size_t)(chunk * 64 + qh * 32) * 3072 + 1024 + head * 128, 3, jj0,
                             kin<17>()[l * 8 + head] * LOG2E, nullptr, 0, c.tid);
            }
            SEAM(pb + 2);
        }
        if (PHON(3) && IN(pb + 3)) {
            const Ctx c = make_ctx(lds);
            LAS float* tbl = (LAS float*)(c.lds + LDS_TBL);
            for (int i = c.tid; i < 8 * 257; i += NTHR) { const int hh = i / 257, e = i - hh * 257; tbl[hh * 260 + e] = kin<18>()[(size_t)l * 8 * 257 + i] * LOG2E; }
            __syncthreads();
            REP(3) {
            {
                const bf16_t* Z = WSP(bf16_t, WS_Z);
                for (int u = c.bid; u < 512; u += c.G) {
                    const int x = u & 7, k = u >> 3;
                    attn_quad(c.lds, Z, WSP(bf16_t, WS_BR), 4 * k, x, tbl + x * 260, c.tid);
                }
            }
            {
                const int nsmp = c.G >= 128 ? 64 : 0;
                if (c.bid < nsmp || nsmp == 0) {
                    for (int u = c.bid; u < 64; u += (nsmp ? nsmp : c.G)) {
                        const int hg = u & 1, chunk = 256 + (u >> 1), head = hg * 4 + (c.wave >> 1), qh = c.wave & 1;
                        const bf16_t* Z = WSP(bf16_t, WS_Z);
                        SrcCb src{Z, WSP(bf16_t, WS_KCC), WSP(bf16_t, WS_VTCC), chunk, hg * 4};
                        attn_item<1>(c.lds, src, Z + (size_t)(chunk * 64 + qh * 32) * ZLD + C_QC + head * 128, WSP(bf16_t, WS_BR) + (size_t)(chunk * 64 + qh * 32) * 3072 + 2048 + head * 128, 9, 0,
                                     0.f, tbl + head * 260, qh * 32, c.tid);
                    }
                    if (nsmp) {
                        const int u = 512 + c.bid, chunk = u >> 1, kv = u & 1, head = kv * 4 + (c.wave >> 1), qh = c.wave & 1;
                        const bf16_t* Z = WSP(bf16_t, WS_Z);
                        SrcSwa src{Z, WSP(bf16_t, WS_KCB), WSP(bf16_t, WS_VTCB), chunk, kv};
                        attn_item<0>(c.lds, src, Z + (size_t)(chunk * 64 + qh * 32) * ZLD + C_QB + head * 128, WSP(bf16_t, WS_BR) + (size_t)(chunk * 64 + qh * 32) * 3072 + 1024 + head * 128, 3, 0,
                                     kin<17>()[l * 8 + head] * LOG2E, nullptr, 0, c.tid);
                    }
                }
                if (c.bid >= nsmp) for (int u = c.bid - nsmp; u < NCHUNK * 2; u += c.G - nsmp) lru_fix_unit(c, l, u >> 1, u & 1);
            }
            copy_state(c, kout() + O_PCONV + (size_t)l * 2 * 3 * 1024, 2, 3, 1024, 8189, 8192, C_AX);
            copy_state(c, kout() + O_SCONV + (size_t)l * 32 * 3 * 1024, 32, 3, 1024, MP + 61, 64, C_AX);
            copy_state(c, kout() + O_PSWAK + (size_t)l * 2 * 128 * 256, 2, 128, 256, 8192 - 128, 8192, C_KB);
            copy_state(c, kout() + O_PSWAV + (size_t)l * 2 * 128 * 256, 2, 128, 256, 8192 - 128, 8192, C_VB);
            copy_state(c, kout() + O_PCBK + (size_t)l * 2 * 512 * 1024, 2, 512, 1024, 8192 - 512, 8192, C_KC);
            copy_state(c, kout() + O_PCBV + (size_t)l * 2 * 512 * 1024, 2, 512, 1024, 8192 - 512, 8192, C_VC);
            copy_state(c, kout() + O_SSWAK + (size_t)l * 32 * 64 * 256, 32, 64, 256, MP, 64, C_KB);
            copy_state(c, kout() + O_SSWAV + (size_t)l * 32 * 64 * 256, 32, 64, 256, MP, 64, C_VB);
            copy_state(c, kout() + O_SCBK + (size_t)l * 32 * 64 * 1024, 32, 64, 1024, MP, 64, C_KC);
            copy_state(c, kout() + O_SCBV + (size_t)l * 32 * 64 * 1024, 32, 64, 1024, MP, 64, C_VC);
            }
            SEAM(pb + 3);
        }
        if (PHON(4) && IN(pb + 4)) {
            pg8::SplitOrder S{{WSP(bf16_t, WS_BR), WSP(bf16_t, WS_W) + (size_t)l * WL_SIZE + WL_BR, 3 * BW, 3 * BW}, (int)gridDim.x, (int)blockIdx.x, 3 * BW / 64, 3, BW / 64};
            pg8::EpiD E{WSP(unsigned char, WS_GATE), WSP(bf16_t, WS_ACT2), WSP(float, WS_PART)};
            pg8::gemm_phase(lds, S, E);
            SEAM(pb + 4);
        }
        if (PHON(5) && IN(pb + 5)) { const Ctx c = make_ctx(lds); phase_postD(c); SEAM(pb + 5); }
        if (PHON(6) && IN(pb + 6)) {
            pg8::SplitOrder S{{WSP(bf16_t, WS_ACT2), WSP(bf16_t, WS_W) + (size_t)l * WL_SIZE + WL_OUT, DM, DM}, (int)gridDim.x, (int)blockIdx.x, DM / 64, 4, DM / 256};
            if (l == 0) { pg8::EpiRes<true> E{kin<0>(), WSP(bf16_t, WS_ACT), WSP(float, WS_SSQ), WSP(float, WS_PART)}; pg8::gemm_phase(lds, S, E); }
            else { pg8::EpiRes<false> E{nullptr, WSP(bf16_t, WS_ACT), WSP(float, WS_SSQ), WSP(float, WS_PART)}; pg8::gemm_phase(lds, S, E); }
            SEAM(pb + 6);
        }
        if (PHON(7) && IN(pb + 7)) { const Ctx c = make_ctx(lds); phase_postRes(c, l == 0 ? kin<1>() : nullptr); SEAM(pb + 7); }
        if (PHON(8) && IN(pb + 8)) {
            pg8::FullOrder S{{WSP(bf16_t, WS_ACT), WSP(bf16_t, WS_W) + (size_t)l * WL_SIZE + WL_UP, DM, DM}, M / 256, DFF / 256, (int)gridDim.x, (int)blockIdx.x, DM / 64};
            pg8::EpiUp E{WSP(bf16_t, WS_Z)  , WSP(float, WS_RS)};
            REP(8) pg8::gemm_phase(lds, S, E);
            SEAM(pb + 8);
        }
        if (PHON(9) && IN(pb + 9)) {
            pg8::SplitOrder S{{WSP(bf16_t, WS_Z), WSP(bf16_t, WS_W) + (size_t)l * WL_SIZE + WL_DOWN, DFF, DFF}, (int)gridDim.x, (int)blockIdx.x, DFF / 64, 4, DFF / 256};
            pg8::EpiRes<false> E{nullptr, WSP(bf16_t, WS_ACT), WSP(float, WS_SSQ), WSP(float, WS_PART)};
            pg8::gemm_phase(lds, S, E);
            SEAM(pb + 9);
        }
        if (PHON(10) && IN(pb + 10)) { const Ctx c = make_ctx(lds); phase_postRes(c, nullptr); SEAM(pb + 10); }
    }
    if (PHON(11) && IN(PH_FINAL)) { const Ctx c = make_ctx(lds); phase_final(c); }
#undef IN
#undef SEAM
}

#ifndef N_LAUNCH_MODE
#define N_LAUNCH_MODE 1
#endif
extern "C" void kernel_launch(void* const* d_in, const int* in_sizes, int n_in, void* d_out, int out_size, void* d_ws, size_t ws_size, hipStream_t stream) {
    static int grid = 0;
    if (grid == 0) {
        if (n_in != 25 || (size_t)out_size != O_END || ws_size < WS_END) { fprintf(stderr, "kernel_launch: unexpected sizes (n_in %d out %d ws %zu need %zu)\n", n_in, out_size, ws_size, (size_t)WS_END); grid = -1; return; }
        int dev = 0, cus = 0, per_cu = 0;
        if (hipGetDevice(&dev) != hipSuccess || hipDeviceGetAttribute(&cus, hipDeviceAttributeMultiprocessorCount, dev) != hipSuccess) { grid = -1; return; }
        if (hipFuncSetAttribute((const void*)fwd_kernel, hipFuncAttributeMaxDynamicSharedMemorySize, LDS_BYTES) != hipSuccess) { fprintf(stderr, "kernel_launch: hipFuncSetAttribute failed\n"); grid = -1; return; }
        if (hipOccupancyMaxActiveBlocksPerMultiprocessor(&per_cu, (const void*)fwd_kernel, NTHR, LDS_BYTES) != hipSuccess || per_cu < 1) { fprintf(stderr, "kernel_launch: occupancy query says %d\n", per_cu); (void)hipGetLastError(); grid = -1; return; }
        grid = cus;
    }
    if (grid < 0) return;
    (void)hipMemsetAsync((char*)d_ws + WS_BAR, 0, 16384, stream);
    Args a{};
    for (int i = 0; i < 25; ++i) a.in[i] = (const float*)d_in[i];
    a.out = (float*)d_out; a.ws = (unsigned char*)d_ws;
#if N_LAUNCH_MODE == 1
    a.ph_lo = 0; a.ph_hi = PH_COUNT;
    hipLaunchKernelGGL(fwd_kernel, dim3(grid), dim3(NTHR), LDS_BYTES, stream, a);
#else
    for (int p = 0; p < PH_COUNT; ++p) { a.ph_lo = p; a.ph_hi = p + 1; hipLaunchKernelGGL(fwd_kernel, dim3(grid), dim3(NTHR), LDS_BYTES, stream, a); }
#endif
}
```

```cpp
#include <hip/hip_runtime.h>
#include <cstdio>
#include <cstdint>

#define LAS __attribute__((address_space(3)))
typedef unsigned short bf16_t;
typedef short bf16x8 __attribute__((ext_vector_type(8)));
typedef float f32x2 __attribute__((ext_vector_type(2)));
typedef float f32x4 __attribute__((ext_vector_type(4)));
typedef float f32x16 __attribute__((ext_vector_type(16)));
typedef unsigned u32x2 __attribute__((ext_vector_type(2)));
typedef unsigned u32x4 __attribute__((ext_vector_type(4)));
typedef __bf16 bf16v2 __attribute__((ext_vector_type(2)));
#define DI __device__ __forceinline__

constexpr int MP = 16384, MS = 2048, M = MP + MS, DM = 2048, DIN = 12800, DFF = 8192, BW = 1024, DEPTH = 4, NCHUNK = M / 64;
constexpr int ZLD = 6656;
constexpr int C_AX = 0, C_AG = 1024, C_QB = 2048, C_KB = 3072, C_VB = 3328, C_QC = 3584, C_KC = 4608, C_VC = 5632, C_G = 6656;
constexpr int NWAVES = 8, NTHR = 512;
constexpr float EPS = 1e-6f, LOG2E = 1.4426950408889634f;
constexpr size_t O_YP = 0, O_YS = O_YP + (size_t)MP * DM, O_PCONV = O_YS + (size_t)MS * DM, O_PLRU = O_PCONV + 4 * 2 * 3 * 1024, O_PSWAK = O_PLRU + 4 * 2 * 1024,
                 O_PSWAV = O_PSWAK + 4 * 2 * 128 * 256, O_PCBK = O_PSWAV + 4 * 2 * 128 * 256, O_PCBV = O_PCBK + (size_t)4 * 2 * 512 * 1024, O_SCONV = O_PCBV + (size_t)4 * 2 * 512 * 1024,
                 O_SLRU = O_SCONV + 4 * 32 * 3 * 1024, O_SSWAK = O_SLRU + 4 * 32 * 1024, O_SSWAV = O_SSWAK + (size_t)4 * 32 * 64 * 256, O_SCBK = O_SSWAV + (size_t)4 * 32 * 64 * 256,
                 O_SCBV = O_SCBK + (size_t)4 * 32 * 64 * 1024, O_END = O_SCBV + (size_t)4 * 32 * 64 * 1024;
constexpr size_t WL_IN = 0, WL_BR = WL_IN + (size_t)DIN * DM, WL_OUT = WL_BR + (size_t)3 * DM * BW, WL_UP = WL_OUT + (size_t)DM * DM, WL_DOWN = WL_UP + (size_t)DFF * DM, WL_SIZE = WL_DOWN + (size_t)DM * DFF;
constexpr size_t al256(size_t x) { return (x + 255) & ~(size_t)255; }
constexpr size_t WS_BAR = 0, WS_RS = 16384, WS_AGG = al256(WS_RS + (size_t)M * 4), WS_LRUW = al256(WS_AGG + (size_t)NCHUNK * 1024 * 2 * 4),
                 WS_W = al256(WS_LRUW + (size_t)DEPTH * 2 * 8 * 128 * 128 * 2), WS_ACT = al256(WS_W + (size_t)DEPTH * WL_SIZE * 2), WS_Z = al256(WS_ACT + (size_t)M * DM * 2),
                 WS_KCB = al256(WS_Z + (size_t)M * DFF * 2),
                 WS_VTCB = al256(WS_KCB + (size_t)32 * 128 * 256 * 2), WS_KCC = al256(WS_VTCB + (size_t)32 * 2 * 2 * 8192 * 2), WS_VTCC = al256(WS_KCC + (size_t)32 * 512 * 1024 * 2),
                 WS_R1 = al256(WS_VTCC + (size_t)32 * 8 * 8 * 8192 * 2), WS_BR = al256(WS_R1 + (size_t)2 * M * 1024 * 4), WS_SSQ = al256(WS_BR + (size_t)M * 3 * BW * 2),
                 WS_PART = al256(WS_SSQ + (size_t)MP * 32 * 4), WS_ACT2 = al256(WS_PART + (size_t)4 * MS * DM * 4), WS_GATE = al256(WS_ACT2 + (size_t)M * DM * 2), WS_END = al256(WS_GATE + (size_t)M * 3 * DM * 2);
constexpr int LDS_STAGE = 131072, LDS_MISC = LDS_STAGE, LDS_TBL = LDS_STAGE + 256, LDS_BYTES = LDS_STAGE + 256 + 8 * 260 * 4 + 64;


template <int OFF> DI unsigned long long karg64() { auto ka = __builtin_amdgcn_kernarg_segment_ptr(); unsigned long long p;
    asm volatile("s_load_dwordx2 %0, %1, %2\n\ts_waitcnt lgkmcnt(0)" : "=s"(p) : "s"(ka), "n"(OFF)); return p; }
template <int I> DI const float* kin() { return (const float*)karg64<I * 8>(); }
DI float* kout() { return (float*)karg64<200>(); }
DI unsigned char* kws() { return (unsigned char*)karg64<208>(); }
DI int launder_tid() { int t = threadIdx.x; asm volatile("" : "+v"(t)); return t; }
DI float bf2f(unsigned short b) { return __uint_as_float(((unsigned)b) << 16); }
DI float bflo(unsigned w) { return __uint_as_float(w << 16); }
DI float bfhi(unsigned w) { return __uint_as_float(w & 0xffff0000u); }
DI unsigned pk2(float a, float b) { f32x2 v = {a, b}; bf16v2 r = __builtin_convertvector(v, bf16v2); return __builtin_bit_cast(unsigned, r); }
DI float wave_sum(float v) {
#pragma unroll
    for (int o = 1; o < 64; o <<= 1) v += __shfl_xor(v, o);
    return v;
}
DI float sigmoidf_(float x) { return 1.0f / (1.0f + __expf(-x)); }
DI float gelu_tanh(float x) { const float u = 0.7978845608028654f * (x + 0.044715f * x * x * x); const float e = __expf(-2.0f * u); return x * (1.0f / (1.0f + e)); }

#define XB_TMO      128
#define XB_XCNT(j)  (256  + 64 * (j))
#define XB_XSUB(j)  (1280 + 64 * (j))
#define XB_XGEN(j)  (2304 + 64 * (j))
#define XB_TOP      3328
#define XB_TOPGEN   3392
#define XCD_BAR_WORDS 3456
#define XB_SPIN_CAP (1u << 20)
DI unsigned xb_ld(unsigned* p)              { return __hip_atomic_load(p, __ATOMIC_RELAXED, __HIP_MEMORY_SCOPE_AGENT); }
DI unsigned xb_add(unsigned* p, unsigned v) { return __hip_atomic_fetch_add(p, v, __ATOMIC_RELAXED, __HIP_MEMORY_SCOPE_AGENT); }
DI unsigned xb_xcc_id() { return (unsigned)__builtin_amdgcn_s_getreg((3 << 11) | 20) & 0xFu; }
#define XB_SPIN(cond, bar) do { unsigned _sp = 0; while (cond) { __builtin_amdgcn_s_sleep(1); \
    if ((++_sp & 255u) == 0u) { if (xb_ld(&(bar)[XB_TMO])) break; if (_sp > XB_SPIN_CAP) { atomicAdd(&(bar)[XB_TMO], 1u); break; } } } } while (0)
struct XcdBarrier { unsigned* bar; unsigned x; volatile LAS unsigned* st; };
DI XcdBarrier xcd_barrier_post(unsigned* bar, volatile LAS unsigned* st) {
    XcdBarrier b; b.bar = bar; b.x = xb_xcc_id(); b.st = st;
    if (threadIdx.x == 0) (void)xb_add(&bar[XB_XCNT(b.x)], 1u);
    return b;
}
DI void xcd_barrier_complete(unsigned* bar, unsigned x, unsigned& nloc, unsigned& nx) {
    const unsigned G = gridDim.x * gridDim.y * gridDim.z;
    unsigned sum, cnt, mine, sp = 0u;
    for (;;) {
        sum = 0u; cnt = 0u; mine = 0u;
#pragma unroll
        for (unsigned j = 0; j < 16; ++j) { const unsigned c = xb_ld(&bar[XB_XCNT(j)]); sum += c; cnt += (c > 0u) ? 1u : 0u; mine = (j == x) ? c : mine; }
        if (sum == G) break;
        __builtin_amdgcn_s_sleep(1);
        if ((++sp & 255u) == 0u) { if (xb_ld(&bar[XB_TMO])) break; if (sp > XB_SPIN_CAP) { atomicAdd(&bar[XB_TMO], 1u); break; } }
    }
    nloc = mine > 0u ? mine : 1u; nx = cnt > 0u ? cnt : 1u;
}
DI void xcd_barrier(const XcdBarrier& b) {
    asm volatile("s_waitcnt vmcnt(0)" ::: "memory");
    __syncthreads();
    if (threadIdx.x == 0) {
        unsigned* bar = b.bar;
        __builtin_amdgcn_s_waitcnt(0);
        unsigned nloc = b.st[0], nx = b.st[1];
        if (nloc == 0u) { xcd_barrier_complete(bar, b.x, nloc, nx); b.st[0] = nloc; b.st[1] = nx; }
        const unsigned old = xb_add(&bar[XB_XSUB(b.x)], 1u);
        const unsigned gen = old / nloc;
        if (old + 1u == (gen + 1u) * nloc) {
            __builtin_amdgcn_fence(__ATOMIC_RELEASE, "agent");
            asm volatile("s_waitcnt vmcnt(0)" ::: "memory");
            const unsigned og = xb_add(&bar[XB_TOP], 1u);
            const unsigned tg = og / nx;
            if (og + 1u == (tg + 1u) * nx) xb_add(&bar[XB_TOPGEN], 1u);
            else XB_SPIN(xb_ld(&bar[XB_TOPGEN]) == tg, bar);
            __builtin_amdgcn_fence(__ATOMIC_ACQUIRE, "agent");
            xb_add(&bar[XB_XGEN(b.x)], 1u);
            asm volatile("s_waitcnt vmcnt(0)" ::: "memory");
        } else {
            XB_SPIN(xb_ld(&bar[XB_XGEN(b.x)]) == gen, bar);
            __builtin_amdgcn_fence(__ATOMIC_ACQUIRE, "agent");
            asm volatile("s_waitcnt vmcnt(0)" ::: "memory");
        }
    }
    __syncthreads();
}

namespace pg8 {
constexpr int BM = 256, BK = 64, HALF = 128, HTB = HALF * BK * 2, STAGE_BYTES = 8 * HTB, NXCD = 8;
#ifndef WGM_FULL
#define WGM_FULL 8
#endif
#ifndef WGM_INPROJ
#define WGM_INPROJ 8
#endif
#ifndef WGM_SPLIT
#define WGM_SPLIT 4
#endif
DI int lds_byte(int r, int c) { const int st = (r >> 4) * 2 + (c >> 5), rr = r & 15, cc = c & 31, ob = rr * 64 + cc * 2; return st * 1024 + (ob ^ (((ob >> 9) & 1) << 5)); }
DI void stage_rc(int b, int& R, int& C) { const int st = b / 1024, sb = b % 1024, swz = sb ^ (((sb >> 9) & 1) << 5); R = (st >> 1) * 16 + swz / 64; C = (st & 1) * 32 + (swz % 64) / 2; }
DI int perm32(int rho) { const int n = rho >> 4, i = rho & 15; return 8 * (i >> 2) + 4 * n + (i & 3); }
struct Unit { int pm, pn, ks, nt; const char* a; const char* b; };
struct Geo { const bf16_t* A; const bf16_t* Bt; int lda, ldb; };
template <int WGM> DI void xcd_tile(int L, int nM, int nN, int& pm, int& pn) {
    const int nwg = nM * nN; int wgid = L; { const int q = nwg / NXCD, r = nwg % NXCD, xcd = wgid % NXCD, off = wgid / NXCD; wgid = (xcd < r ? xcd * (q + 1) : r * (q + 1) + (xcd - r) * q) + off; }
    const int nig = WGM * nN, gid = wgid / nig, fm = gid * WGM, gsz = (nM - fm) < WGM ? (nM - fm) : WGM;
    pm = fm + ((wgid % nig) % gsz); pn = (wgid % nig) / gsz;
}
struct FullOrder {
    Geo g; int nM, nN, G, c, nt;
    DI bool next(int i, Unit& u) const {
        const long L = (long)i * G + c; if (L >= (long)nM * nN) return false;
        xcd_tile<WGM_FULL>((int)L, nM, nN, u.pm, u.pn); u.ks = -1; u.nt = nt;
        u.a = (const char*)g.A + (size_t)u.pm * BM * g.lda * 2; u.b = (const char*)g.Bt + (size_t)u.pn * BM * g.ldb * 2; return true;
    }
};
struct InprojOrder {
    Geo g; int G, c;
    DI bool next(int i, Unit& u) const {
        const long L = (long)i * G + c;
        if (L < 3584) {
            if (L < 3550) xcd_tile<WGM_INPROJ>((int)L, 71, 50, u.pm, u.pn); else { const int idx = (int)L - 3550; u.pm = 71; u.pn = idx < 26 ? idx : idx + 16; }
            u.ks = -1; u.nt = DM / BK; u.a = (const char*)g.A + (size_t)u.pm * BM * g.lda * 2; u.b = (const char*)g.Bt + (size_t)u.pn * BM * g.ldb * 2; return true; }
        const long j = L - 3584; if (j >= 128) return false;
        u.pm = 71; u.pn = 26 + ((int)j & 15); u.ks = (int)(j >> 4); u.nt = 4;
        u.a = (const char*)g.A + ((size_t)u.pm * BM * g.lda + (size_t)u.ks * 256) * 2; u.b = (const char*)g.Bt + ((size_t)u.pn * BM * g.ldb + (size_t)u.ks * 256) * 2; return true;
    }
};
struct SplitOrder {
    Geo g; int G, c, ntFull, S, ntSplit;
    DI bool next(int i, Unit& u) const {
        const long L = (long)i * G + c;
        if (L < 512) { xcd_tile<WGM_SPLIT>((int)L, 64, 8, u.pm, u.pn); u.ks = -1; u.nt = ntFull;
            u.a = (const char*)g.A + (size_t)u.pm * BM * g.lda * 2; u.b = (const char*)g.Bt + (size_t)u.pn * BM * g.ldb * 2; return true; }
        const long j = L - 512; if (j >= 64 * S) return false;
        const int xq = (int)j & 7, sq = (int)j >> 3, combo = xq * S + (sq >> 3); u.pn = sq & 7; u.pm = 64 + (combo & 7); u.ks = combo >> 3; u.nt = ntSplit;
        u.a = (const char*)g.A + ((size_t)u.pm * BM * g.lda + (size_t)u.ks * ntSplit * BK) * 2; u.b = (const char*)g.Bt + ((size_t)u.pn * BM * g.ldb + (size_t)u.ks * ntSplit * BK) * 2; return true;
    }
};
template <class Epi, class Sched>
DI void gemm_phase(LAS unsigned char* lds, const Sched& S, const Epi& E) {
    const int tid = launder_tid(), wid = __builtin_amdgcn_readfirstlane(tid >> 6), lane = tid & 63, wr = wid >> 2, wc = wid & 3, fr = lane & 15, fq = lane >> 4;
    const int lda = S.g.lda, ldb = S.g.ldb;
    unsigned voffA[2], voffB[2];
#pragma unroll
    for (int i = 0; i < 2; ++i) { int R, C; stage_rc(tid * 16 + i * 8192, R, C); const int Rb = (R & ~31) + perm32(R & 31);
        voffA[i] = (unsigned)(R * lda + C) * 2u; voffB[i] = (unsigned)(Rb * ldb + C) * 2u; }
    const size_t kstep = (size_t)(BK * 2);
    const size_t hstepA = (size_t)HALF * lda * 2, hstepB = (size_t)HALF * ldb * 2;
    const unsigned ldsw = (unsigned)wid * 1024u;
    const int aoff = lds_byte(wr * 64 + fr, fq * 8), boff = lds_byte(wc * 32 + fr, fq * 8);
#define PG8_SA(b, h) (((b) * 2 + (h)) * HTB)
#define PG8_SB(b, h) ((4 + (b) * 2 + (h)) * HTB)
#define PG8_STAGE(bufoff, gbase, voff) do { _Pragma("unroll") for (int _i = 0; _i < 2; ++_i) \
        __builtin_amdgcn_global_load_lds((const unsigned*)((const char*)(gbase) + (voff)[_i]), (LAS unsigned*)(lds + (bufoff) + ldsw + _i * 8192), 16, 0, 0); } while (0)
#define PG8_LDA(dst, b, h) do { _Pragma("unroll") for (int m = 0; m < 4; ++m) _Pragma("unroll") for (int k = 0; k < 2; ++k) dst[m][k] = *(const LAS bf16x8*)(lds + PG8_SA(b, h) + aoff + m * 2048 + k * 1024); } while (0)
#define PG8_LDB(dst, b, h) do { _Pragma("unroll") for (int n = 0; n < 2; ++n) _Pragma("unroll") for (int k = 0; k < 2; ++k) dst[n][k] = *(const LAS bf16x8*)(lds + PG8_SB(b, h) + boff + n * 2048 + k * 1024); } while (0)
#define PG8_MMA(ai, bj, At, Bt) do { __builtin_amdgcn_s_setprio(1); _Pragma("unroll") for (int m = 0; m < 4; ++m) _Pragma("unroll") for (int n = 0; n < 2; ++n) _Pragma("unroll") for (int k = 0; k < 2; ++k) \
        acc[ai][bj][m][n] = __builtin_amdgcn_mfma_f32_16x16x32_bf16(Bt[n][k], At[m][k], acc[ai][bj][m][n], 0, 0, 0); __builtin_amdgcn_s_setprio(0); } while (0)
#define PG8_WAIT_V(n) asm volatile("s_waitcnt vmcnt(" #n ")" ::: "memory")
#define PG8_WAIT_L(n) asm volatile("s_waitcnt lgkmcnt(" #n ")" ::: "memory")
#define PG8_BAR __builtin_amdgcn_s_barrier()
#define PG8_SCHED __builtin_amdgcn_sched_barrier(0)
    Unit cur, nxt; int ui = 0;
    if (!S.next(0, cur)) return;
    f32x4 acc[2][2][4][2];
#pragma unroll
    for (int a = 0; a < 2; ++a)
#pragma unroll
        for (int b = 0; b < 2; ++b)
#pragma unroll
            for (int m = 0; m < 4; ++m)
#pragma unroll
                for (int n = 0; n < 2; ++n) acc[a][b][m][n] = (f32x4){0.f, 0.f, 0.f, 0.f};
    bf16x8 At[4][2], B0[2][2], B1[2][2];
    const char* cA = cur.a; const char* cB = cur.b;
#define PG8_RSDMA(unit_, par_) do { if constexpr (Epi::RSLDS) { if (wid < 4) __builtin_amdgcn_global_load_lds((const unsigned*)(E.rs + (unit_).pm * BM + wid * 64 + lane), \
        (LAS unsigned*)(lds + LDS_TBL + (par_) * 1024 + wid * 256), 4, 0, 0); } } while (0)
    PG8_RSDMA(cur, 0);
    PG8_STAGE(PG8_SB(0, 0), cB, voffB); PG8_STAGE(PG8_SB(0, 1), cB + hstepB, voffB); PG8_STAGE(PG8_SA(0, 0), cA, voffA); PG8_STAGE(PG8_SA(0, 1), cA + hstepA, voffA);
    if (wr == 1) PG8_BAR;
    PG8_WAIT_V(2); PG8_BAR;
    PG8_STAGE(PG8_SB(1, 0), cB + kstep, voffB); PG8_STAGE(PG8_SA(1, 0), cA + kstep, voffA); PG8_STAGE(PG8_SB(1, 1), cB + hstepB + kstep, voffB);
    PG8_WAIT_V(6); PG8_BAR;
    for (;;) {
        const bool has_next = S.next(ui + 1, nxt);
        const char* nA = has_next ? nxt.a : cA; const char* nB = has_next ? nxt.b : cB;
        const int nt = cur.nt;
        for (int t = 0; t < nt; t += 2) {
            const bool last = (t == nt - 2);
            const char* a1 = cA + (size_t)(t + 1) * kstep;
            const char* a2 = last ? nA : cA + (size_t)(t + 2) * kstep; const char* b2 = last ? nB : cB + (size_t)(t + 2) * kstep;
            const char* a3 = a2 + kstep; const char* b3 = b2 + kstep;
            if constexpr (Epi::HOOK) { if (cur.ks < 0 && (t == 16 || t == 32)) E.hook(acc, cur, t >> 4, wr, wc, fr, fq); }
            PG8_LDB(B0, 0, 0); PG8_LDB(B1, 0, 1); PG8_SCHED; PG8_LDA(At, 0, 0); PG8_STAGE(PG8_SA(1, 1), a1 + hstepA, voffA);
            PG8_WAIT_V(8); PG8_WAIT_L(0); PG8_BAR; PG8_MMA(0, 0, At, B0); PG8_MMA(0, 1, At, B1); PG8_BAR; PG8_SCHED;
            PG8_LDA(At, 0, 1); PG8_STAGE(PG8_SB(0, 0), b2, voffB); PG8_STAGE(PG8_SB(0, 1), b2 + hstepB, voffB); PG8_STAGE(PG8_SA(0, 0), a2, voffA);
            PG8_WAIT_V(8); PG8_WAIT_L(0); PG8_BAR; PG8_MMA(1, 0, At, B0); PG8_MMA(1, 1, At, B1); PG8_BAR; PG8_SCHED;
            PG8_LDB(B0, 1, 0); PG8_LDB(B1, 1, 1); PG8_SCHED; PG8_LDA(At, 1, 0); PG8_STAGE(PG8_SA(0, 1), a2 + hstepA, voffA);
            PG8_WAIT_V(8); PG8_WAIT_L(0); PG8_BAR; PG8_MMA(0, 0, At, B0); PG8_MMA(0, 1, At, B1); PG8_BAR; PG8_SCHED;
            PG8_LDA(At, 1, 1); PG8_STAGE(PG8_SB(1, 0), b3, voffB); PG8_STAGE(PG8_SB(1, 1), b3 + hstepB, voffB); PG8_STAGE(PG8_SA(1, 0), a3, voffA);
            PG8_WAIT_V(8); PG8_WAIT_L(0); PG8_BAR; PG8_MMA(1, 0, At, B0); PG8_MMA(1, 1, At, B1); PG8_BAR; PG8_SCHED;
        }
        if (wr == 0) PG8_BAR;
        E(acc, cur, wr, wc, fr, fq, (const LAS float*)(lds + LDS_TBL + (ui & 1) * 1024));
        if (!has_next) break;
#pragma unroll
        for (int a = 0; a < 2; ++a)
#pragma unroll
            for (int b = 0; b < 2; ++b)
#pragma unroll
                for (int m = 0; m < 4; ++m)
#pragma unroll
                    for (int n = 0; n < 2; ++n) acc[a][b][m][n] = (f32x4){0.f, 0.f, 0.f, 0.f};
        cur = nxt; cA = nA; cB = nB; ++ui;
        PG8_RSDMA(cur, ui & 1);
        if (wr == 1) PG8_BAR;
    }
    PG8_WAIT_V(0);
    PG8_BAR;
#undef PG8_RSDMA
#undef PG8_SA
#undef PG8_SB
#undef PG8_STAGE
#undef PG8_LDA
#undef PG8_LDB
#undef PG8_MMA
#undef PG8_WAIT_V
#undef PG8_WAIT_L
#undef PG8_BAR
#undef PG8_SCHED
}

DI unsigned q8(float s) { const float t = fminf(fmaxf(s * 255.0f + 0.5f, 1.0f), 255.0f); return (unsigned)(int)t; }
DI unsigned pk4q8(const f32x4 v) {
    unsigned w = 0u;
    w = __builtin_amdgcn_cvt_pk_u8_f32(fmaxf(__builtin_rintf(v[0] * 255.0f), 1.0f), 0, w); w = __builtin_amdgcn_cvt_pk_u8_f32(fmaxf(__builtin_rintf(v[1] * 255.0f), 1.0f), 1, w);
    w = __builtin_amdgcn_cvt_pk_u8_f32(fmaxf(__builtin_rintf(v[2] * 255.0f), 1.0f), 2, w); w = __builtin_amdgcn_cvt_pk_u8_f32(fmaxf(__builtin_rintf(v[3] * 255.0f), 1.0f), 3, w);
    return w;
}
DI u32x2 packq8(const f32x4 v0, const f32x4 v1) { u32x2 w; w.x = pk4q8(v0); w.y = pk4q8(v1); return w; }
DI void unpackq8(const u32x2 w, f32x4& v0, f32x4& v1) {
    v0 = (f32x4){(float)(w.x & 0xffu), (float)((w.x >> 8) & 0xffu), (float)((w.x >> 16) & 0xffu), (float)(w.x >> 24)};
    v1 = (f32x4){(float)(w.y & 0xffu), (float)((w.y >> 8) & 0xffu), (float)((w.y >> 16) & 0xffu), (float)(w.y >> 24)}; }
DI u32x4 pack8(const f32x4 v0, const f32x4 v1) { u32x4 w; w.x = pk2(v0[0], v0[1]); w.y = pk2(v0[2], v0[3]); w.z = pk2(v1[0], v1[1]); w.w = pk2(v1[2], v1[3]); return w; }
DI void unpack8(const u32x4 w, f32x4& v0, f32x4& v1) { v0 = (f32x4){bflo(w.x), bfhi(w.x), bflo(w.y), bfhi(w.y)}; v1 = (f32x4){bflo(w.z), bfhi(w.z), bflo(w.w), bfhi(w.w)}; }
struct EpiInproj {
    static constexpr bool HOOK = false, RSLDS = true;
    bf16_t* Z; const float* rs; float* part; unsigned char* GT;
    DI void operator()(const f32x4 (&acc)[2][2][4][2], const Unit& u, int wr, int wc, int fr, int fq, const LAS float* rsl) const {
        const int row0 = u.pm * BM + wr * 64 + fr, col0 = u.pn * BM + wc * 32 + 8 * fq;
        const bool gate = u.pn >= C_G / BM;
#pragma unroll
        for (int ai = 0; ai < 2; ++ai)
#pragma unroll
            for (int m = 0; m < 4; ++m) {
                const int row = row0 + ai * HALF + m * 16;
                if (u.ks < 0) {
                    const float s = rsl[wr * 64 + fr + ai * HALF + m * 16];
                    bf16_t* rowp = Z + (size_t)row * ZLD + col0;
                    unsigned char* gq = GT + (((size_t)u.pm * 24 + (u.pn - 26)) * 256 + (row & 255)) * 256 + wc * 32 + 8 * fq;
#pragma unroll
                    for (int bj = 0; bj < 2; ++bj) {
                        f32x4 v0 = acc[ai][bj][m][0] * s, v1 = acc[ai][bj][m][1] * s;
                        if (gate) {
#pragma unroll
                            for (int j = 0; j < 4; ++j) { v0[j] = __builtin_amdgcn_rcpf(1.0f + __expf(-v0[j])); v1[j] = __builtin_amdgcn_rcpf(1.0f + __expf(-v1[j])); }
                            *(u32x2*)(gq + bj * HALF) = packq8(v0, v1);
                        } else *(u32x4*)(rowp + bj * HALF) = pack8(v0, v1);
                    }
                } else {
                    float* pp = part + (((size_t)u.ks * 16 + (u.pn - 26)) * 256 + (row - 71 * BM)) * 256 + wc * 32 + 8 * fq;
#pragma unroll
                    for (int bj = 0; bj < 2; ++bj) { *(f32x4*)(pp + bj * HALF) = acc[ai][bj][m][0]; *(f32x4*)(pp + bj * HALF + 4) = acc[ai][bj][m][1]; }
                }
            }
    }
};
struct EpiUp {
    static constexpr bool HOOK = false, RSLDS = true;
    bf16_t* H; const float* rs;
    DI void operator()(const f32x4 (&acc)[2][2][4][2], const Unit& u, int wr, int wc, int fr, int fq, const LAS float* rsl) const {
        const int row0 = u.pm * BM + wr * 64 + fr, col0 = u.pn * BM + wc * 32 + 8 * fq;
#pragma unroll
        for (int ai = 0; ai < 2; ++ai)
#pragma unroll
            for (int m = 0; m < 4; ++m) {
                const int row = row0 + ai * HALF + m * 16; const float s = rsl[wr * 64 + fr + ai * HALF + m * 16];
                bf16_t* rowp = H + (size_t)row * DFF + col0;
#pragma unroll
                for (int bj = 0; bj < 2; ++bj) {
                    f32x4 v0 = acc[ai][bj][m][0] * s, v1 = acc[ai][bj][m][1] * s;
#pragma unroll
                    for (int j = 0; j < 4; ++j) { v0[j] = fmaxf(v0[j], 0.f); v0[j] *= v0[j]; v1[j] = fmaxf(v1[j], 0.f); v1[j] *= v1[j]; }
                    *(u32x4*)(rowp + bj * HALF) = pack8(v0, v1);
                }
            }
    }
};
struct EpiD {
    static constexpr bool HOOK = true, RSLDS = false;
    const unsigned char* Z; bf16_t* act; float* part;
    DI void hook(f32x4 (&acc)[2][2][4][2], const Unit& u, int r, int wr, int wc, int fr_, int fq_) const {
        int fr = fr_, fq = fq_; asm volatile("" : "+v"(fr), "+v"(fq));
        const int row0 = u.pm * BM + wr * 64 + fr, col0 = u.pn * BM + wc * 32 + 8 * fq;
#pragma unroll
        for (int ai = 0; ai < 2; ++ai) {
#pragma unroll
            for (int m = 0; m < 4; ++m) {
                const unsigned char* gp = Z + (((size_t)u.pm * 24 + (r - 1) * 8 + u.pn) * 256 + (wr * 64 + fr + ai * HALF + m * 16)) * 256 + wc * 32 + 8 * fq;
#pragma unroll
                for (int bj = 0; bj < 2; ++bj) {
                    f32x4 n0, n1, d0, d1; unpackq8(*(const u32x2*)(gp + bj * HALF), n0, n1); unpackq8(*(const u32x2*)(gp + 8 * 65536 + bj * HALF), d0, d1);
#pragma unroll
                    for (int j = 0; j < 4; ++j) { acc[ai][bj][m][0][j] *= n0[j] * __builtin_amdgcn_rcpf(d0[j]); acc[ai][bj][m][1][j] *= n1[j] * __builtin_amdgcn_rcpf(d1[j]); }
                }
            }
            asm volatile("" : "+v"(acc[ai][0][0][0]), "+v"(acc[ai][0][1][0]), "+v"(acc[ai][0][2][0]), "+v"(acc[ai][0][3][0]), "+v"(acc[ai][1][0][0]), "+v"(acc[ai][1][1][0]), "+v"(acc[ai][1][2][0]), "+v"(acc[ai][1][3][0]));
        }
    }
    DI void operator()(const f32x4 (&acc)[2][2][4][2], const Unit& u, int wr, int wc, int fr, int fq, const LAS float* rsl) const {
        const int row0 = u.pm * BM + wr * 64 + fr, col0 = u.pn * BM + wc * 32 + 8 * fq;
        const int r = u.ks < 0 ? 2 : u.ks;
#pragma unroll
        for (int ai = 0; ai < 2; ++ai)
#pragma unroll
            for (int m = 0; m < 4; ++m) {
                const int row = row0 + ai * HALF + m * 16;
                const unsigned char* gp = Z + (((size_t)u.pm * 24 + r * 8 + u.pn) * 256 + (row & 255)) * 256 + wc * 32 + 8 * fq;
#pragma unroll
                for (int bj = 0; bj < 2; ++bj) {
                    f32x4 s0, s1; unpackq8(*(const u32x2*)(gp + bj * HALF), s0, s1);
                    const f32x4 v0 = acc[ai][bj][m][0] * (s0 * (1.0f / 255.0f)), v1 = acc[ai][bj][m][1] * (s1 * (1.0f / 255.0f));
                    if (u.ks < 0) *(u32x4*)(act + (size_t)row * DM + col0 + bj * HALF) = pack8(v0, v1);
                    else { float* pp = part + ((size_t)u.ks * MS + (row - MP)) * DM + col0 + bj * HALF; *(f32x4*)pp = v0; *(f32x4*)(pp + 4) = v1; }
                }
            }
    }
};
template <bool XF32> struct EpiRes {
    static constexpr bool HOOK = false, RSLDS = false;
    const float* Xin; bf16_t* act; float* ssq; float* part;
    DI void operator()(const f32x4 (&acc)[2][2][4][2], const Unit& u, int wr, int wc, int fr, int fq, const LAS float* rsl) const {
        const int row0 = u.pm * BM + wr * 64 + fr, col0 = u.pn * BM + wc * 32 + 8 * fq;
        u32x4 xin[2][4][2];
        if (!XF32 && u.ks < 0) {
#pragma unroll
            for (int ai = 0; ai < 2; ++ai)
#pragma unroll
                for (int m = 0; m < 4; ++m)
#pragma unroll
                    for (int bj = 0; bj < 2; ++bj) xin[ai][m][bj] = *(const u32x4*)(act + (size_t)(row0 + ai * HALF + m * 16) * DM + col0 + bj * HALF);
        }
#pragma unroll
        for (int ai = 0; ai < 2; ++ai)
#pragma unroll
            for (int m = 0; m < 4; ++m) {
                const int row = row0 + ai * HALF + m * 16;
                if (u.ks < 0) {
                    const size_t off = (size_t)row * DM + col0; float sq = 0.f;
#pragma unroll
                    for (int bj = 0; bj < 2; ++bj) {
                        f32x4 x0, x1;
                        if (XF32) { x0 = *(const f32x4*)(Xin + off + bj * HALF); x1 = *(const f32x4*)(Xin + off + bj * HALF + 4); }
                        else unpack8(xin[ai][m][bj], x0, x1);
                        x0 += acc[ai][bj][m][0]; x1 += acc[ai][bj][m][1];
                        *(u32x4*)(act + off + bj * HALF) = pack8(x0, x1);
                        sq += (x0[0] * x0[0] + x0[1] * x0[1]) + (x0[2] * x0[2] + x0[3] * x0[3]) + (x1[0] * x1[0] + x1[1] * x1[1]) + (x1[2] * x1[2] + x1[3] * x1[3]);
                    }
                    sq += __shfl_xor(sq, 16); sq += __shfl_xor(sq, 32);
                    if (fq == 0) ssq[(size_t)row * 32 + u.pn * 4 + wc] = sq;
                } else {
#pragma unroll
                    for (int bj = 0; bj < 2; ++bj) { float* pp = part + ((size_t)u.ks * MS + (row - MP)) * DM + col0 + bj * HALF; *(f32x4*)pp = acc[ai][bj][m][0]; *(f32x4*)(pp + 4) = acc[ai][bj][m][1]; }
                }
            }
    }
};
}

DI void tr_item(const float* src, size_t sld, bf16_t* dst, size_t dld, const float* ksc, LAS unsigned* scr, int lane) {
    const int ng = lane & 15, kq = lane >> 4;
#pragma unroll
    for (int i = 0; i < 8; ++i) {
        const int k = 8 * i + 2 * kq;
        f32x4 a = *(const f32x4*)(src + (size_t)k * sld + 4 * ng);
        f32x4 b = *(const f32x4*)(src + (size_t)(k + 1) * sld + 4 * ng);
        if (ksc) { a *= ksc[k]; b *= ksc[k + 1]; }
        LAS unsigned* d = scr + (4 * ng) * 33 + 4 * i + kq;
        d[0] = pk2(a[0], b[0]); d[33] = pk2(a[1], b[1]); d[66] = pk2(a[2], b[2]); d[99] = pk2(a[3], b[3]);
    }
    asm volatile("s_waitcnt lgkmcnt(0)" ::: "memory");
#pragma unroll
    for (int j = 0; j < 8; ++j) {
        const int n = (lane >> 3) + 8 * j, c = lane & 7;
        const LAS unsigned* s = scr + n * 33 + 4 * c;
        u32x4 o; o.x = s[0]; o.y = s[1]; o.z = s[2]; o.w = s[3];
        *(u32x4*)(dst + (size_t)n * dld + 8 * c) = o;
    }
    asm volatile("s_waitcnt lgkmcnt(0)" ::: "memory");
}

struct Ctx {
    LAS unsigned char* lds;
    int tid, lane, wave, bid, G;
};
DI Ctx make_ctx(LAS unsigned char* lds) { Ctx c; c.lds = lds; c.tid = launder_tid(); c.lane = c.tid & 63; c.wave = __builtin_amdgcn_readfirstlane(c.tid >> 6); c.bid = blockIdx.x; c.G = gridDim.x; return c; }

DI void conv_matrix_item(const float* W, int K, int N, bf16_t* Wt, const float* ksc, int item, LAS unsigned* scr, int lane) {
    const int nb = N >> 6, kb = item / nb, nn = item - kb * nb;
    tr_item(W + (size_t)kb * 64 * N + nn * 64, (size_t)N, Wt + (size_t)nn * 64 * K + kb * 64, (size_t)K, ksc ? ksc + kb * 64 : nullptr, scr, lane);
}
DI void phase_prologue(const Ctx& c) {
    LAS unsigned* scr = (LAS unsigned*)(c.lds + c.wave * 16384);
    const int gw = c.bid * NWAVES + c.wave, NGW = c.G * NWAVES;
    constexpr int I_IN = 32 * 200, I_BR = 16 * 32, I_OUT = 32 * 32, I_UP = 32 * 128, I_DN = 128 * 32, I_LRU = 4, I_L = I_IN + 3 * I_BR + I_OUT + I_UP + I_DN + 16 * I_LRU;
    bf16_t* Wall = (bf16_t*)(kws() + WS_W); bf16_t* lruw = (bf16_t*)(kws() + WS_LRUW);
    for (int it = gw; it < DEPTH * I_L; it += NGW) {
        const int l = it / I_L; int r = it - l * I_L;
        bf16_t* Wl = Wall + (size_t)l * WL_SIZE;
        if (r < I_IN) { conv_matrix_item(kin<9>() + (size_t)l * DM * DIN, DM, DIN, Wl + WL_IN, kin<8>() + l * DM, r, scr, c.lane); continue; } r -= I_IN;
        if (r < 3 * I_BR) { const int b = r / I_BR, it2 = r - b * I_BR, kb = it2 / (DM / 64), nn = it2 - kb * (DM / 64);
            tr_item(kin<19>() + ((size_t)l * 3 + b) * BW * DM + (size_t)kb * 64 * DM + nn * 64, (size_t)DM, Wl + WL_BR + (size_t)nn * 64 * (3 * BW) + b * BW + kb * 64, (size_t)(3 * BW), nullptr, scr, c.lane); continue; } r -= 3 * I_BR;
        if (r < I_OUT) { conv_matrix_item(kin<20>() + (size_t)l * DM * DM, DM, DM, Wl + WL_OUT, nullptr, r, scr, c.lane); continue; } r -= I_OUT;
        if (r < I_UP) { conv_matrix_item(kin<22>() + (size_t)l * DM * DFF, DM, DFF, Wl + WL_UP, kin<21>() + l * DM, r, scr, c.lane); continue; } r -= I_UP;
        if (r < I_DN) { conv_matrix_item(kin<23>() + (size_t)l * DFF * DM, DFF, DM, Wl + WL_DOWN, nullptr, r, scr, c.lane); continue; } r -= I_DN;
        { const int wsel = r / (8 * I_LRU), rr = r - wsel * 8 * I_LRU, blk = rr / I_LRU, sub = rr - blk * I_LRU;
          conv_matrix_item((wsel ? kin<14>() : kin<12>()) + ((size_t)l * 8 + blk) * 16384, 128, 128, lruw + (((size_t)l * 2 + wsel) * 8 + blk) * 16384, nullptr, sub, scr, c.lane); }
    }
}

DI void phase_norm(const Ctx& c, const float* xP, const float* xS) {
    const int gw = c.bid * NWAVES + c.wave, NGW = c.G * NWAVES;
    bf16_t* act = (bf16_t*)(kws() + WS_ACT); float* rs = (float*)(kws() + WS_RS);
    for (int row = gw; row < M; row += NGW) {
        const f32x4* xr = (const f32x4*)((row < MP ? xP : xS) + (size_t)row * DM) + c.lane;
        f32x4 v[8]; float s = 0.f;
#pragma unroll
        for (int j = 0; j < 8; ++j) { v[j] = xr[64 * j]; s += (v[j][0] * v[j][0] + v[j][1] * v[j][1]) + (v[j][2] * v[j][2] + v[j][3] * v[j][3]); }
        s = wave_sum(s);
        if (c.lane == 0) rs[row] = 1.0f / sqrtf(s * (1.0f / DM) + EPS);
        u32x2* o = (u32x2*)(act + (size_t)row * DM) + c.lane;
#pragma unroll
        for (int j = 0; j < 8; ++j) { u32x2 w; w.x = pk2(v[j][0], v[j][1]); w.y = pk2(v[j][2], v[j][3]); o[64 * j] = w; }
    }
}
DI void phase_final(const Ctx& c) {
    const int gw = c.bid * NWAVES + c.wave, NGW = c.G * NWAVES;
    const f32x4* gp = (const f32x4*)kin<24>() + c.lane; const float* rs = (const float*)(kws() + WS_RS); const bf16_t* act = (const bf16_t*)(kws() + WS_ACT);
    f32x4 gv[8];
#pragma unroll
    for (int j = 0; j < 8; ++j) gv[j] = gp[64 * j];
    for (int row = gw; row < M; row += NGW) {
        f32x4* yr = (f32x4*)(kout() + (size_t)row * DM) + c.lane; const u32x2* xr = (const u32x2*)(act + (size_t)row * DM) + c.lane; const float r = rs[row];
#pragma unroll
        for (int j = 0; j < 8; ++j) { const u32x2 w = xr[64 * j]; yr[64 * j] = (f32x4){bflo(w.x), bfhi(w.x), bflo(w.y), bfhi(w.y)} * r * gv[j]; }
    }
}
DI void cvt_f32_bf16(const float* s, bf16_t* d, size_t n8, size_t gt, size_t NT) {
    for (size_t i = gt; i < n8; i += NT) { const f32x4 a = ((const f32x4*)s)[2 * i], b = ((const f32x4*)s)[2 * i + 1]; u32x4 w; w.x = pk2(a[0], a[1]); w.y = pk2(a[2], a[3]); w.z = pk2(b[0], b[1]); w.w = pk2(b[2], b[3]); ((u32x4*)d)[i] = w; }
}
DI void phase_cacheconv(const Ctx& c, int l, int pidx, int pcount) {
    const size_t gt = (size_t)pidx * NTHR + c.tid, NT = (size_t)pcount * NTHR;
    cvt_f32_bf16(kin<4>() + (size_t)l * 32 * 128 * 256, (bf16_t*)(kws() + WS_KCB), (size_t)32 * 128 * 256 / 8, gt, NT);
    cvt_f32_bf16(kin<5>() + (size_t)l * 32 * 128 * 256, (bf16_t*)(kws() + WS_VTCB), (size_t)32 * 128 * 256 / 8, gt, NT);
    cvt_f32_bf16(kin<6>() + (size_t)l * 32 * 512 * 1024, (bf16_t*)(kws() + WS_KCC), (size_t)32 * 512 * 1024 / 8, gt, NT);
    cvt_f32_bf16(kin<7>() + (size_t)l * 32 * 512 * 1024, (bf16_t*)(kws() + WS_VTCC), (size_t)32 * 512 * 1024 / 8, gt, NT);
}

DI void lru_local_phase(const Ctx& c, int l) {
    LAS float* uf = (LAS float*)c.lds;
    LAS unsigned char* ub = c.lds + 33792;
    LAS float* sa = (LAS float*)(c.lds + 33792 + 17408);
    LAS float* sb = sa + 8192;
    LAS float* tot = sb + 8192;
    const bf16_t* Z = (const bf16_t*)(kws() + WS_Z);
    const int nunits = NCHUNK * 8;
    int u = c.bid; if (u >= nunits) return;
    const int cg = c.tid & 15, tk = c.tid >> 4;
    const int fr = c.lane & 15, fq = c.lane >> 4, w = c.wave;
    const int chl = c.tid & 127, q = c.tid >> 7;
    int nblk_cur = -1;
    LAS float* cwl = tot + 1024;
    bf16x8 bwa[4], bwx[4]; float ba = 0.f, bx = 0.f, c8 = 0.f;
    u32x4 pre[2][4];
#define LRU_PREFETCH(uu) do { const int chunk_ = (uu) >> 3, nb_ = (uu) & 7; const bool smp_ = chunk_ >= 256, first_ = !smp_ && (chunk_ & 127) == 0; \
        _Pragma("unroll") for (int hh = 0; hh < 2; ++hh) _Pragma("unroll") for (int k = 0; k < 4; ++k) { const int ts = tk + 32 * hh - 3 + k; \
            if (ts >= 0 || (!smp_ && !first_)) pre[hh][k] = *(const u32x4*)(Z + (size_t)(chunk_ * 64 + ts) * ZLD + C_AX + nb_ * 128 + 8 * cg); } } while (0)
    LRU_PREFETCH(u);
    for (; u < nunits; u += c.G) {
        const int chunk = u >> 3, nblk = u & 7;
        const int row0 = chunk * 64, ch0 = nblk * 128; const bool smp = chunk >= 256; const bool first = !smp && (chunk & 127) == 0; const int bs = chunk - 256;
        if (nblk != nblk_cur) {
            nblk_cur = nblk;
            __syncthreads();
            for (int i = c.tid; i < 640; i += NTHR) { const int k = i >> 7, cc = i & 127; cwl[i] = k < 4 ? kin<10>()[(size_t)l * 4 * 1024 + k * 1024 + ch0 + cc] : kin<11>()[(size_t)l * 1024 + ch0 + cc]; }
            __syncthreads();
            const bf16_t* wat = (const bf16_t*)(kws() + WS_LRUW) + (((size_t)l * 2 + 0) * 8 + nblk) * 16384 + (size_t)(16 * w + fr) * 128 + 8 * fq;
            const bf16_t* wxt = wat + (size_t)8 * 16384;
#pragma unroll
            for (int ks = 0; ks < 4; ++ks) { bwa[ks] = *(const bf16x8*)(wat + 32 * ks); bwx[ks] = *(const bf16x8*)(wxt + 32 * ks); }
            const int ch = ch0 + 16 * w + fr;
            ba = kin<13>()[(size_t)l * 1024 + ch]; bx = kin<15>()[(size_t)l * 1024 + ch]; c8 = 8.0f * log1pf(expf(-kin<16>()[(size_t)l * 1024 + ch]));
        }
#pragma unroll
        for (int hh = 0; hh < 2; ++hh) {
            const int tt = tk + 32 * hh;
            f32x4 a0 = *(const LAS f32x4*)(cwl + 512 + 8 * cg), a1 = *(const LAS f32x4*)(cwl + 512 + 8 * cg + 4);
#pragma unroll
            for (int k = 0; k < 4; ++k) {
                const int ts = tt - 3 + k;
                f32x4 x0, x1;
                if (ts >= 0 || (!smp && !first)) { const u32x4 v = pre[hh][k];
                    x0 = (f32x4){bflo(v.x), bfhi(v.x), bflo(v.y), bfhi(v.y)}; x1 = (f32x4){bflo(v.z), bfhi(v.z), bflo(v.w), bfhi(v.w)};
                } else if (smp) {
                    const float* sp = kin<2>() + (((size_t)l * 32 + bs) * 3 + (3 + ts)) * 1024 + ch0 + 8 * cg;
                    x0 = *(const f32x4*)sp; x1 = *(const f32x4*)(sp + 4);
                } else { x0 = (f32x4){0.f, 0.f, 0.f, 0.f}; x1 = x0; }
                a0 += *(const LAS f32x4*)(cwl + k * 128 + 8 * cg) * x0; a1 += *(const LAS f32x4*)(cwl + k * 128 + 8 * cg + 4) * x1;
            }
            *(LAS f32x4*)(uf + tt * 132 + 8 * cg) = a0; *(LAS f32x4*)(uf + tt * 132 + 8 * cg + 4) = a1;
            u32x4 pw; pw.x = pk2(a0[0], a0[1]); pw.y = pk2(a0[2], a0[3]); pw.z = pk2(a1[0], a1[1]); pw.w = pk2(a1[2], a1[3]);
            *(LAS u32x4*)(ub + tt * 272 + 16 * cg) = pw;
        }
        if (u + c.G < nunits) LRU_PREFETCH(u + c.G);
        __syncthreads();
        {
            f32x4 ar[4], ai[4];
#pragma unroll
            for (int mt = 0; mt < 4; ++mt) { ar[mt] = (f32x4){0.f, 0.f, 0.f, 0.f}; ai[mt] = ar[mt]; }
#pragma unroll
            for (int ks = 0; ks < 4; ++ks)
#pragma unroll
                for (int mt = 0; mt < 4; ++mt) {
                    const bf16x8 af = *(const LAS bf16x8*)(ub + (mt * 16 + fr) * 272 + (ks * 32 + fq * 8) * 2);
                    ar[mt] = __builtin_amdgcn_mfma_f32_16x16x32_bf16(af, bwa[ks], ar[mt], 0, 0, 0);
                    ai[mt] = __builtin_amdgcn_mfma_f32_16x16x32_bf16(af, bwx[ks], ai[mt], 0, 0, 0);
                }
            const int chw = 16 * w + fr;
#pragma unroll
            for (int mt = 0; mt < 4; ++mt)
#pragma unroll
                for (int j = 0; j < 4; ++j) {
                    const int tok = mt * 16 + fq * 4 + j;
                    const float r = __builtin_amdgcn_rcpf(1.0f + __expf(-(ar[mt][j] + ba))), ig = __builtin_amdgcn_rcpf(1.0f + __expf(-(ai[mt][j] + bx)));
                    const float la = -c8 * r, a = __expf(la), x2 = 2.0f * la;
                    const float omt = -x2 * (1.0f + x2 * (0.5f + x2 * (0.16666667f + x2 * (0.041666668f + x2 * (0.0083333338f + x2 * 0.0013888889f)))));
                    const float om = x2 > -0.25f ? omt : 1.0f - a * a;
                    const float bb = __builtin_amdgcn_sqrtf(om) * (ig * uf[tok * 132 + chw]);
                    sa[tok * 128 + chw] = a; sb[tok * 128 + chw] = bb;
                }
        }
        __syncthreads();
        {
            float h = (smp && q == 0) ? kin<3>()[((size_t)l * 32 + bs) * 1024 + ch0 + chl] : 0.f, A = 1.f;
#pragma unroll 4
            for (int t = 16 * q; t < 16 * q + 16; ++t) { const float a = sa[t * 128 + chl], b = sb[t * 128 + chl]; h = a * h + b; A *= a; sb[t * 128 + chl] = h; sa[t * 128 + chl] = A; }
            tot[(q * 128 + chl) * 2] = A; tot[(q * 128 + chl) * 2 + 1] = h;
        }
        __syncthreads();
        {
            float cin = 0.f, Apre = 1.f;
            for (int qq = 0; qq < q; ++qq) { const float A = tot[(qq * 128 + chl) * 2], h = tot[(qq * 128 + chl) * 2 + 1]; cin = A * cin + h; Apre *= A; }
            unsigned* hc = (unsigned*)(kws() + WS_R1) + (size_t)row0 * 1024 + ch0 + chl;
            float h = 0.f, A = 1.f;
#pragma unroll 4
            for (int t = 16 * q; t < 16 * q + 16; ++t) { h = sb[t * 128 + chl] + sa[t * 128 + chl] * cin; A = sa[t * 128 + chl] * Apre; hc[(size_t)t * 1024] = pk2(h, A); }
            if (q == 3) { f32x2 ag = {A, h}; *(f32x2*)((float*)(kws() + WS_AGG) + ((size_t)chunk * 1024 + ch0 + chl) * 2) = ag; }
        }
        __syncthreads();
    }
#undef LRU_PREFETCH
}

DI void lru_fix_unit(const Ctx& c, int l, int chunk, int half) {
    const int cg4 = c.tid & 127, tq = c.tid >> 7, ch = half * 512 + 4 * cg4; const bool smp = chunk >= 256; const int n = smp ? 0 : (chunk & 127);
    f32x4 cr = {0.f, 0.f, 0.f, 0.f};
    const f32x4* ag = (const f32x4*)((const float*)(kws() + WS_AGG) + ((size_t)(chunk - n) * 1024 + ch) * 2);
    int i = 0;
    for (; i + 8 <= n; i += 8) {
        f32x4 a[8][2];
#pragma unroll
        for (int j = 0; j < 8; ++j) { a[j][0] = ag[(size_t)(i + j) * 512]; a[j][1] = ag[(size_t)(i + j) * 512 + 1]; }
#pragma unroll
        for (int j = 0; j < 8; ++j) { cr[0] = a[j][0][0] * cr[0] + a[j][0][1]; cr[1] = a[j][0][2] * cr[1] + a[j][0][3]; cr[2] = a[j][1][0] * cr[2] + a[j][1][1]; cr[3] = a[j][1][2] * cr[3] + a[j][1][3]; }
    }
    for (; i < n; ++i) { const f32x4 a0 = ag[(size_t)i * 512], a1 = ag[(size_t)i * 512 + 1]; cr[0] = a0[0] * cr[0] + a0[1]; cr[1] = a0[2] * cr[1] + a0[3]; cr[2] = a1[0] * cr[2] + a1[1]; cr[3] = a1[2] * cr[3] + a1[3]; }
    const unsigned* hc = (const unsigned*)(kws() + WS_R1) + (size_t)(chunk * 64 + tq) * 1024 + ch;
    const bf16_t* zg = (const bf16_t*)(kws() + WS_Z) + (size_t)(chunk * 64 + tq) * ZLD + C_AG + ch;
    bf16_t* br = (bf16_t*)(kws() + WS_BR) + (size_t)(chunk * 64 + tq) * 3072 + ch;
    u32x4 hv[16]; u32x2 gv[16];
#pragma unroll
    for (int k = 0; k < 16; ++k) { hv[k] = *(const u32x4*)(hc + (size_t)(4 * k) * 1024); gv[k] = *(const u32x2*)(zg + (size_t)(4 * k) * ZLD); }
    f32x4 h = {0.f, 0.f, 0.f, 0.f};
#pragma unroll
    for (int k = 0; k < 16; ++k) {
        h[0] = bflo(hv[k].x) + bfhi(hv[k].x) * cr[0]; h[1] = bflo(hv[k].y) + bfhi(hv[k].y) * cr[1]; h[2] = bflo(hv[k].z) + bfhi(hv[k].z) * cr[2]; h[3] = bflo(hv[k].w) + bfhi(hv[k].w) * cr[3];
        u32x2 w; w.x = pk2(h[0] * gelu_tanh(bflo(gv[k].x)), h[1] * gelu_tanh(bfhi(gv[k].x))); w.y = pk2(h[2] * gelu_tanh(bflo(gv[k].y)), h[3] * gelu_tanh(bfhi(gv[k].y)));
        *(u32x2*)(br + (size_t)(4 * k) * 3072) = w;
    }
    if (tq == 3) {
        if (smp) *(f32x4*)(kout() + O_SLRU + ((size_t)l * 32 + (chunk - 256)) * 1024 + ch) = h;
        else if (n == 127) *(f32x4*)(kout() + O_PLRU + ((size_t)l * 2 + (chunk >> 7)) * 1024 + ch) = h;
    }
}

#define MFMA32(a, b, cc) __builtin_amdgcn_mfma_f32_32x32x16_bf16((a), (b), (cc), 0, 0, 0)
typedef short s16x4 __attribute__((ext_vector_type(4)));
template <int MODE, class Src>
DI void attn_item(LAS unsigned char* lds, const Src& src, const bf16_t* Qp  , bf16_t* Op  , int nband, int jj0, float sink_l2, const LAS float* tbl, int qbase, int tid) {
    constexpr int NT = MODE ? 4 : 1, NL = 2 * NT;
    const int lane = tid & 63, w = __builtin_amdgcn_readfirstlane(tid >> 6), r = lane & 31, h = lane >> 5;
    const int hl = MODE ? (w >> 1) : 0;
    const int lq = lane >> 4, chp = lane & 15;
#define ATT_ISSUE(jj_, isV_) do { _Pragma("unroll") for (int i_ = 0; i_ < NL; ++i_) { \
        const int t_ = MODE ? (w >> 1) : 0, rowb_ = MODE ? ((w & 1) * 32 + 4 * i_) : (8 * w + 4 * i_); \
        const int row_ = rowb_ + lq, ch_ = chp ^ ((lq << 2) | ((rowb_ >> 2) & 3)); \
        const bf16_t* base_; int st_; src.get((jj_), t_, (isV_), base_, st_); \
        __builtin_amdgcn_global_load_lds((const unsigned*)(base_ + (size_t)row_ * st_ + ch_ * 8), (LAS unsigned*)(lds + ((isV_) ? 65536 : 0) + t_ * 16384 + rowb_ * 256), 16, 0, 0); } } while (0)
    bf16x8 qf[8];
#pragma unroll
    for (int ks = 0; ks < 8; ++ks) qf[ks] = *(const bf16x8*)(Qp + (size_t)r * ZLD + ks * 16 + h * 8);
    f32x16 o[4];
#pragma unroll
    for (int db = 0; db < 4; ++db)
#pragma unroll
        for (int i = 0; i < 16; ++i) o[db][i] = 0.f;
    float mrun = MODE == 0 ? sink_l2 : -1e30f, lrun = MODE == 0 ? 1.f : 0.f;
    const float sc = 0.08838834764831845f * LOG2E;
    const LAS unsigned char* Kt = lds + hl * 16384 + 256 * r;
    const int kx = 16 * (h ^ (((r & 3) << 2) | ((r >> 2) & 3)));
    const int blk = (lane >> 4) & 1, q = (lane & 15) >> 2, p = lane & 3;
    const LAS unsigned char* Vt = lds + 65536 + hl * 16384 + 256 * (4 * h + q) + 8 * (p & 1);
    const int vlo = 2 * blk + (p >> 1);
    ATT_ISSUE(jj0, false); ATT_ISSUE(jj0, true);
    for (int jj = jj0; jj < nband; ++jj) {
        const bool last = (jj == nband - 1);
        if (MODE) asm volatile("s_waitcnt vmcnt(8)" ::: "memory"); else asm volatile("s_waitcnt vmcnt(2)" ::: "memory");
        __builtin_amdgcn_s_barrier(); asm volatile("" ::: "memory");
        f32x16 s[2];
#pragma unroll
        for (int kb = 0; kb < 2; ++kb) {
#pragma unroll
            for (int i = 0; i < 16; ++i) s[kb][i] = 0.f;
#pragma unroll
            for (int ks = 0; ks < 8; ++ks) { const bf16x8 kf = *(const LAS bf16x8*)(Kt + 8192 * kb + ((32 * ks) ^ kx)); s[kb] = MFMA32(kf, qf[ks], s[kb]); }
        }
        asm volatile("s_waitcnt lgkmcnt(0)" ::: "memory"); __builtin_amdgcn_s_barrier(); asm volatile("" ::: "memory");
        if (!last) ATT_ISSUE(jj + 1, false);
#pragma unroll
        for (int kb = 0; kb < 2; ++kb) {
            if (MODE == 1) {
                if (jj <= 5) { const float bc = tbl[256];
#pragma unroll
                    for (int i = 0; i < 16; ++i) s[kb][i] = s[kb][i] * sc + bc;
                } else {
                    const int dbase = qbase + r - kb * 32 - 4 * h + (8 - jj) * 64 + 128;
#pragma unroll
                    for (int i = 0; i < 16; ++i) { int idx = dbase - ((i & 3) + 8 * (i >> 2)); idx = idx > 256 ? 256 : idx; idx = idx < 0 ? 0 : idx; s[kb][i] = s[kb][i] * sc + tbl[idx]; }
                }
            } else {
#pragma unroll
                for (int i = 0; i < 16; ++i) s[kb][i] *= sc;
            }
        }
        float bm = fmaxf(s[0][0], s[1][0]);
#pragma unroll
        for (int i = 1; i < 16; ++i) bm = fmaxf(bm, fmaxf(s[0][i], s[1][i]));
        bm = fmaxf(bm, __shfl_xor(bm, 32));
        if (__builtin_amdgcn_ballot_w64(bm > mrun + 8.0f) != 0ull) {
            const float mnew = fmaxf(mrun, bm), alpha = __builtin_amdgcn_exp2f(mrun - mnew);
            lrun *= alpha; mrun = mnew;
#pragma unroll
            for (int db = 0; db < 4; ++db)
#pragma unroll
                for (int i = 0; i < 16; ++i) o[db][i] *= alpha;
        }
        float ps = 0.f;
#pragma unroll
        for (int kb = 0; kb < 2; ++kb)
#pragma unroll
            for (int i = 0; i < 16; ++i) { s[kb][i] = __builtin_amdgcn_exp2f(s[kb][i] - mrun); ps += s[kb][i]; }
        ps += __shfl_xor(ps, 32);
        lrun += ps;
        if (last) asm volatile("s_waitcnt vmcnt(0)" ::: "memory"); else { if (MODE) asm volatile("s_waitcnt vmcnt(8)" ::: "memory"); else asm volatile("s_waitcnt vmcnt(2)" ::: "memory"); }
        __builtin_amdgcn_s_barrier(); asm volatile("" ::: "memory");
#pragma unroll
        for (int kb = 0; kb < 2; ++kb)
#pragma unroll
            for (int st = 0; st < 2; ++st) {
                u32x4 pp; pp.x = pk2(s[kb][8 * st + 0], s[kb][8 * st + 1]); pp.y = pk2(s[kb][8 * st + 2], s[kb][8 * st + 3]); pp.z = pk2(s[kb][8 * st + 4], s[kb][8 * st + 5]); pp.w = pk2(s[kb][8 * st + 6], s[kb][8 * st + 7]);
                const bf16x8 pf = __builtin_bit_cast(bf16x8, pp);
#pragma unroll
                for (int db = 0; db < 4; ++db) {
                    s16x4 v2[2];
#pragma unroll
                    for (int t = 0; t < 2; ++t) {
                        const int f = (q << 2) | ((2 * t + h) & 3);
                        v2[t] = __builtin_amdgcn_ds_read_tr16_b64_v4i16((LAS s16x4*)(Vt + 256 * (32 * kb + 16 * st + 8 * t) + 16 * ((4 * db + vlo) ^ f)));
                    }
                    const bf16x8 vf = __builtin_shufflevector(v2[0], v2[1], 0, 1, 2, 3, 4, 5, 6, 7);
                    o[db] = MFMA32(vf, pf, o[db]);
                }
            }
        asm volatile("s_waitcnt lgkmcnt(0)" ::: "memory"); __builtin_amdgcn_s_barrier(); asm volatile("" ::: "memory");
        if (!last) ATT_ISSUE(jj + 1, true);
    }
#undef ATT_ISSUE
    const float inv = 1.0f / lrun;
#pragma unroll
    for (int db = 0; db < 4; ++db)
#pragma unroll
        for (int g = 0; g < 4; ++g) {
            u32x2 wv; wv.x = pk2(o[db][4 * g] * inv, o[db][4 * g + 1] * inv); wv.y = pk2(o[db][4 * g + 2] * inv, o[db][4 * g + 3] * inv);
            *(u32x2*)(Op + (size_t)r * 3072 + db * 32 + 8 * g + 4 * h) = wv;
        }
}
DI void attn_quad(LAS unsigned char* lds, const bf16_t* Z, bf16_t* BR, int c0  , int head, const LAS float* tbl, int tid) {
    const int lane = tid & 63, w = __builtin_amdgcn_readfirstlane(tid >> 6), r = lane & 31, h = lane >> 5;
    const int qc = w >> 1, qh = w & 1;
    const int lq = lane >> 4, chp = lane & 15;
    const int n0 = c0 & 127, j0 = n0 < 8 ? 8 - n0 : 0;
    const bf16_t* Qp = Z + (size_t)((c0 + qc) * 64 + qh * 32) * ZLD + C_QC + head * 128;
    bf16_t* Op = BR + (size_t)((c0 + qc) * 64 + qh * 32) * 3072 + 2048 + head * 128;
#define AQ_ISSUE(j_) do { const bf16_t* kb_ = Z + (size_t)(c0 - 8 + (j_)) * 64 * ZLD + C_KC + head * 128; LAS unsigned char* st_ = lds + ((j_) & 3) * 32768; \
        _Pragma("unroll") for (int i_ = 0; i_ < 2; ++i_) { const int rowb_ = 8 * w + 4 * i_, row_ = rowb_ + lq, ch_ = chp ^ ((lq << 2) | ((rowb_ >> 2) & 3)); \
            __builtin_amdgcn_global_load_lds((const unsigned*)(kb_ + (size_t)row_ * ZLD + ch_ * 8), (LAS unsigned*)(st_ + rowb_ * 256), 16, 0, 0); \
            __builtin_amdgcn_global_load_lds((const unsigned*)(kb_ + (C_VC - C_KC) + (size_t)row_ * ZLD + ch_ * 8), (LAS unsigned*)(st_ + 16384 + rowb_ * 256), 16, 0, 0); } } while (0)
    bf16x8 qf[8];
#pragma unroll
    for (int ks = 0; ks < 8; ++ks) qf[ks] = *(const bf16x8*)(Qp + (size_t)r * ZLD + ks * 16 + h * 8);
    f32x16 o[4];
#pragma unroll
    for (int db = 0; db < 4; ++db)
#pragma unroll
        for (int i = 0; i < 16; ++i) o[db][i] = 0.f;
    float mrun = -1e30f, lrun = 0.f;
    const float sc = 0.08838834764831845f * LOG2E;
    const int kx = 16 * (h ^ (((r & 3) << 2) | ((r >> 2) & 3)));
    const int blk = (lane >> 4) & 1, q = (lane & 15) >> 2, p = lane & 3;
    const int vlo = 2 * blk + (p >> 1);
    const int qbase = qh * 32;
    AQ_ISSUE(j0); if (j0 + 1 < 12) AQ_ISSUE(j0 + 1); if (j0 + 2 < 12) AQ_ISSUE(j0 + 2);
    for (int j = j0; j < 12; ++j) {
        if (j + 2 < 12) asm volatile("s_waitcnt vmcnt(8)" ::: "memory"); else if (j + 1 < 12) asm volatile("s_waitcnt vmcnt(4)" ::: "memory"); else asm volatile("s_waitcnt vmcnt(0)" ::: "memory");
        asm volatile("s_waitcnt lgkmcnt(0)" ::: "memory"); __builtin_amdgcn_s_barrier(); asm volatile("" ::: "memory");
        if (j + 3 < 12) AQ_ISSUE(j + 3);
        const int jj = j - qc;
        if (jj < 0 || jj > 8) continue;
        const LAS unsigned char* Kt = lds + (j & 3) * 32768 + 256 * r;
        const LAS unsigned char* Vt = lds + (j & 3) * 32768 + 16384 + 256 * (4 * h + q) + 8 * (p & 1);
        f32x16 s[2];
#pragma unroll
        for (int kb = 0; kb < 2; ++kb) {
#pragma unroll
            for (int i = 0; i < 16; ++i) s[kb][i] = 0.f;
#pragma unroll
            for (int ks = 0; ks < 8; ++ks) { const bf16x8 kf = *(const LAS bf16x8*)(Kt + 8192 * kb + ((32 * ks) ^ kx)); s[kb] = MFMA32(kf, qf[ks], s[kb]); }
        }
#pragma unroll
        for (int kb = 0; kb < 2; ++kb) {
            if (jj <= 5) { const float bc = tbl[256];
#pragma unroll
                for (int i = 0; i < 16; ++i) s[kb][i] = s[kb][i] * sc + bc;
            } else {
                const int dbase = qbase + r - kb * 32 - 4 * h + (8 - jj) * 64 + 128;
#pragma unroll
                for (int i = 0; i < 16; ++i) { int idx = dbase - ((i & 3) + 8 * (i >> 2)); idx = idx > 256 ? 256 : idx; idx = idx < 0 ? 0 : idx; s[kb][i] = s[kb][i] * sc + tbl[idx]; }
            }
        }
        float bm = fmaxf(s[0][0], s[1][0]);
#pragma unroll
        for (int i = 1; i < 16; ++i) bm = fmaxf(bm, fmaxf(s[0][i], s[1][i]));
        bm = fmaxf(bm, __shfl_xor(bm, 32));
        if (__builtin_amdgcn_ballot_w64(bm > mrun + 8.0f) != 0ull) {
            const float mnew = fmaxf(mrun, bm), alpha = __builtin_amdgcn_exp2f(mrun - mnew);
            lrun *= alpha; mrun = mnew;
#pragma unroll
            for (int db = 0; db < 4; ++db)
#pragma unroll
                for (int i = 0; i < 16; ++i) o[db][i] *= alpha;
        }
        float ps = 0.f;
#pragma unroll
        for (int kb = 0; kb < 2; ++kb)
#pragma unroll
            for (int i = 0; i < 16; ++i) { s[kb][i] = __builtin_amdgcn_exp2f(s[kb][i] - mrun); ps += s[kb][i]; }
        ps += __shfl_xor(ps, 32);
        lrun += ps;
#pragma unroll
        for (int kb = 0; kb < 2; ++kb)
#pragma unroll
            for (int st = 0; st < 2; ++st) {
                u32x4 pp; pp.x = pk2(s[kb][8 * st + 0], s[kb][8 * st + 1]); pp.y = pk2(s[kb][8 * st + 2], s[kb][8 * st + 3]); pp.z = pk2(s[kb][8 * st + 4], s[kb][8 * st + 5]); pp.w = pk2(s[kb][8 * st + 6], s[kb][8 * st + 7]);
                const bf16x8 pf = __builtin_bit_cast(bf16x8, pp);
#pragma unroll
                for (int db = 0; db < 4; ++db) {
                    s16x4 v2[2];
#pragma unroll
                    for (int t = 0; t < 2; ++t) {
                        const int f = (q << 2) | ((2 * t + h) & 3);
                        v2[t] = __builtin_amdgcn_ds_read_tr16_b64_v4i16((LAS s16x4*)(Vt + 256 * (32 * kb + 16 * st + 8 * t) + 16 * ((4 * db + vlo) ^ f)));
                    }
                    const bf16x8 vf = __builtin_shufflevector(v2[0], v2[1], 0, 1, 2, 3, 4, 5, 6, 7);
                    o[db] = MFMA32(vf, pf, o[db]);
                }
            }
    }
#undef AQ_ISSUE
    asm volatile("s_waitcnt lgkmcnt(0)" ::: "memory"); __builtin_amdgcn_s_barrier(); asm volatile("" ::: "memory");
    const float inv = 1.0f / lrun;
#pragma unroll
    for (int db = 0; db < 4; ++db)
#pragma unroll
        for (int g = 0; g < 4; ++g) {
            u32x2 wv; wv.x = pk2(o[db][4 * g] * inv, o[db][4 * g + 1] * inv); wv.y = pk2(o[db][4 * g + 2] * inv, o[db][4 * g + 3] * inv);
            *(u32x2*)(Op + (size_t)r * 3072 + db * 32 + 8 * g + 4 * h) = wv;
        }
}
struct SrcSwa {
    const bf16_t* Z; const bf16_t* KcB; const bf16_t* VcB; int chunk, kv;
    DI void get(int jj, int t, bool isV, const bf16_t*& base, int& st) const {
        if (chunk < 256) { const int cc = chunk - 2 + jj; base = Z + (size_t)cc * 64 * ZLD + (isV ? C_VB : C_KB) + kv * 128; st = ZLD; return; }
        const int bs = chunk - 256;
        if (jj < 2) { base = (isV ? VcB : KcB) + (size_t)(bs * 128 + jj * 64) * 256 + kv * 128; st = 256; return; }
        base = Z + (size_t)chunk * 64 * ZLD + (isV ? C_VB : C_KB) + kv * 128; st = ZLD;
    }
};
struct SrcCb {
    const bf16_t* Z; const bf16_t* KcC; const bf16_t* VcC; int chunk, head0;
    DI void get(int jj, int t, bool isV, const bf16_t*& base, int& st) const {
        const int head = head0 + t;
        if (chunk < 256) { const int cc = chunk - 8 + jj; base = Z + (size_t)cc * 64 * ZLD + (isV ? C_VC : C_KC) + head * 128; st = ZLD; return; }
        const int bs = chunk - 256;
        if (jj < 8) { base = (isV ? VcC : KcC) + (size_t)(bs * 512 + jj * 64) * 1024 + head * 128; st = 1024; return; }
        base = Z + (size_t)chunk * 64 * ZLD + (isV ? C_VC : C_KC) + head * 128; st = ZLD;
    }
};

DI void copy_state(const Ctx& c, float* dst, int nb, int rows, int width, int row0, int bstride, int col) {
    const bf16_t* Z = (const bf16_t*)(kws() + WS_Z);
    const int w8 = width >> 3; const size_t total = (size_t)nb * rows * w8;
    for (size_t i = (size_t)c.bid * NTHR + c.tid; i < total; i += (size_t)c.G * NTHR) {
        const int e = (int)(i % w8); const size_t rt = i / w8; const int t = (int)(rt % rows), b = (int)(rt / rows);
        const u32x4 v = *(const u32x4*)(Z + (size_t)(row0 + b * bstride + t) * ZLD + col + 8 * e);
        f32x4* d = (f32x4*)(dst + ((size_t)(b * rows + t) * width + 8 * e));
        d[0] = (f32x4){bflo(v.x), bfhi(v.x), bflo(v.y), bfhi(v.y)}; d[1] = (f32x4){bflo(v.z), bfhi(v.z), bflo(v.w), bfhi(v.w)};
    }
}

DI void inproj_tail_combine(const Ctx& c) {
    const float* part = (const float*)(kws() + WS_PART); const float* rs = (const float*)(kws() + WS_RS); bf16_t* Z = (bf16_t*)(kws() + WS_Z);
    for (int i = c.bid * NTHR + c.tid; i < 16 * 8192; i += c.G * NTHR) {
        const int tile = i >> 13, e = i & 8191, r = e >> 5, c8 = (e & 31) * 8, row = 71 * 256 + r;
        const float* p = part + ((size_t)tile * 256 + r) * 256 + c8;
        f32x4 v0 = *(const f32x4*)p, v1 = *(const f32x4*)(p + 4);
#pragma unroll
        for (int ks = 1; ks < 8; ++ks) { v0 += *(const f32x4*)(p + (size_t)ks * 16 * 65536); v1 += *(const f32x4*)(p + (size_t)ks * 16 * 65536 + 4); }
        const float sc = rs[row];
#pragma unroll
        for (int j = 0; j < 4; ++j) { v0[j] = __builtin_amdgcn_rcpf(1.0f + __expf(-v0[j] * sc)); v1[j] = __builtin_amdgcn_rcpf(1.0f + __expf(-v1[j] * sc)); }
        *(u32x2*)((unsigned char*)(kws() + WS_GATE) + (((size_t)71 * 24 + tile) * 256 + r) * 256 + c8) = pg8::packq8(v0, v1);
    }
}
DI void phase_postD(const Ctx& c) {
    const float* part = (const float*)(kws() + WS_PART); bf16_t* act = (bf16_t*)(kws() + WS_ACT2) + (size_t)MP * DM;
    const size_t total = (size_t)MS * DM / 8;
    for (size_t i = (size_t)c.bid * NTHR + c.tid; i < total; i += (size_t)c.G * NTHR) {
        const f32x4* p = (const f32x4*)part + 2 * i; const size_t st = (size_t)MS * DM / 4;
        const f32x4 v0 = p[0] + p[st] + p[2 * st], v1 = p[1] + p[st + 1] + p[2 * st + 1];
        ((u32x4*)act)[i] = pg8::pack8(v0, v1);
    }
}
DI void phase_postRes(const Ctx& c, const float* xinS  ) {
    const int gw = c.bid * NWAVES + c.wave, NGW = c.G * NWAVES;
    bf16_t* act = (bf16_t*)(kws() + WS_ACT); float* rs = (float*)(kws() + WS_RS); const float* part = (const float*)(kws() + WS_PART);
    for (int row = MP + gw; row < M; row += NGW) {
        const f32x4* pr = (const f32x4*)(part + (size_t)(row - MP) * DM) + c.lane; const size_t st = (size_t)MS * DM / 4;
        u32x2* ao = (u32x2*)(act + (size_t)row * DM) + c.lane;
        float s = 0.f;
#pragma unroll
        for (int j = 0; j < 8; ++j) {
            f32x4 xi;
            if (xinS) xi = ((const f32x4*)(xinS + (size_t)(row - MP) * DM) + c.lane)[64 * j];
            else { const u32x2 w = ao[64 * j]; xi = (f32x4){bflo(w.x), bfhi(w.x), bflo(w.y), bfhi(w.y)}; }
            const f32x4 v = xi + ((pr[64 * j] + pr[st + 64 * j]) + (pr[2 * st + 64 * j] + pr[3 * st + 64 * j]));
            u32x2 w; w.x = pk2(v[0], v[1]); w.y = pk2(v[2], v[3]); ao[64 * j] = w;
            s += (v[0] * v[0] + v[1] * v[1]) + (v[2] * v[2] + v[3] * v[3]);
        }
        s = wave_sum(s);
        if (c.lane == 0) rs[row] = 1.0f / sqrtf(s * (1.0f / DM) + EPS);
    }
    const float* ssq = (const float*)(kws() + WS_SSQ);
    for (int row = c.bid * NTHR + c.tid; row < MP; row += c.G * NTHR) {
        const f32x4* q = (const f32x4*)(ssq + (size_t)row * 32); float s = 0.f;
#pragma unroll
        for (int j = 0; j < 8; ++j) { const f32x4 v = q[j]; s += (v[0] + v[1]) + (v[2] + v[3]); }
        rs[row] = 1.0f / sqrtf(s * (1.0f / DM) + EPS);
    }
}

DI void phase_postRes_final(const Ctx& c) {
    const int gw = c.bid * NWAVES + c.wave, NGW = c.G * NWAVES;
    const bf16_t* act = (const bf16_t*)(kws() + WS_ACT); const float* part = (const float*)(kws() + WS_PART); const float* ssq = (const float*)(kws() + WS_SSQ);
    const f32x4* gp = (const f32x4*)kin<24>() + c.lane;
    f32x4 gv[8];
#pragma unroll
    for (int j = 0; j < 8; ++j) gv[j] = gp[64 * j];
    for (int row = MP + gw; row < M; row += NGW) {
        const f32x4* pr = (const f32x4*)(part + (size_t)(row - MP) * DM) + c.lane; const size_t st = (size_t)MS * DM / 4;
        const u32x2* ai = (const u32x2*)(act + (size_t)row * DM) + c.lane; f32x4* yr = (f32x4*)(kout() + (size_t)row * DM) + c.lane;
        f32x4 v[8]; float s = 0.f;
#pragma unroll
        for (int j = 0; j < 8; ++j) { const u32x2 w = ai[64 * j]; const f32x4 xi = {bflo(w.x), bfhi(w.x), bflo(w.y), bfhi(w.y)};
            v[j] = xi + ((pr[64 * j] + pr[st + 64 * j]) + (pr[2 * st + 64 * j] + pr[3 * st + 64 * j])); s += (v[j][0] * v[j][0] + v[j][1] * v[j][1]) + (v[j][2] * v[j][2] + v[j][3] * v[j][3]); }
        s = wave_sum(s); const float r = 1.0f / sqrtf(s * (1.0f / DM) + EPS);
#pragma unroll
        for (int j = 0; j < 8; ++j) yr[64 * j] = v[j] * r * gv[j];
    }
    for (int row = gw; row < MP; row += NGW) {
        float s = c.lane < 32 ? ssq[(size_t)row * 32 + c.lane] : 0.f; s = wave_sum(s); const float r = 1.0f / sqrtf(s * (1.0f / DM) + EPS);
        const u32x2* xr = (const u32x2*)(act + (size_t)row * DM) + c.lane; f32x4* yr = (f32x4*)(kout() + (size_t)row * DM) + c.lane;
#pragma unroll
        for (int j = 0; j < 8; ++j) { const u32x2 w = xr[64 * j]; yr[64 * j] = (f32x4){bflo(w.x), bfhi(w.x), bflo(w.y), bfhi(w.y)} * r * gv[j]; }
    }
}

struct Args { const float* in[25]; float* out; unsigned char* ws; int ph_lo, ph_hi; };
constexpr int PH_PER_LAYER = 11, PH_FINAL = 1 + DEPTH * PH_PER_LAYER, PH_COUNT = PH_FINAL + 1;

__global__ void __launch_bounds__(NTHR, 2) fwd_kernel(Args args) {
    extern __shared__ __attribute__((aligned(16))) unsigned char lds_raw[];
    LAS unsigned char* const lds = (LAS unsigned char*)lds_raw;
    volatile LAS unsigned* misc = (volatile LAS unsigned*)(lds + LDS_MISC);
    if (threadIdx.x < 4) misc[threadIdx.x] = 0u;
    __syncthreads();
    const int lo = args.ph_lo, hi = args.ph_hi;
    XcdBarrier bar; bar.bar = (unsigned*)(kws() + WS_BAR); bar.x = 0; bar.st = misc;
    if (hi - lo > 1) bar = xcd_barrier_post((unsigned*)(kws() + WS_BAR), misc);
#define IN(k) (lo <= (k) && (k) < hi)
#define SEAM(k) do { if ((k) + 1 < hi) { bar.bar = (unsigned*)(kws() + WS_BAR); xcd_barrier(bar); } } while (0)
#define WSP(T, off) ((T*)(kws() + (off)))
#ifndef PHMASK
#define PHMASK 0xFFFF
#endif
#define PHON(j) ((PHMASK >> (j)) & 1)
#ifndef PROBE_MASK
#define PROBE_MASK 0
#endif
#define REP(j) for (int rep_ = 0; rep_ < 1 + ((PROBE_MASK >> (j)) & 1); ++rep_)
    if (PHON(14) && IN(0)) { REP(14) { const Ctx c = make_ctx(lds); phase_prologue(c); phase_norm(c, kin<0>(), kin<1>() - (size_t)MP * DM); } SEAM(0); }

    for (int l = 0; l < DEPTH; ++l) {
        const int pb = 1 + l * PH_PER_LAYER;
        if (PHON(1) && IN(pb + 1)) {
            pg8::InprojOrder S{{WSP(bf16_t, WS_ACT), WSP(bf16_t, WS_W) + (size_t)l * WL_SIZE + WL_IN, DM, DM}, (int)gridDim.x, (int)blockIdx.x};
            pg8::EpiInproj E{WSP(bf16_t, WS_Z), WSP(float, WS_RS), WSP(float, WS_PART), WSP(unsigned char, WS_GATE)};
            REP(1) pg8::gemm_phase(lds, S, E);
            {
                const Ctx c = make_ctx(lds); const int extra = (3584 + 128) % c.G;
                if (extra == 0 || c.bid >= extra) phase_cacheconv(c, l, extra == 0 ? c.bid : c.bid - extra, extra == 0 ? c.G : c.G - extra);
            }
            SEAM(pb + 1);
        }
        if (PHON(2) && IN(pb + 2)) {
            const Ctx c = make_ctx(lds);
            inproj_tail_combine(c);
            REP(12) lru_local_phase(c, l);
            REP(13) for (int u = c.bid; u < (c.G >= 128 ? 512 : NCHUNK * 2); u += c.G) {
                const int chunk = u >> 1, kv = u & 1, head = kv * 4 + (c.wave >> 1), qh = c.wave & 1;
                const bf16_t* Z = WSP(bf16_t, WS_Z);
                SrcSwa src{Z, WSP(bf16_t, WS_KCB), WSP(bf16_t, WS_VTCB), chunk, kv};
                const int n = chunk & 127, jj0 = (chunk < 256 && n < 2) ? 2 - n : 0;
                attn_item<0>(c.lds, src, Z + (size_t)(chunk * 64 + qh * 32) * ZLD + C_QB + head * 128, WSP(bf16_t, WS_BR) + (size_t)(chunk * 64 + qh * 32) * 3072 + 1024 + head * 128, 3, jj0,
                             kin<17>()[l * 8 + head] * LOG2E, nullptr, 0, c.tid);
            }
            SEAM(pb + 2);
        }
        if (PHON(3) && IN(pb + 3)) {
            const Ctx c = make_ctx(lds);
            LAS float* tbl = (LAS float*)(c.lds + LDS_TBL);
            for (int i = c.tid; i < 8 * 257; i += NTHR) { const int hh = i / 257, e = i - hh * 257; tbl[hh * 260 + e] = kin<18>()[(size_t)l * 8 * 257 + i] * LOG2E; }
            __syncthreads();
            REP(3) {
            {
                const bf16_t* Z = WSP(bf16_t, WS_Z);
                for (int u = c.bid; u < 512; u += c.G) {
                    const int x = u & 7, k = u >> 3;
                    attn_quad(c.lds, Z, WSP(bf16_t, WS_BR), 4 * k, x, tbl + x * 260, c.tid);
                }
            }
            {
                const int nsmp = c.G >= 128 ? 64 : 0;
                if (c.bid < nsmp || nsmp == 0) {
                    for (int u = c.bid; u < 64; u += (nsmp ? nsmp : c.G)) {
                        const int hg = u & 1, chunk = 256 + (u >> 1), head = hg * 4 + (c.wave >> 1), qh = c.wave & 1;
                        const bf16_t* Z = WSP(bf16_t, WS_Z);
                        SrcCb src{Z, WSP(bf16_t, WS_KCC), WSP(bf16_t, WS_VTCC), chunk, hg * 4};
                        attn_item<1>(c.lds, src, Z + (size_t)(chunk * 64 + qh * 32) * ZLD + C_QC + head * 128, WSP(bf16_t, WS_BR) + (size_t)(chunk * 64 + qh * 32) * 3072 + 2048 + head * 128, 9, 0,
                                     0.f, tbl + head * 260, qh * 32, c.tid);
                    }
                    if (nsmp) {
                        const int u = 512 + c.bid, chunk = u >> 1, kv = u & 1, head = kv * 4 + (c.wave >> 1), qh = c.wave & 1;
                        const bf16_t* Z = WSP(bf16_t, WS_Z);
                        SrcSwa src{Z, WSP(bf16_t, WS_KCB), WSP(bf16_t, WS_VTCB), chunk, kv};
                        attn_item<0>(c.lds, src, Z + (size_t)(chunk * 64 + qh * 32) * ZLD + C_QB + head * 128, WSP(bf16_t, WS_BR) + (size_t)(chunk * 64 + qh * 32) * 3072 + 1024 + head * 128, 3, 0,
                                     kin<17>()[l * 8 + head] * LOG2E, nullptr, 0, c.tid);
                    }
                }
                if (c.bid >= nsmp) for (int u = c.bid - nsmp; u < NCHUNK * 2; u += c.G - nsmp) lru_fix_unit(c, l, u >> 1, u & 1);
            }
            copy_state(c, kout() + O_PCONV + (size_t)l * 2 * 3 * 1024, 2, 3, 1024, 8189, 8192, C_AX);
            copy_state(c, kout() + O_SCONV + (size_t)l * 32 * 3 * 1024, 32, 3, 1024, MP + 61, 64, C_AX);
            copy_state(c, kout() + O_PSWAK + (size_t)l * 2 * 128 * 256, 2, 128, 256, 8192 - 128, 8192, C_KB);
            copy_state(c, kout() + O_PSWAV + (size_t)l * 2 * 128 * 256, 2, 128, 256, 8192 - 128, 8192, C_VB);
            copy_state(c, kout() + O_PCBK + (size_t)l * 2 * 512 * 1024, 2, 512, 1024, 8192 - 512, 8192, C_KC);
            copy_state(c, kout() + O_PCBV + (size_t)l * 2 * 512 * 1024, 2, 512, 1024, 8192 - 512, 8192, C_VC);
            copy_state(c, kout() + O_SSWAK + (size_t)l * 32 * 64 * 256, 32, 64, 256, MP, 64, C_KB);
            copy_state(c, kout() + O_SSWAV + (size_t)l * 32 * 64 * 256, 32, 64, 256, MP, 64, C_VB);
            copy_state(c, kout() + O_SCBK + (size_t)l * 32 * 64 * 1024, 32, 64, 1024, MP, 64, C_KC);
            copy_state(c, kout() + O_SCBV + (size_t)l * 32 * 64 * 1024, 32, 64, 1024, MP, 64, C_VC);
            }
            SEAM(pb + 3);
        }
        if (PHON(4) && IN(pb + 4)) {
            pg8::SplitOrder S{{WSP(bf16_t, WS_BR), WSP(bf16_t, WS_W) + (size_t)l * WL_SIZE + WL_BR, 3 * BW, 3 * BW}, (int)gridDim.x, (int)blockIdx.x, 3 * BW / 64, 3, BW / 64};
            pg8::EpiD E{WSP(unsigned char, WS_GATE), WSP(bf16_t, WS_ACT2), WSP(float, WS_PART)};
            pg8::gemm_phase(lds, S, E);
            SEAM(pb + 4);
        }
        if (PHON(5) && IN(pb + 5)) { const Ctx c = make_ctx(lds); phase_postD(c); SEAM(pb + 5); }
        if (PHON(6) && IN(pb + 6)) {
            pg8::SplitOrder S{{WSP(bf16_t, WS_ACT2), WSP(bf16_t, WS_W) + (size_t)l * WL_SIZE + WL_OUT, DM, DM}, (int)gridDim.x, (int)blockIdx.x, DM / 64, 4, DM / 256};
            if (l == 0) { pg8::EpiRes<true> E{kin<0>(), WSP(bf16_t, WS_ACT), WSP(float, WS_SSQ), WSP(float, WS_PART)}; pg8::gemm_phase(lds, S, E); }
            else { pg8::EpiRes<false> E{nullptr, WSP(bf16_t, WS_ACT), WSP(float, WS_SSQ), WSP(float, WS_PART)}; pg8::gemm_phase(lds, S, E); }
            SEAM(pb + 6);
        }
        if (PHON(7) && IN(pb + 7)) { const Ctx c = make_ctx(lds); phase_postRes(c, l == 0 ? kin<1>() : nullptr); SEAM(pb + 7); }
        if (PHON(8) && IN(pb + 8)) {
            pg8::FullOrder S{{WSP(bf16_t, WS_ACT), WSP(bf16_t, WS_W) + (size_t)l * WL_SIZE + WL_UP, DM, DM}, M / 256, DFF / 256, (int)gridDim.x, (int)blockIdx.x, DM / 64};
            pg8::EpiUp E{WSP(bf16_t, WS_Z)  , WSP(float, WS_RS)};
            REP(8) pg8::gemm_phase(lds, S, E);
            SEAM(pb + 8);
        }
        if (PHON(9) && IN(pb + 9)) {
            pg8::SplitOrder S{{WSP(bf16_t, WS_Z), WSP(bf16_t, WS_W) + (size_t)l * WL_SIZE + WL_DOWN, DFF, DFF}, (int)gridDim.x, (int)blockIdx.x, DFF / 64, 4, DFF / 256};
            pg8::EpiRes<false> E{nullptr, WSP(bf16_t, WS_ACT), WSP(float, WS_SSQ), WSP(float, WS_PART)};
            pg8::gemm_phase(lds, S, E);
            SEAM(pb + 9);
        }
        if (PHON(10) && IN(pb + 10)) { const Ctx c = make_ctx(lds); if (l == DEPTH - 1) phase_postRes_final(c); else { phase_postRes(c, nullptr); SEAM(pb + 10); } }
    }
#undef IN
#undef SEAM
}

#ifndef N_LAUNCH_MODE
#define N_LAUNCH_MODE 1
#endif
extern "C" void kernel_launch(void* const* d_in, const int* in_sizes, int n_in, void* d_out, int out_size, void* d_ws, size_t ws_size, hipStream_t stream) {
    static int grid = 0;
    if (grid == 0) {
        if (n_in != 25 || (size_t)out_size != O_END || ws_size < WS_END) { fprintf(stderr, "kernel_launch: unexpected sizes (n_in %d out %d ws %zu need %zu)\n", n_in, out_size, ws_size, (size_t)WS_END); grid = -1; return; }
        int dev = 0, cus = 0, per_cu = 0;
        if (hipGetDevice(&dev) != hipSuccess || hipDeviceGetAttribute(&cus, hipDeviceAttributeMultiprocessorCount, dev) != hipSuccess) { grid = -1; return; }
        if (hipFuncSetAttribute((const void*)fwd_kernel, hipFuncAttributeMaxDynamicSharedMemorySize, LDS_BYTES) != hipSuccess) { fprintf(stderr, "kernel_launch: hipFuncSetAttribute failed\n"); grid = -1; return; }
        if (hipOccupancyMaxActiveBlocksPerMultiprocessor(&per_cu, (const void*)fwd_kernel, NTHR, LDS_BYTES) != hipSuccess || per_cu < 1) { fprintf(stderr, "kernel_launch: occupancy query says %d\n", per_cu); (void)hipGetLastError(); grid = -1; return; }
        grid = cus;
    }
    if (grid < 0) return;
    (void)hipMemsetAsync((char*)d_ws + WS_BAR, 0, 16384, stream);
    Args a{};
    for (int i = 0; i < 25; ++i) a.in[i] = (const float*)d_in[i];
    a.out = (float*)d_out; a.ws = (unsigned char*)d_ws;
#if N_LAUNCH_MODE == 1
    a.ph_lo = 0; a.ph_hi = PH_COUNT;
    hipLaunchKernelGGL(fwd_kernel, dim3(grid), dim3(NTHR), LDS_BYTES, stream, a);
#else
    for (int p = 0; p < PH_COUNT; ++p) { a.ph_lo = p; a.ph_hi = p + 1; hipLaunchKernelGGL(fwd_kernel, dim3(grid), dim3(NTHR), LDS_BYTES, stream, a); }
#endif
}
```

```cpp
#include <hip/hip_runtime.h>
#include <cstdio>
#include <cstdint>

#define LAS __attribute__((address_space(3)))
typedef unsigned short bf16_t;
typedef short bf16x8 __attribute__((ext_vector_type(8)));
typedef float f32x2 __attribute__((ext_vector_type(2)));
typedef float f32x4 __attribute__((ext_vector_type(4)));
typedef float f32x16 __attribute__((ext_vector_type(16)));
typedef unsigned u32x2 __attribute__((ext_vector_type(2)));
typedef unsigned u32x4 __attribute__((ext_vector_type(4)));
typedef __bf16 bf16v2 __attribute__((ext_vector_type(2)));
#define DI __device__ __forceinline__

constexpr int MP = 16384, MS = 2048, M = MP + MS, DM = 2048, DIN = 12800, DFF = 8192, BW = 1024, DEPTH = 4, NCHUNK = M / 64;
constexpr int ZLD = 6656;
constexpr int C_AX = 0, C_AG = 1024, C_QB = 2048, C_KB = 3072, C_VB = 3328, C_QC = 3584, C_KC = 4608, C_VC = 5632, C_G = 6656;
constexpr int NWAVES = 8, NTHR = 512;
constexpr float EPS = 1e-6f, LOG2E = 1.4426950408889634f;
constexpr size_t O_YP = 0, O_YS = O_YP + (size_t)MP * DM, O_PCONV = O_YS + (size_t)MS * DM, O_PLRU = O_PCONV + 4 * 2 * 3 * 1024, O_PSWAK = O_PLRU + 4 * 2 * 1024,
                 O_PSWAV = O_PSWAK + 4 * 2 * 128 * 256, O_PCBK = O_PSWAV + 4 * 2 * 128 * 256, O_PCBV = O_PCBK + (size_t)4 * 2 * 512 * 1024, O_SCONV = O_PCBV + (size_t)4 * 2 * 512 * 1024,
                 O_SLRU = O_SCONV + 4 * 32 * 3 * 1024, O_SSWAK = O_SLRU + 4 * 32 * 1024, O_SSWAV = O_SSWAK + (size_t)4 * 32 * 64 * 256, O_SCBK = O_SSWAV + (size_t)4 * 32 * 64 * 256,
                 O_SCBV = O_SCBK + (size_t)4 * 32 * 64 * 1024, O_END = O_SCBV + (size_t)4 * 32 * 64 * 1024;
constexpr size_t WL_IN = 0, WL_BR = WL_IN + (size_t)DIN * DM, WL_OUT = WL_BR + (size_t)3 * DM * BW, WL_UP = WL_OUT + (size_t)DM * DM, WL_DOWN = WL_UP + (size_t)DFF * DM, WL_SIZE = WL_DOWN + (size_t)DM * DFF;
constexpr size_t al256(size_t x) { return (x + 255) & ~(size_t)255; }
constexpr size_t WS_BAR = 0, WS_RS = 16384, WS_AGG = al256(WS_RS + (size_t)M * 4), WS_LRUW = al256(WS_AGG + (size_t)NCHUNK * 1024 * 2 * 4),
                 WS_W = al256(WS_LRUW + (size_t)DEPTH * 2 * 8 * 128 * 128 * 2), WS_ACT = al256(WS_W + (size_t)DEPTH * WL_SIZE * 2), WS_Z = al256(WS_ACT + (size_t)M * DM * 2),
                 WS_KCB = al256(WS_Z + (size_t)M * DFF * 2),
                 WS_VTCB = al256(WS_KCB + (size_t)32 * 128 * 256 * 2), WS_KCC = al256(WS_VTCB + (size_t)32 * 2 * 2 * 8192 * 2), WS_VTCC = al256(WS_KCC + (size_t)32 * 512 * 1024 * 2),
                 WS_R1 = al256(WS_VTCC + (size_t)32 * 8 * 8 * 8192 * 2), WS_BR = al256(WS_R1 + (size_t)2 * M * 1024 * 4), WS_SSQ = al256(WS_BR + (size_t)M * 3 * BW * 2),
                 WS_PART = al256(WS_SSQ + (size_t)MP * 32 * 4), WS_ACT2 = al256(WS_PART + (size_t)4 * MS * DM * 4), WS_GATE = al256(WS_ACT2 + (size_t)M * DM * 2), WS_END = al256(WS_GATE + (size_t)M * 3 * DM * 2);
constexpr int LDS_STAGE = 131072, LDS_MISC = LDS_STAGE, LDS_TBL = LDS_STAGE + 256, LDS_BYTES = LDS_STAGE + 256 + 8 * 260 * 4 + 64;


template <int OFF> DI unsigned long long karg64() { auto ka = __builtin_amdgcn_kernarg_segment_ptr(); unsigned long long p;
    asm volatile("s_load_dwordx2 %0, %1, %2\n\ts_waitcnt lgkmcnt(0)" : "=s"(p) : "s"(ka), "n"(OFF)); return p; }
template <int I> DI const float* kin() { return (const float*)karg64<I * 8>(); }
DI float* kout() { return (float*)karg64<200>(); }
DI unsigned char* kws() { return (unsigned char*)karg64<208>(); }
DI int launder_tid() { int t = threadIdx.x; asm volatile("" : "+v"(t)); return t; }
DI float bf2f(unsigned short b) { return __uint_as_float(((unsigned)b) << 16); }
DI float bflo(unsigned w) { return __uint_as_float(w << 16); }
DI float bfhi(unsigned w) { return __uint_as_float(w & 0xffff0000u); }
DI unsigned pk2(float a, float b) { f32x2 v = {a, b}; bf16v2 r = __builtin_convertvector(v, bf16v2); return __builtin_bit_cast(unsigned, r); }
DI float wave_sum(float v) {
#pragma unroll
    for (int o = 1; o < 64; o <<= 1) v += __shfl_xor(v, o);
    return v;
}
DI float sigmoidf_(float x) { return 1.0f / (1.0f + __expf(-x)); }
DI float gelu_tanh(float x) { const float u = 0.7978845608028654f * (x + 0.044715f * x * x * x); const float e = __expf(-2.0f * u); return x * (1.0f / (1.0f + e)); }

#define XB_TMO      128
#define XB_XCNT(j)  (256  + 64 * (j))
#define XB_XSUB(j)  (1280 + 64 * (j))
#define XB_XGEN(j)  (2304 + 64 * (j))
#define XB_TOP      3328
#define XB_TOPGEN   3392
#define XCD_BAR_WORDS 3456
#define XB_SPIN_CAP (1u << 20)
DI unsigned xb_ld(unsigned* p)              { return __hip_atomic_load(p, __ATOMIC_RELAXED, __HIP_MEMORY_SCOPE_AGENT); }
DI unsigned xb_add(unsigned* p, unsigned v) { return __hip_atomic_fetch_add(p, v, __ATOMIC_RELAXED, __HIP_MEMORY_SCOPE_AGENT); }
DI unsigned xb_xcc_id() { return (unsigned)__builtin_amdgcn_s_getreg((3 << 11) | 20) & 0xFu; }
#define XB_SPIN(cond, bar) do { unsigned _sp = 0; while (cond) { __builtin_amdgcn_s_sleep(1); \
    if ((++_sp & 255u) == 0u) { if (xb_ld(&(bar)[XB_TMO])) break; if (_sp > XB_SPIN_CAP) { atomicAdd(&(bar)[XB_TMO], 1u); break; } } } } while (0)
struct XcdBarrier { unsigned* bar; unsigned x; volatile LAS unsigned* st; };
DI XcdBarrier xcd_barrier_post(unsigned* bar, volatile LAS unsigned* st) {
    XcdBarrier b; b.bar = bar; b.x = xb_xcc_id(); b.st = st;
    if (threadIdx.x == 0) (void)xb_add(&bar[XB_XCNT(b.x)], 1u);
    return b;
}
DI void xcd_barrier_complete(unsigned* bar, unsigned x, unsigned& nloc, unsigned& nx) {
    const unsigned G = gridDim.x * gridDim.y * gridDim.z;
    unsigned sum, cnt, mine, sp = 0u;
    for (;;) {
        sum = 0u; cnt = 0u; mine = 0u;
#pragma unroll
        for (unsigned j = 0; j < 16; ++j) { const unsigned c = xb_ld(&bar[XB_XCNT(j)]); sum += c; cnt += (c > 0u) ? 1u : 0u; mine = (j == x) ? c : mine; }
        if (sum == G) break;
        __builtin_amdgcn_s_sleep(1);
        if ((++sp & 255u) == 0u) { if (xb_ld(&bar[XB_TMO])) break; if (sp > XB_SPIN_CAP) { atomicAdd(&bar[XB_TMO], 1u); break; } }
    }
    nloc = mine > 0u ? mine : 1u; nx = cnt > 0u ? cnt : 1u;
}
DI void xcd_barrier(const XcdBarrier& b) {
    asm volatile("s_waitcnt vmcnt(0)" ::: "memory");
    __syncthreads();
    if (threadIdx.x == 0) {
        unsigned* bar = b.bar;
        __builtin_amdgcn_s_waitcnt(0);
        unsigned nloc = b.st[0], nx = b.st[1];
        if (nloc == 0u) { xcd_barrier_complete(bar, b.x, nloc, nx); b.st[0] = nloc; b.st[1] = nx; }
        const unsigned old = xb_add(&bar[XB_XSUB(b.x)], 1u);
        const unsigned gen = old / nloc;
        if (old + 1u == (gen + 1u) * nloc) {
            __builtin_amdgcn_fence(__ATOMIC_RELEASE, "agent");
            asm volatile("s_waitcnt vmcnt(0)" ::: "memory");
            const unsigned og = xb_add(&bar[XB_TOP], 1u);
            const unsigned tg = og / nx;
            if (og + 1u == (tg + 1u) * nx) xb_add(&bar[XB_TOPGEN], 1u);
            else XB_SPIN(xb_ld(&bar[XB_TOPGEN]) == tg, bar);
            __builtin_amdgcn_fence(__ATOMIC_ACQUIRE, "agent");
            xb_add(&bar[XB_XGEN(b.x)], 1u);
            asm volatile("s_waitcnt vmcnt(0)" ::: "memory");
        } else {
            XB_SPIN(xb_ld(&bar[XB_XGEN(b.x)]) == gen, bar);
            __builtin_amdgcn_fence(__ATOMIC_ACQUIRE, "agent");
            asm volatile("s_waitcnt vmcnt(0)" ::: "memory");
        }
    }
    __syncthreads();
}

namespace pg8 {
constexpr int BM = 256, BK = 64, HALF = 128, HTB = HALF * BK * 2, STAGE_BYTES = 8 * HTB, NXCD = 8;
#ifndef WGM_FULL
#define WGM_FULL 8
#endif
#ifndef WGM_INPROJ
#define WGM_INPROJ 8
#endif
#ifndef WGM_SPLIT
#define WGM_SPLIT 4
#endif
DI int lds_byte(int r, int c) { const int st = (r >> 4) * 2 + (c >> 5), rr = r & 15, cc = c & 31, ob = rr * 64 + cc * 2; return st * 1024 + (ob ^ (((ob >> 9) & 1) << 5)); }
DI void stage_rc(int b, int& R, int& C) { const int st = b / 1024, sb = b % 1024, swz = sb ^ (((sb >> 9) & 1) << 5); R = (st >> 1) * 16 + swz / 64; C = (st & 1) * 32 + (swz % 64) / 2; }
DI int perm32(int rho) { const int n = rho >> 4, i = rho & 15; return 8 * (i >> 2) + 4 * n + (i & 3); }
struct Unit { int pm, pn, ks, nt; const char* a; const char* b; };
struct Geo { const bf16_t* A; const bf16_t* Bt; int lda, ldb; };
template <int WGM> DI void xcd_tile(int L, int nM, int nN, int& pm, int& pn) {
    const int nwg = nM * nN; int wgid = L; { const int q = nwg / NXCD, r = nwg % NXCD, xcd = wgid % NXCD, off = wgid / NXCD; wgid = (xcd < r ? xcd * (q + 1) : r * (q + 1) + (xcd - r) * q) + off; }
    const int nig = WGM * nN, gid = wgid / nig, fm = gid * WGM, gsz = (nM - fm) < WGM ? (nM - fm) : WGM;
    pm = fm + ((wgid % nig) % gsz); pn = (wgid % nig) / gsz;
}
struct FullOrder {
    Geo g; int nM, nN, G, c, nt;
    DI bool next(int i, Unit& u) const {
        const long L = (long)i * G + c; if (L >= (long)nM * nN) return false;
        xcd_tile<WGM_FULL>((int)L, nM, nN, u.pm, u.pn); u.ks = -1; u.nt = nt;
        u.a = (const char*)g.A + (size_t)u.pm * BM * g.lda * 2; u.b = (const char*)g.Bt + (size_t)u.pn * BM * g.ldb * 2; return true;
    }
};
struct InprojOrder {
    Geo g; int G, c;
    DI bool next(int i, Unit& u) const {
        const long L = (long)i * G + c;
        if (L < 3584) {
            if (L < 3550) xcd_tile<WGM_INPROJ>((int)L, 71, 50, u.pm, u.pn); else { const int idx = (int)L - 3550; u.pm = 71; u.pn = idx < 26 ? idx : idx + 16; }
            u.ks = -1; u.nt = DM / BK; u.a = (const char*)g.A + (size_t)u.pm * BM * g.lda * 2; u.b = (const char*)g.Bt + (size_t)u.pn * BM * g.ldb * 2; return true; }
        const long j = L - 3584; if (j >= 128) return false;
        u.pm = 71; u.pn = 26 + ((int)j & 15); u.ks = (int)(j >> 4); u.nt = 4;
        u.a = (const char*)g.A + ((size_t)u.pm * BM * g.lda + (size_t)u.ks * 256) * 2; u.b = (const char*)g.Bt + ((size_t)u.pn * BM * g.ldb + (size_t)u.ks * 256) * 2; return true;
    }
};
struct SplitOrder {
    Geo g; int G, c, ntFull, S, ntSplit;
    DI bool next(int i, Unit& u) const {
        const long L = (long)i * G + c;
        if (L < 512) { xcd_tile<WGM_SPLIT>((int)L, 64, 8, u.pm, u.pn); u.ks = -1; u.nt = ntFull;
            u.a = (const char*)g.A + (size_t)u.pm * BM * g.lda * 2; u.b = (const char*)g.Bt + (size_t)u.pn * BM * g.ldb * 2; return true; }
        const long j = L - 512; if (j >= 64 * S) return false;
        const int xq = (int)j & 7, sq = (int)j >> 3, combo = xq * S + (sq >> 3); u.pn = sq & 7; u.pm = 64 + (combo & 7); u.ks = combo >> 3; u.nt = ntSplit;
        u.a = (const char*)g.A + ((size_t)u.pm * BM * g.lda + (size_t)u.ks * ntSplit * BK) * 2; u.b = (const char*)g.Bt + ((size_t)u.pn * BM * g.ldb + (size_t)u.ks * ntSplit * BK) * 2; return true;
    }
};
template <class Epi, class Sched>
DI void gemm_phase(LAS unsigned char* lds, const Sched& S, const Epi& E) {
    const int tid = launder_tid(), wid = __builtin_amdgcn_readfirstlane(tid >> 6), lane = tid & 63, wr = wid >> 2, wc = wid & 3, fr = lane & 15, fq = lane >> 4;
    const int lda = S.g.lda, ldb = S.g.ldb;
    unsigned voffA[2], voffB[2];
#pragma unroll
    for (int i = 0; i < 2; ++i) { int R, C; stage_rc(tid * 16 + i * 8192, R, C); const int Rb = (R & ~31) + perm32(R & 31);
        voffA[i] = (unsigned)(R * lda + C) * 2u; voffB[i] = (unsigned)(Rb * ldb + C) * 2u; }
    const size_t kstep = (size_t)(BK * 2);
    const size_t hstepA = (size_t)HALF * lda * 2, hstepB = (size_t)HALF * ldb * 2;
    const unsigned ldsw = (unsigned)wid * 1024u;
    const int aoff = lds_byte(wr * 64 + fr, fq * 8), boff = lds_byte(wc * 32 + fr, fq * 8);
#define PG8_SA(b, h) (((b) * 2 + (h)) * HTB)
#define PG8_SB(b, h) ((4 + (b) * 2 + (h)) * HTB)
#define PG8_STAGE(bufoff, gbase, voff) do { _Pragma("unroll") for (int _i = 0; _i < 2; ++_i) \
        __builtin_amdgcn_global_load_lds((const unsigned*)((const char*)(gbase) + (voff)[_i]), (LAS unsigned*)(lds + (bufoff) + ldsw + _i * 8192), 16, 0, 0); } while (0)
#define PG8_LDA(dst, b, h) do { _Pragma("unroll") for (int m = 0; m < 4; ++m) _Pragma("unroll") for (int k = 0; k < 2; ++k) dst[m][k] = *(const LAS bf16x8*)(lds + PG8_SA(b, h) + aoff + m * 2048 + k * 1024); } while (0)
#define PG8_LDB(dst, b, h) do { _Pragma("unroll") for (int n = 0; n < 2; ++n) _Pragma("unroll") for (int k = 0; k < 2; ++k) dst[n][k] = *(const LAS bf16x8*)(lds + PG8_SB(b, h) + boff + n * 2048 + k * 1024); } while (0)
#define PG8_MMA(ai, bj, At, Bt) do { __builtin_amdgcn_s_setprio(1); _Pragma("unroll") for (int m = 0; m < 4; ++m) _Pragma("unroll") for (int n = 0; n < 2; ++n) _Pragma("unroll") for (int k = 0; k < 2; ++k) \
        acc[ai][bj][m][n] = __builtin_amdgcn_mfma_f32_16x16x32_bf16(Bt[n][k], At[m][k], acc[ai][bj][m][n], 0, 0, 0); __builtin_amdgcn_s_setprio(0); } while (0)
#define PG8_WAIT_V(n) asm volatile("s_waitcnt vmcnt(" #n ")" ::: "memory")
#define PG8_WAIT_L(n) asm volatile("s_waitcnt lgkmcnt(" #n ")" ::: "memory")
#define PG8_BAR __builtin_amdgcn_s_barrier()
#define PG8_SCHED __builtin_amdgcn_sched_barrier(0)
    Unit cur, nxt; int ui = 0;
    if (!S.next(0, cur)) return;
    f32x4 acc[2][2][4][2];
#pragma unroll
    for (int a = 0; a < 2; ++a)
#pragma unroll
        for (int b = 0; b < 2; ++b)
#pragma unroll
            for (int m = 0; m < 4; ++m)
#pragma unroll
                for (int n = 0; n < 2; ++n) acc[a][b][m][n] = (f32x4){0.f, 0.f, 0.f, 0.f};
    bf16x8 At[4][2], B0[2][2], B1[2][2];
    const char* cA = cur.a; const char* cB = cur.b;
#define PG8_RSDMA(unit_, par_) do { if constexpr (Epi::RSLDS) { if (wid < 4) __builtin_amdgcn_global_load_lds((const unsigned*)(E.rs + (unit_).pm * BM + wid * 64 + lane), \
        (LAS unsigned*)(lds + LDS_TBL + (par_) * 1024 + wid * 256), 4, 0, 0); } } while (0)
    PG8_RSDMA(cur, 0);
    PG8_STAGE(PG8_SB(0, 0), cB, voffB); PG8_STAGE(PG8_SB(0, 1), cB + hstepB, voffB); PG8_STAGE(PG8_SA(0, 0), cA, voffA); PG8_STAGE(PG8_SA(0, 1), cA + hstepA, voffA);
    if (wr == 1) PG8_BAR;
    PG8_WAIT_V(2); PG8_BAR;
    PG8_STAGE(PG8_SB(1, 0), cB + kstep, voffB); PG8_STAGE(PG8_SA(1, 0), cA + kstep, voffA); PG8_STAGE(PG8_SB(1, 1), cB + hstepB + kstep, voffB);
    PG8_WAIT_V(6); PG8_BAR;
    for (;;) {
        const bool has_next = S.next(ui + 1, nxt);
        const char* nA = has_next ? nxt.a : cA; const char* nB = has_next ? nxt.b : cB;
        const int nt = cur.nt;
        for (int t = 0; t < nt; t += 2) {
            const bool last = (t == nt - 2);
            const char* a1 = cA + (size_t)(t + 1) * kstep;
            const char* a2 = last ? nA : cA + (size_t)(t + 2) * kstep; const char* b2 = last ? nB : cB + (size_t)(t + 2) * kstep;
            const char* a3 = a2 + kstep; const char* b3 = b2 + kstep;
            if constexpr (Epi::HOOK) { if (cur.ks < 0 && (t == 16 || t == 32)) E.hook(acc, cur, t >> 4, wr, wc, fr, fq); }
            PG8_LDB(B0, 0, 0); PG8_LDB(B1, 0, 1); PG8_SCHED; PG8_LDA(At, 0, 0); PG8_STAGE(PG8_SA(1, 1), a1 + hstepA, voffA);
            PG8_WAIT_V(8); PG8_WAIT_L(0); PG8_BAR; PG8_MMA(0, 0, At, B0); PG8_MMA(0, 1, At, B1); PG8_BAR; PG8_SCHED;
            PG8_LDA(At, 0, 1); PG8_STAGE(PG8_SB(0, 0), b2, voffB); PG8_STAGE(PG8_SB(0, 1), b2 + hstepB, voffB); PG8_STAGE(PG8_SA(0, 0), a2, voffA);
            PG8_WAIT_V(8); PG8_WAIT_L(0); PG8_BAR; PG8_MMA(1, 0, At, B0); PG8_MMA(1, 1, At, B1); PG8_BAR; PG8_SCHED;
            PG8_LDB(B0, 1, 0); PG8_LDB(B1, 1, 1); PG8_SCHED; PG8_LDA(At, 1, 0); PG8_STAGE(PG8_SA(0, 1), a2 + hstepA, voffA);
            PG8_WAIT_V(8); PG8_WAIT_L(0); PG8_BAR; PG8_MMA(0, 0, At, B0); PG8_MMA(0, 1, At, B1); PG8_BAR; PG8_SCHED;
            PG8_LDA(At, 1, 1); PG8_STAGE(PG8_SB(1, 0), b3, voffB); PG8_STAGE(PG8_SB(1, 1), b3 + hstepB, voffB); PG8_STAGE(PG8_SA(1, 0), a3, voffA);
            PG8_WAIT_V(8); PG8_WAIT_L(0); PG8_BAR; PG8_MMA(1, 0, At, B0); PG8_MMA(1, 1, At, B1); PG8_BAR; PG8_SCHED;
        }
        if (wr == 0) PG8_BAR;
        E(acc, cur, wr, wc, fr, fq, (const LAS float*)(lds + LDS_TBL + (ui & 1) * 1024));
        if (!has_next) break;
#pragma unroll
        for (int a = 0; a < 2; ++a)
#pragma unroll
            for (int b = 0; b < 2; ++b)
#pragma unroll
                for (int m = 0; m < 4; ++m)
#pragma unroll
                    for (int n = 0; n < 2; ++n) acc[a][b][m][n] = (f32x4){0.f, 0.f, 0.f, 0.f};
        cur = nxt; cA = nA; cB = nB; ++ui;
        PG8_RSDMA(cur, ui & 1);
        if (wr == 1) PG8_BAR;
    }
    PG8_WAIT_V(0);
    PG8_BAR;
#undef PG8_RSDMA
#undef PG8_SA
#undef PG8_SB
#undef PG8_STAGE
#undef PG8_LDA
#undef PG8_LDB
#undef PG8_MMA
#undef PG8_WAIT_V
#undef PG8_WAIT_L
#undef PG8_BAR
#undef PG8_SCHED
}

DI unsigned q8(float s) { const float t = fminf(fmaxf(s * 255.0f + 0.5f, 1.0f), 255.0f); return (unsigned)(int)t; }
DI unsigned pk4q8(const f32x4 v) {
    unsigned w = 0u;
    w = __builtin_amdgcn_cvt_pk_u8_f32(fmaxf(__builtin_rintf(v[0] * 255.0f), 1.0f), 0, w); w = __builtin_amdgcn_cvt_pk_u8_f32(fmaxf(__builtin_rintf(v[1] * 255.0f), 1.0f), 1, w);
    w = __builtin_amdgcn_cvt_pk_u8_f32(fmaxf(__builtin_rintf(v[2] * 255.0f), 1.0f), 2, w); w = __builtin_amdgcn_cvt_pk_u8_f32(fmaxf(__builtin_rintf(v[3] * 255.0f), 1.0f), 3, w);
    return w;
}
DI u32x2 packq8(const f32x4 v0, const f32x4 v1) { u32x2 w; w.x = pk4q8(v0); w.y = pk4q8(v1); return w; }
DI void unpackq8(const u32x2 w, f32x4& v0, f32x4& v1) {
    v0 = (f32x4){(float)(w.x & 0xffu), (float)((w.x >> 8) & 0xffu), (float)((w.x >> 16) & 0xffu), (float)(w.x >> 24)};
    v1 = (f32x4){(float)(w.y & 0xffu), (float)((w.y >> 8) & 0xffu), (float)((w.y >> 16) & 0xffu), (float)(w.y >> 24)}; }
DI u32x4 pack8(const f32x4 v0, const f32x4 v1) { u32x4 w; w.x = pk2(v0[0], v0[1]); w.y = pk2(v0[2], v0[3]); w.z = pk2(v1[0], v1[1]); w.w = pk2(v1[2], v1[3]); return w; }
DI void unpack8(const u32x4 w, f32x4& v0, f32x4& v1) { v0 = (f32x4){bflo(w.x), bfhi(w.x), bflo(w.y), bfhi(w.y)}; v1 = (f32x4){bflo(w.z), bfhi(w.z), bflo(w.w), bfhi(w.w)}; }
struct EpiInproj {
    static constexpr bool HOOK = false, RSLDS = true;
    bf16_t* Z; const float* rs; float* part; unsigned char* GT;
    DI void operator()(const f32x4 (&acc)[2][2][4][2], const Unit& u, int wr, int wc, int fr, int fq, const LAS float* rsl) const {
        const int row0 = u.pm * BM + wr * 64 + fr, col0 = u.pn * BM + wc * 32 + 8 * fq;
        const bool gate = u.pn >= C_G / BM;
#pragma unroll
        for (int ai = 0; ai < 2; ++ai)
#pragma unroll
            for (int m = 0; m < 4; ++m) {
                const int row = row0 + ai * HALF + m * 16;
                if (u.ks < 0) {
                    const float s = rsl[wr * 64 + fr + ai * HALF + m * 16];
                    bf16_t* rowp = Z + (size_t)row * ZLD + col0;
                    unsigned char* gq = GT + (((size_t)u.pm * 24 + (u.pn - 26)) * 256 + (row & 255)) * 256 + wc * 32 + 8 * fq;
#pragma unroll
                    for (int bj = 0; bj < 2; ++bj) {
                        f32x4 v0 = acc[ai][bj][m][0] * s, v1 = acc[ai][bj][m][1] * s;
                        if (gate) {
#pragma unroll
                            for (int j = 0; j < 4; ++j) { v0[j] = __builtin_amdgcn_rcpf(1.0f + __expf(-v0[j])); v1[j] = __builtin_amdgcn_rcpf(1.0f + __expf(-v1[j])); }
                            *(u32x2*)(gq + bj * HALF) = packq8(v0, v1);
                        } else *(u32x4*)(rowp + bj * HALF) = pack8(v0, v1);
                    }
                } else {
                    float* pp = part + (((size_t)u.ks * 16 + (u.pn - 26)) * 256 + (row - 71 * BM)) * 256 + wc * 32 + 8 * fq;
#pragma unroll
                    for (int bj = 0; bj < 2; ++bj) { *(f32x4*)(pp + bj * HALF) = acc[ai][bj][m][0]; *(f32x4*)(pp + bj * HALF + 4) = acc[ai][bj][m][1]; }
                }
            }
    }
};
struct EpiUp {
    static constexpr bool HOOK = false, RSLDS = true;
    bf16_t* H; const float* rs;
    DI void operator()(const f32x4 (&acc)[2][2][4][2], const Unit& u, int wr, int wc, int fr, int fq, const LAS float* rsl) const {
        const int row0 = u.pm * BM + wr * 64 + fr, col0 = u.pn * BM + wc * 32 + 8 * fq;
#pragma unroll
        for (int ai = 0; ai < 2; ++ai)
#pragma unroll
            for (int m = 0; m < 4; ++m) {
                const int row = row0 + ai * HALF + m * 16; const float s = rsl[wr * 64 + fr + ai * HALF + m * 16];
                bf16_t* rowp = H + (size_t)row * DFF + col0;
#pragma unroll
                for (int bj = 0; bj < 2; ++bj) {
                    f32x4 v0 = acc[ai][bj][m][0] * s, v1 = acc[ai][bj][m][1] * s;
#pragma unroll
                    for (int j = 0; j < 4; ++j) { v0[j] = fmaxf(v0[j], 0.f); v0[j] *= v0[j]; v1[j] = fmaxf(v1[j], 0.f); v1[j] *= v1[j]; }
                    *(u32x4*)(rowp + bj * HALF) = pack8(v0, v1);
                }
            }
    }
};
struct EpiD {
    static constexpr bool HOOK = true, RSLDS = false;
    const unsigned char* Z; bf16_t* act; float* part;
    DI void hook(f32x4 (&acc)[2][2][4][2], const Unit& u, int r, int wr, int wc, int fr_, int fq_) const {
        int fr = fr_, fq = fq_; asm volatile("" : "+v"(fr), "+v"(fq));
        const int row0 = u.pm * BM + wr * 64 + fr, col0 = u.pn * BM + wc * 32 + 8 * fq;
#pragma unroll
        for (int ai = 0; ai < 2; ++ai) {
#pragma unroll
            for (int m = 0; m < 4; ++m) {
                const unsigned char* gp = Z + (((size_t)u.pm * 24 + (r - 1) * 8 + u.pn) * 256 + (wr * 64 + fr + ai * HALF + m * 16)) * 256 + wc * 32 + 8 * fq;
#pragma unroll
                for (int bj = 0; bj < 2; ++bj) {
                    f32x4 n0, n1, d0, d1; unpackq8(*(const u32x2*)(gp + bj * HALF), n0, n1); unpackq8(*(const u32x2*)(gp + 8 * 65536 + bj * HALF), d0, d1);
#pragma unroll
                    for (int j = 0; j < 4; ++j) { acc[ai][bj][m][0][j] *= n0[j] * __builtin_amdgcn_rcpf(d0[j]); acc[ai][bj][m][1][j] *= n1[j] * __builtin_amdgcn_rcpf(d1[j]); }
                }
            }
            asm volatile("" : "+v"(acc[ai][0][0][0]), "+v"(acc[ai][0][1][0]), "+v"(acc[ai][0][2][0]), "+v"(acc[ai][0][3][0]), "+v"(acc[ai][1][0][0]), "+v"(acc[ai][1][1][0]), "+v"(acc[ai][1][2][0]), "+v"(acc[ai][1][3][0]));
        }
    }
    DI void operator()(const f32x4 (&acc)[2][2][4][2], const Unit& u, int wr, int wc, int fr, int fq, const LAS float* rsl) const {
        const int row0 = u.pm * BM + wr * 64 + fr, col0 = u.pn * BM + wc * 32 + 8 * fq;
        const int r = u.ks < 0 ? 2 : u.ks;
#pragma unroll
        for (int ai = 0; ai < 2; ++ai)
#pragma unroll
            for (int m = 0; m < 4; ++m) {
                const int row = row0 + ai * HALF + m * 16;
                const unsigned char* gp = Z + (((size_t)u.pm * 24 + r * 8 + u.pn) * 256 + (row & 255)) * 256 + wc * 32 + 8 * fq;
#pragma unroll
                for (int bj = 0; bj < 2; ++bj) {
                    f32x4 s0, s1; unpackq8(*(const u32x2*)(gp + bj * HALF), s0, s1);
                    const f32x4 v0 = acc[ai][bj][m][0] * (s0 * (1.0f / 255.0f)), v1 = acc[ai][bj][m][1] * (s1 * (1.0f / 255.0f));
                    if (u.ks < 0) *(u32x4*)(act + (size_t)row * DM + col0 + bj * HALF) = pack8(v0, v1);
                    else { float* pp = part + ((size_t)u.ks * MS + (row - MP)) * DM + col0 + bj * HALF; *(f32x4*)pp = v0; *(f32x4*)(pp + 4) = v1; }
                }
            }
    }
};
template <bool XF32> struct EpiRes {
    static constexpr bool HOOK = false, RSLDS = false;
    const float* Xin; bf16_t* act; float* ssq; float* part;
    DI void operator()(const f32x4 (&acc)[2][2][4][2], const Unit& u, int wr, int wc, int fr, int fq, const LAS float* rsl) const {
        const int row0 = u.pm * BM + wr * 64 + fr, col0 = u.pn * BM + wc * 32 + 8 * fq;
        u32x4 xin[2][4][2];
        if (!XF32 && u.ks < 0) {
#pragma unroll
            for (int ai = 0; ai < 2; ++ai)
#pragma unroll
                for (int m = 0; m < 4; ++m)
#pragma unroll
                    for (int bj = 0; bj < 2; ++bj) xin[ai][m][bj] = *(const u32x4*)(act + (size_t)(row0 + ai * HALF + m * 16) * DM + col0 + bj * HALF);
        }
#pragma unroll
        for (int ai = 0; ai < 2; ++ai)
#pragma unroll
            for (int m = 0; m < 4; ++m) {
                const int row = row0 + ai * HALF + m * 16;
                if (u.ks < 0) {
                    const size_t off = (size_t)row * DM + col0; float sq = 0.f;
#pragma unroll
                    for (int bj = 0; bj < 2; ++bj) {
                        f32x4 x0, x1;
                        if (XF32) { x0 = *(const f32x4*)(Xin + off + bj * HALF); x1 = *(const f32x4*)(Xin + off + bj * HALF + 4); }
                        else unpack8(xin[ai][m][bj], x0, x1);
                        x0 += acc[ai][bj][m][0]; x1 += acc[ai][bj][m][1];
                        *(u32x4*)(act + off + bj * HALF) = pack8(x0, x1);
                        sq += (x0[0] * x0[0] + x0[1] * x0[1]) + (x0[2] * x0[2] + x0[3] * x0[3]) + (x1[0] * x1[0] + x1[1] * x1[1]) + (x1[2] * x1[2] + x1[3] * x1[3]);
                    }
                    sq += __shfl_xor(sq, 16); sq += __shfl_xor(sq, 32);
                    if (fq == 0) ssq[(size_t)row * 32 + u.pn * 4 + wc] = sq;
                } else {
#pragma unroll
                    for (int bj = 0; bj < 2; ++bj) { float* pp = part + ((size_t)u.ks * MS + (row - MP)) * DM + col0 + bj * HALF; *(f32x4*)pp = acc[ai][bj][m][0]; *(f32x4*)(pp + 4) = acc[ai][bj][m][1]; }
                }
            }
    }
};
}

DI void tr_item(const float* src, size_t sld, bf16_t* dst, size_t dld, const float* ksc, LAS unsigned* scr, int lane) {
    const int ng = lane & 15, kq = lane >> 4;
#pragma unroll
    for (int i = 0; i < 8; ++i) {
        const int k = 8 * i + 2 * kq;
        f32x4 a = *(const f32x4*)(src + (size_t)k * sld + 4 * ng);
        f32x4 b = *(const f32x4*)(src + (size_t)(k + 1) * sld + 4 * ng);
        if (ksc) { a *= ksc[k]; b *= ksc[k + 1]; }
        LAS unsigned* d = scr + (4 * ng) * 33 + 4 * i + kq;
        d[0] = pk2(a[0], b[0]); d[33] = pk2(a[1], b[1]); d[66] = pk2(a[2], b[2]); d[99] = pk2(a[3], b[3]);
    }
    asm volatile("s_waitcnt lgkmcnt(0)" ::: "memory");
#pragma unroll
    for (int j = 0; j < 8; ++j) {
        const int n = (lane >> 3) + 8 * j, c = lane & 7;
        const LAS unsigned* s = scr + n * 33 + 4 * c;
        u32x4 o; o.x = s[0]; o.y = s[1]; o.z = s[2]; o.w = s[3];
        *(u32x4*)(dst + (size_t)n * dld + 8 * c) = o;
    }
    asm volatile("s_waitcnt lgkmcnt(0)" ::: "memory");
}

struct Ctx {
    LAS unsigned char* lds;
    int tid, lane, wave, bid, G;
};
DI Ctx make_ctx(LAS unsigned char* lds) { Ctx c; c.lds = lds; c.tid = launder_tid(); c.lane = c.tid & 63; c.wave = __builtin_amdgcn_readfirstlane(c.tid >> 6); c.bid = blockIdx.x; c.G = gridDim.x; return c; }

DI void conv_matrix_item(const float* W, int K, int N, bf16_t* Wt, const float* ksc, int item, LAS unsigned* scr, int lane) {
    const int nb = N >> 6, kb = item / nb, nn = item - kb * nb;
    tr_item(W + (size_t)kb * 64 * N + nn * 64, (size_t)N, Wt + (size_t)nn * 64 * K + kb * 64, (size_t)K, ksc ? ksc + kb * 64 : nullptr, scr, lane);
}
DI void phase_prologue(const Ctx& c) {
    LAS unsigned* scr = (LAS unsigned*)(c.lds + c.wave * 16384);
    const int gw = c.bid * NWAVES + c.wave, NGW = c.G * NWAVES;
    constexpr int I_IN = 32 * 200, I_BR = 16 * 32, I_OUT = 32 * 32, I_UP = 32 * 128, I_DN = 128 * 32, I_LRU = 4, I_L = I_IN + 3 * I_BR + I_OUT + I_UP + I_DN + 16 * I_LRU;
    bf16_t* Wall = (bf16_t*)(kws() + WS_W); bf16_t* lruw = (bf16_t*)(kws() + WS_LRUW);
    for (int it = gw; it < DEPTH * I_L; it += NGW) {
        const int l = it / I_L; int r = it - l * I_L;
        bf16_t* Wl = Wall + (size_t)l * WL_SIZE;
        if (r < I_IN) { conv_matrix_item(kin<9>() + (size_t)l * DM * DIN, DM, DIN, Wl + WL_IN, kin<8>() + l * DM, r, scr, c.lane); continue; } r -= I_IN;
        if (r < 3 * I_BR) { const int b = r / I_BR, it2 = r - b * I_BR, kb = it2 / (DM / 64), nn = it2 - kb * (DM / 64);
            tr_item(kin<19>() + ((size_t)l * 3 + b) * BW * DM + (size_t)kb * 64 * DM + nn * 64, (size_t)DM, Wl + WL_BR + (size_t)nn * 64 * (3 * BW) + b * BW + kb * 64, (size_t)(3 * BW), nullptr, scr, c.lane); continue; } r -= 3 * I_BR;
        if (r < I_OUT) { conv_matrix_item(kin<20>() + (size_t)l * DM * DM, DM, DM, Wl + WL_OUT, nullptr, r, scr, c.lane); continue; } r -= I_OUT;
        if (r < I_UP) { conv_matrix_item(kin<22>() + (size_t)l * DM * DFF, DM, DFF, Wl + WL_UP, kin<21>() + l * DM, r, scr, c.lane); continue; } r -= I_UP;
        if (r < I_DN) { conv_matrix_item(kin<23>() + (size_t)l * DFF * DM, DFF, DM, Wl + WL_DOWN, nullptr, r, scr, c.lane); continue; } r -= I_DN;
        { const int wsel = r / (8 * I_LRU), rr = r - wsel * 8 * I_LRU, blk = rr / I_LRU, sub = rr - blk * I_LRU;
          conv_matrix_item((wsel ? kin<14>() : kin<12>()) + ((size_t)l * 8 + blk) * 16384, 128, 128, lruw + (((size_t)l * 2 + wsel) * 8 + blk) * 16384, nullptr, sub, scr, c.lane); }
    }
}

DI void phase_norm(const Ctx& c, const float* xP, const float* xS) {
    const int gw = c.bid * NWAVES + c.wave, NGW = c.G * NWAVES;
    bf16_t* act = (bf16_t*)(kws() + WS_ACT); float* rs = (float*)(kws() + WS_RS);
    for (int row = gw; row < M; row += NGW) {
        const f32x4* xr = (const f32x4*)((row < MP ? xP : xS) + (size_t)row * DM) + c.lane;
        f32x4 v[8]; float s = 0.f;
#pragma unroll
        for (int j = 0; j < 8; ++j) { v[j] = xr[64 * j]; s += (v[j][0] * v[j][0] + v[j][1] * v[j][1]) + (v[j][2] * v[j][2] + v[j][3] * v[j][3]); }
        s = wave_sum(s);
        if (c.lane == 0) rs[row] = 1.0f / sqrtf(s * (1.0f / DM) + EPS);
        u32x2* o = (u32x2*)(act + (size_t)row * DM) + c.lane;
#pragma unroll
        for (int j = 0; j < 8; ++j) { u32x2 w; w.x = pk2(v[j][0], v[j][1]); w.y = pk2(v[j][2], v[j][3]); o[64 * j] = w; }
    }
}
DI void phase_final(const Ctx& c) {
    const int gw = c.bid * NWAVES + c.wave, NGW = c.G * NWAVES;
    const f32x4* gp = (const f32x4*)kin<24>() + c.lane; const float* rs = (const float*)(kws() + WS_RS); const bf16_t* act = (const bf16_t*)(kws() + WS_ACT);
    f32x4 gv[8];
#pragma unroll
    for (int j = 0; j < 8; ++j) gv[j] = gp[64 * j];
    for (int row = gw; row < M; row += NGW) {
        f32x4* yr = (f32x4*)(kout() + (size_t)row * DM) + c.lane; const u32x2* xr = (const u32x2*)(act + (size_t)row * DM) + c.lane; const float r = rs[row];
#pragma unroll
        for (int j = 0; j < 8; ++j) { const u32x2 w = xr[64 * j]; yr[64 * j] = (f32x4){bflo(w.x), bfhi(w.x), bflo(w.y), bfhi(w.y)} * r * gv[j]; }
    }
}
DI void cvt_f32_bf16(const float* s, bf16_t* d, size_t n8, size_t gt, size_t NT) {
    for (size_t i = gt; i < n8; i += NT) { const f32x4 a = ((const f32x4*)s)[2 * i], b = ((const f32x4*)s)[2 * i + 1]; u32x4 w; w.x = pk2(a[0], a[1]); w.y = pk2(a[2], a[3]); w.z = pk2(b[0], b[1]); w.w = pk2(b[2], b[3]); ((u32x4*)d)[i] = w; }
}
DI void phase_cacheconv(const Ctx& c, int l, int pidx, int pcount) {
    const size_t gt = (size_t)pidx * NTHR + c.tid, NT = (size_t)pcount * NTHR;
    cvt_f32_bf16(kin<4>() + (size_t)l * 32 * 128 * 256, (bf16_t*)(kws() + WS_KCB), (size_t)32 * 128 * 256 / 8, gt, NT);
    cvt_f32_bf16(kin<5>() + (size_t)l * 32 * 128 * 256, (bf16_t*)(kws() + WS_VTCB), (size_t)32 * 128 * 256 / 8, gt, NT);
    cvt_f32_bf16(kin<6>() + (size_t)l * 32 * 512 * 1024, (bf16_t*)(kws() + WS_KCC), (size_t)32 * 512 * 1024 / 8, gt, NT);
    cvt_f32_bf16(kin<7>() + (size_t)l * 32 * 512 * 1024, (bf16_t*)(kws() + WS_VTCC), (size_t)32 * 512 * 1024 / 8, gt, NT);
}

DI void lru_local_phase(const Ctx& c, int l) {
    LAS float* uf = (LAS float*)c.lds;
    LAS unsigned char* ub = c.lds + 33792;
    LAS float* sa = (LAS float*)(c.lds + 33792 + 17408);
    LAS float* sb = sa + 8192;
    LAS float* tot = sb + 8192;
    const bf16_t* Z = (const bf16_t*)(kws() + WS_Z);
    const int nunits = NCHUNK * 8;
    int u = c.bid; if (u >= nunits) return;
    const int cg = c.tid & 15, tk = c.tid >> 4;
    const int fr = c.lane & 15, fq = c.lane >> 4, w = c.wave;
    const int chl = c.tid & 127, q = c.tid >> 7;
    int nblk_cur = -1;
    LAS float* cwl = tot + 1024;
    bf16x8 bwa[4], bwx[4]; float ba = 0.f, bx = 0.f, c8 = 0.f;
    u32x4 pre[2][4];
#define LRU_PREFETCH(uu) do { const int chunk_ = (uu) >> 3, nb_ = (uu) & 7; const bool smp_ = chunk_ >= 256, first_ = !smp_ && (chunk_ & 127) == 0; \
        _Pragma("unroll") for (int hh = 0; hh < 2; ++hh) _Pragma("unroll") for (int k = 0; k < 4; ++k) { const int ts = tk + 32 * hh - 3 + k; \
            if (ts >= 0 || (!smp_ && !first_)) pre[hh][k] = *(const u32x4*)(Z + (size_t)(chunk_ * 64 + ts) * ZLD + C_AX + nb_ * 128 + 8 * cg); } } while (0)
    LRU_PREFETCH(u);
    for (; u < nunits; u += c.G) {
        const int chunk = u >> 3, nblk = u & 7;
        const int row0 = chunk * 64, ch0 = nblk * 128; const bool smp = chunk >= 256; const bool first = !smp && (chunk & 127) == 0; const int bs = chunk - 256;
        if (nblk != nblk_cur) {
            nblk_cur = nblk;
            __syncthreads();
            for (int i = c.tid; i < 640; i += NTHR) { const int k = i >> 7, cc = i & 127; cwl[i] = k < 4 ? kin<10>()[(size_t)l * 4 * 1024 + k * 1024 + ch0 + cc] : kin<11>()[(size_t)l * 1024 + ch0 + cc]; }
            __syncthreads();
            const bf16_t* wat = (const bf16_t*)(kws() + WS_LRUW) + (((size_t)l * 2 + 0) * 8 + nblk) * 16384 + (size_t)(16 * w + fr) * 128 + 8 * fq;
            const bf16_t* wxt = wat + (size_t)8 * 16384;
#pragma unroll
            for (int ks = 0; ks < 4; ++ks) { bwa[ks] = *(const bf16x8*)(wat + 32 * ks); bwx[ks] = *(const bf16x8*)(wxt + 32 * ks); }
            const int ch = ch0 + 16 * w + fr;
            ba = kin<13>()[(size_t)l * 1024 + ch]; bx = kin<15>()[(size_t)l * 1024 + ch]; c8 = 8.0f * log1pf(expf(-kin<16>()[(size_t)l * 1024 + ch]));
        }
#pragma unroll
        for (int hh = 0; hh < 2; ++hh) {
            const int tt = tk + 32 * hh;
            f32x4 a0 = *(const LAS f32x4*)(cwl + 512 + 8 * cg), a1 = *(const LAS f32x4*)(cwl + 512 + 8 * cg + 4);
#pragma unroll
            for (int k = 0; k < 4; ++k) {
                const int ts = tt - 3 + k;
                f32x4 x0, x1;
                if (ts >= 0 || (!smp && !first)) { const u32x4 v = pre[hh][k];
                    x0 = (f32x4){bflo(v.x), bfhi(v.x), bflo(v.y), bfhi(v.y)}; x1 = (f32x4){bflo(v.z), bfhi(v.z), bflo(v.w), bfhi(v.w)};
                } else if (smp) {
                    const float* sp = kin<2>() + (((size_t)l * 32 + bs) * 3 + (3 + ts)) * 1024 + ch0 + 8 * cg;
                    x0 = *(const f32x4*)sp; x1 = *(const f32x4*)(sp + 4);
                } else { x0 = (f32x4){0.f, 0.f, 0.f, 0.f}; x1 = x0; }
                a0 += *(const LAS f32x4*)(cwl + k * 128 + 8 * cg) * x0; a1 += *(const LAS f32x4*)(cwl + k * 128 + 8 * cg + 4) * x1;
            }
            *(LAS f32x4*)(uf + tt * 132 + 8 * cg) = a0; *(LAS f32x4*)(uf + tt * 132 + 8 * cg + 4) = a1;
            u32x4 pw; pw.x = pk2(a0[0], a0[1]); pw.y = pk2(a0[2], a0[3]); pw.z = pk2(a1[0], a1[1]); pw.w = pk2(a1[2], a1[3]);
            *(LAS u32x4*)(ub + tt * 272 + 16 * cg) = pw;
        }
        if (u + c.G < nunits) LRU_PREFETCH(u + c.G);
        __syncthreads();
        {
            f32x4 ar[4], ai[4];
#pragma unroll
            for (int mt = 0; mt < 4; ++mt) { ar[mt] = (f32x4){0.f, 0.f, 0.f, 0.f}; ai[mt] = ar[mt]; }
#pragma unroll
            for (int ks = 0; ks < 4; ++ks)
#pragma unroll
                for (int mt = 0; mt < 4; ++mt) {
                    const bf16x8 af = *(const LAS bf16x8*)(ub + (mt * 16 + fr) * 272 + (ks * 32 + fq * 8) * 2);
                    ar[mt] = __builtin_amdgcn_mfma_f32_16x16x32_bf16(af, bwa[ks], ar[mt], 0, 0, 0);
                    ai[mt] = __builtin_amdgcn_mfma_f32_16x16x32_bf16(af, bwx[ks], ai[mt], 0, 0, 0);
                }
            const int chw = 16 * w + fr;
#pragma unroll
            for (int mt = 0; mt < 4; ++mt)
#pragma unroll
                for (int j = 0; j < 4; ++j) {
                    const int tok = mt * 16 + fq * 4 + j;
                    const float r = __builtin_amdgcn_rcpf(1.0f + __expf(-(ar[mt][j] + ba))), ig = __builtin_amdgcn_rcpf(1.0f + __expf(-(ai[mt][j] + bx)));
                    const float la = -c8 * r, a = __expf(la), x2 = 2.0f * la;
                    const float omt = -x2 * (1.0f + x2 * (0.5f + x2 * (0.16666667f + x2 * (0.041666668f + x2 * (0.0083333338f + x2 * 0.0013888889f)))));
                    const float om = x2 > -0.25f ? omt : 1.0f - a * a;
                    const float bb = __builtin_amdgcn_sqrtf(om) * (ig * uf[tok * 132 + chw]);
                    sa[tok * 128 + chw] = a; sb[tok * 128 + chw] = bb;
                }
        }
        __syncthreads();
        {
            float h = (smp && q == 0) ? kin<3>()[((size_t)l * 32 + bs) * 1024 + ch0 + chl] : 0.f, A = 1.f;
#pragma unroll 4
            for (int t = 16 * q; t < 16 * q + 16; ++t) { const float a = sa[t * 128 + chl], b = sb[t * 128 + chl]; h = a * h + b; A *= a; sb[t * 128 + chl] = h; sa[t * 128 + chl] = A; }
            tot[(q * 128 + chl) * 2] = A; tot[(q * 128 + chl) * 2 + 1] = h;
        }
        __syncthreads();
        {
            float cin = 0.f, Apre = 1.f;
            for (int qq = 0; qq < q; ++qq) { const float A = tot[(qq * 128 + chl) * 2], h = tot[(qq * 128 + chl) * 2 + 1]; cin = A * cin + h; Apre *= A; }
            unsigned* hc = (unsigned*)(kws() + WS_R1) + (size_t)row0 * 1024 + ch0 + chl;
            float h = 0.f, A = 1.f;
#pragma unroll 4
            for (int t = 16 * q; t < 16 * q + 16; ++t) { h = sb[t * 128 + chl] + sa[t * 128 + chl] * cin; A = sa[t * 128 + chl] * Apre; hc[(size_t)t * 1024] = pk2(h, A); }
            if (q == 3) { f32x2 ag = {A, h}; *(f32x2*)((float*)(kws() + WS_AGG) + ((size_t)chunk * 1024 + ch0 + chl) * 2) = ag; }
        }
        __syncthreads();
    }
#undef LRU_PREFETCH
}

DI void lru_fix_unit(const Ctx& c, int l, int chunk, int half) {
    const int cg4 = c.tid & 127, tq = c.tid >> 7, ch = half * 512 + 4 * cg4; const bool smp = chunk >= 256; const int n = smp ? 0 : (chunk & 127);
    f32x4 cr = {0.f, 0.f, 0.f, 0.f};
    const f32x4* ag = (const f32x4*)((const float*)(kws() + WS_AGG) + ((size_t)(chunk - n) * 1024 + ch) * 2);
    int i = 0;
    for (; i + 8 <= n; i += 8) {
        f32x4 a[8][2];
#pragma unroll
        for (int j = 0; j < 8; ++j) { a[j][0] = ag[(size_t)(i + j) * 512]; a[j][1] = ag[(size_t)(i + j) * 512 + 1]; }
#pragma unroll
        for (int j = 0; j < 8; ++j) { cr[0] = a[j][0][0] * cr[0] + a[j][0][1]; cr[1] = a[j][0][2] * cr[1] + a[j][0][3]; cr[2] = a[j][1][0] * cr[2] + a[j][1][1]; cr[3] = a[j][1][2] * cr[3] + a[j][1][3]; }
    }
    for (; i < n; ++i) { const f32x4 a0 = ag[(size_t)i * 512], a1 = ag[(size_t)i * 512 + 1]; cr[0] = a0[0] * cr[0] + a0[1]; cr[1] = a0[2] * cr[1] + a0[3]; cr[2] = a1[0] * cr[2] + a1[1]; cr[3] = a1[2] * cr[3] + a1[3]; }
    const unsigned* hc = (const unsigned*)(kws() + WS_R1) + (size_t)(chunk * 64 + tq) * 1024 + ch;
    const bf16_t* zg = (const bf16_t*)(kws() + WS_Z) + (size_t)(chunk * 64 + tq) * ZLD + C_AG + ch;
    bf16_t* br = (bf16_t*)(kws() + WS_BR) + (size_t)(chunk * 64 + tq) * 3072 + ch;
    u32x4 hv[16]; u32x2 gv[16];
#pragma unroll
    for (int k = 0; k < 16; ++k) { hv[k] = *(const u32x4*)(hc + (size_t)(4 * k) * 1024); gv[k] = *(const u32x2*)(zg + (size_t)(4 * k) * ZLD); }
    f32x4 h = {0.f, 0.f, 0.f, 0.f};
#pragma unroll
    for (int k = 0; k < 16; ++k) {
        h[0] = bflo(hv[k].x) + bfhi(hv[k].x) * cr[0]; h[1] = bflo(hv[k].y) + bfhi(hv[k].y) * cr[1]; h[2] = bflo(hv[k].z) + bfhi(hv[k].z) * cr[2]; h[3] = bflo(hv[k].w) + bfhi(hv[k].w) * cr[3];
        u32x2 w; w.x = pk2(h[0] * gelu_tanh(bflo(gv[k].x)), h[1] * gelu_tanh(bfhi(gv[k].x))); w.y = pk2(h[2] * gelu_tanh(bflo(gv[k].y)), h[3] * gelu_tanh(bfhi(gv[k].y)));
        *(u32x2*)(br + (size_t)(4 * k) * 3072) = w;
    }
    if (tq == 3) {
        if (smp) *(f32x4*)(kout() + O_SLRU + ((size_t)l * 32 + (chunk - 256)) * 1024 + ch) = h;
        else if (n == 127) *(f32x4*)(kout() + O_PLRU + ((size_t)l * 2 + (chunk >> 7)) * 1024 + ch) = h;
    }
}

#define MFMA32(a, b, cc) __builtin_amdgcn_mfma_f32_32x32x16_bf16((a), (b), (cc), 0, 0, 0)
typedef short s16x4 __attribute__((ext_vector_type(4)));
template <int MODE, class Src>
DI void attn_item(LAS unsigned char* lds, const Src& src, const bf16_t* Qp  , bf16_t* Op  , int nband, int jj0, float sink_l2, const LAS float* tbl, int qbase, int tid) {
    constexpr int NT = MODE ? 4 : 1, NL = 2 * NT;
    const int lane = tid & 63, w = __builtin_amdgcn_readfirstlane(tid >> 6), r = lane & 31, h = lane >> 5;
    const int hl = MODE ? (w >> 1) : 0;
    const int lq = lane >> 4, chp = lane & 15;
#define ATT_ISSUE(jj_, isV_) do { _Pragma("unroll") for (int i_ = 0; i_ < NL; ++i_) { \
        const int t_ = MODE ? (w >> 1) : 0, rowb_ = MODE ? ((w & 1) * 32 + 4 * i_) : (8 * w + 4 * i_); \
        const int row_ = rowb_ + lq, ch_ = chp ^ ((lq << 2) | ((rowb_ >> 2) & 3)); \
        const bf16_t* base_; int st_; src.get((jj_), t_, (isV_), base_, st_); \
        __builtin_amdgcn_global_load_lds((const unsigned*)(base_ + (size_t)row_ * st_ + ch_ * 8), (LAS unsigned*)(lds + ((isV_) ? 65536 : 0) + t_ * 16384 + rowb_ * 256), 16, 0, 0); } } while (0)
    bf16x8 qf[8];
#pragma unroll
    for (int ks = 0; ks < 8; ++ks) qf[ks] = *(const bf16x8*)(Qp + (size_t)r * ZLD + ks * 16 + h * 8);
    f32x16 o[4];
#pragma unroll
    for (int db = 0; db < 4; ++db)
#pragma unroll
        for (int i = 0; i < 16; ++i) o[db][i] = 0.f;
    float mrun = MODE == 0 ? sink_l2 : -1e30f, lrun = MODE == 0 ? 1.f : 0.f;
    const float sc = 0.08838834764831845f * LOG2E;
    const LAS unsigned char* Kt = lds + hl * 16384 + 256 * r;
    const int kx = 16 * (h ^ (((r & 3) << 2) | ((r >> 2) & 3)));
    const int blk = (lane >> 4) & 1, q = (lane & 15) >> 2, p = lane & 3;
    const LAS unsigned char* Vt = lds + 65536 + hl * 16384 + 256 * (4 * h + q) + 8 * (p & 1);
    const int vlo = 2 * blk + (p >> 1);
    ATT_ISSUE(jj0, false); ATT_ISSUE(jj0, true);
    for (int jj = jj0; jj < nband; ++jj) {
        const bool last = (jj == nband - 1);
        if (MODE) asm volatile("s_waitcnt vmcnt(8)" ::: "memory"); else asm volatile("s_waitcnt vmcnt(2)" ::: "memory");
        __builtin_amdgcn_s_barrier(); asm volatile("" ::: "memory");
        f32x16 s[2];
#pragma unroll
        for (int kb = 0; kb < 2; ++kb) {
#pragma unroll
            for (int i = 0; i < 16; ++i) s[kb][i] = 0.f;
#pragma unroll
            for (int ks = 0; ks < 8; ++ks) { const bf16x8 kf = *(const LAS bf16x8*)(Kt + 8192 * kb + ((32 * ks) ^ kx)); s[kb] = MFMA32(kf, qf[ks], s[kb]); }
        }
        asm volatile("s_waitcnt lgkmcnt(0)" ::: "memory"); __builtin_amdgcn_s_barrier(); asm volatile("" ::: "memory");
        if (!last) ATT_ISSUE(jj + 1, false);
        const bool cb = MODE == 0 || jj <= 5; const float bc = (MODE == 1 && cb) ? tbl[256] : 0.f, esc = cb ? sc : 1.0f;
        if (!cb) {
#pragma unroll
            for (int kb = 0; kb < 2; ++kb) {
                const int dbase = qbase + r - kb * 32 - 4 * h + (8 - jj) * 64 + 128;
#pragma unroll
                for (int i = 0; i < 16; ++i) { int idx = dbase - ((i & 3) + 8 * (i >> 2)); idx = idx > 256 ? 256 : idx; idx = idx < 0 ? 0 : idx; s[kb][i] = s[kb][i] * sc + tbl[idx]; }
            }
        }
        float bm = fmaxf(s[0][0], s[1][0]);
#pragma unroll
        for (int i = 1; i < 16; ++i) bm = fmaxf(bm, fmaxf(s[0][i], s[1][i]));
        bm = bm * esc + bc;
        bm = fmaxf(bm, __shfl_xor(bm, 32));
        if (__builtin_amdgcn_ballot_w64(bm > mrun + 8.0f) != 0ull) {
            const float mnew = fmaxf(mrun, bm), alpha = __builtin_amdgcn_exp2f(mrun - mnew);
            lrun *= alpha; mrun = mnew;
#pragma unroll
            for (int db = 0; db < 4; ++db)
#pragma unroll
                for (int i = 0; i < 16; ++i) o[db][i] *= alpha;
        }
        float ps = 0.f; const float eoff = bc - mrun;
#pragma unroll
        for (int kb = 0; kb < 2; ++kb)
#pragma unroll
            for (int i = 0; i < 16; ++i) { s[kb][i] = __builtin_amdgcn_exp2f(__builtin_fmaf(s[kb][i], esc, eoff)); ps += s[kb][i]; }
        ps += __shfl_xor(ps, 32);
        lrun += ps;
        if (last) asm volatile("s_waitcnt vmcnt(0)" ::: "memory"); else { if (MODE) asm volatile("s_waitcnt vmcnt(8)" ::: "memory"); else asm volatile("s_waitcnt vmcnt(2)" ::: "memory"); }
        __builtin_amdgcn_s_barrier(); asm volatile("" ::: "memory");
#pragma unroll
        for (int kb = 0; kb < 2; ++kb)
#pragma unroll
            for (int st = 0; st < 2; ++st) {
                u32x4 pp; pp.x = pk2(s[kb][8 * st + 0], s[kb][8 * st + 1]); pp.y = pk2(s[kb][8 * st + 2], s[kb][8 * st + 3]); pp.z = pk2(s[kb][8 * st + 4], s[kb][8 * st + 5]); pp.w = pk2(s[kb][8 * st + 6], s[kb][8 * st + 7]);
                const bf16x8 pf = __builtin_bit_cast(bf16x8, pp);
#pragma unroll
                for (int db = 0; db < 4; ++db) {
                    s16x4 v2[2];
#pragma unroll
                    for (int t = 0; t < 2; ++t) {
                        const int f = (q << 2) | ((2 * t + h) & 3);
                        v2[t] = __builtin_amdgcn_ds_read_tr16_b64_v4i16((LAS s16x4*)(Vt + 256 * (32 * kb + 16 * st + 8 * t) + 16 * ((4 * db + vlo) ^ f)));
                    }
                    const bf16x8 vf = __builtin_shufflevector(v2[0], v2[1], 0, 1, 2, 3, 4, 5, 6, 7);
                    o[db] = MFMA32(vf, pf, o[db]);
                }
            }
        asm volatile("s_waitcnt lgkmcnt(0)" ::: "memory"); __builtin_amdgcn_s_barrier(); asm volatile("" ::: "memory");
        if (!last) ATT_ISSUE(jj + 1, true);
    }
#undef ATT_ISSUE
    const float inv = 1.0f / lrun;
#pragma unroll
    for (int db = 0; db < 4; ++db)
#pragma unroll
        for (int g = 0; g < 4; ++g) {
            u32x2 wv; wv.x = pk2(o[db][4 * g] * inv, o[db][4 * g + 1] * inv); wv.y = pk2(o[db][4 * g + 2] * inv, o[db][4 * g + 3] * inv);
            *(u32x2*)(Op + (size_t)r * 3072 + db * 32 + 8 * g + 4 * h) = wv;
        }
}
DI void attn_quad(LAS unsigned char* lds, const bf16_t* Z, bf16_t* BR, int c0  , int head, const LAS float* tbl, int tid) {
    const int lane = tid & 63, w = __builtin_amdgcn_readfirstlane(tid >> 6), r = lane & 31, h = lane >> 5;
    const int qc = w >> 1, qh = w & 1;
    const int lq = lane >> 4, chp = lane & 15;
    const int n0 = c0 & 127, j0 = n0 < 8 ? 8 - n0 : 0;
    const bf16_t* Qp = Z + (size_t)((c0 + qc) * 64 + qh * 32) * ZLD + C_QC + head * 128;
    bf16_t* Op = BR + (size_t)((c0 + qc) * 64 + qh * 32) * 3072 + 2048 + head * 128;
#define AQ_ISSUE(j_) do { const bf16_t* kb_ = Z + (size_t)(c0 - 8 + (j_)) * 64 * ZLD + C_KC + head * 128; LAS unsigned char* st_ = lds + ((j_) & 3) * 32768; \
        _Pragma("unroll") for (int i_ = 0; i_ < 2; ++i_) { const int rowb_ = 8 * w + 4 * i_, row_ = rowb_ + lq, ch_ = chp ^ ((lq << 2) | ((rowb_ >> 2) & 3)); \
            __builtin_amdgcn_global_load_lds((const unsigned*)(kb_ + (size_t)row_ * ZLD + ch_ * 8), (LAS unsigned*)(st_ + rowb_ * 256), 16, 0, 0); \
            __builtin_amdgcn_global_load_lds((const unsigned*)(kb_ + (C_VC - C_KC) + (size_t)row_ * ZLD + ch_ * 8), (LAS unsigned*)(st_ + 16384 + rowb_ * 256), 16, 0, 0); } } while (0)
    bf16x8 qf[8];
#pragma unroll
    for (int ks = 0; ks < 8; ++ks) qf[ks] = *(const bf16x8*)(Qp + (size_t)r * ZLD + ks * 16 + h * 8);
    f32x16 o[4];
#pragma unroll
    for (int db = 0; db < 4; ++db)
#pragma unroll
        for (int i = 0; i < 16; ++i) o[db][i] = 0.f;
    float mrun = -1e30f, lrun = 0.f;
    const float sc = 0.08838834764831845f * LOG2E;
    const int kx = 16 * (h ^ (((r & 3) << 2) | ((r >> 2) & 3)));
    const int blk = (lane >> 4) & 1, q = (lane & 15) >> 2, p = lane & 3;
    const int vlo = 2 * blk + (p >> 1);
    const int qbase = qh * 32;
    AQ_ISSUE(j0); if (j0 + 1 < 12) AQ_ISSUE(j0 + 1); if (j0 + 2 < 12) AQ_ISSUE(j0 + 2);
    for (int j = j0; j < 12; ++j) {
        if (j + 2 < 12) asm volatile("s_waitcnt vmcnt(8)" ::: "memory"); else if (j + 1 < 12) asm volatile("s_waitcnt vmcnt(4)" ::: "memory"); else asm volatile("s_waitcnt vmcnt(0)" ::: "memory");
        asm volatile("s_waitcnt lgkmcnt(0)" ::: "memory"); __builtin_amdgcn_s_barrier(); asm volatile("" ::: "memory");
        if (j + 3 < 12) AQ_ISSUE(j + 3);
        const int jj = j - qc;
        if (jj < 0 || jj > 8) continue;
        const LAS unsigned char* Kt = lds + (j & 3) * 32768 + 256 * r;
        const LAS unsigned char* Vt = lds + (j & 3) * 32768 + 16384 + 256 * (4 * h + q) + 8 * (p & 1);
        f32x16 s[2];
#pragma unroll
        for (int kb = 0; kb < 2; ++kb) {
#pragma unroll
            for (int i = 0; i < 16; ++i) s[kb][i] = 0.f;
#pragma unroll
            for (int ks = 0; ks < 8; ++ks) { const bf16x8 kf = *(const LAS bf16x8*)(Kt + 8192 * kb + ((32 * ks) ^ kx)); s[kb] = MFMA32(kf, qf[ks], s[kb]); }
        }
        const bool cb = jj <= 5; const float bc = cb ? tbl[256] : 0.f, esc = cb ? sc : 1.0f;
        if (!cb) {
#pragma unroll
            for (int kb = 0; kb < 2; ++kb) {
                const int dbase = qbase + r - kb * 32 - 4 * h + (8 - jj) * 64 + 128;
#pragma unroll
                for (int i = 0; i < 16; ++i) { int idx = dbase - ((i & 3) + 8 * (i >> 2)); idx = idx > 256 ? 256 : idx; idx = idx < 0 ? 0 : idx; s[kb][i] = s[kb][i] * sc + tbl[idx]; }
            }
        }
        float bm = fmaxf(s[0][0], s[1][0]);
#pragma unroll
        for (int i = 1; i < 16; ++i) bm = fmaxf(bm, fmaxf(s[0][i], s[1][i]));
        bm = bm * esc + bc;
        bm = fmaxf(bm, __shfl_xor(bm, 32));
        if (__builtin_amdgcn_ballot_w64(bm > mrun + 8.0f) != 0ull) {
            const float mnew = fmaxf(mrun, bm), alpha = __builtin_amdgcn_exp2f(mrun - mnew);
            lrun *= alpha; mrun = mnew;
#pragma unroll
            for (int db = 0; db < 4; ++db)
#pragma unroll
                for (int i = 0; i < 16; ++i) o[db][i] *= alpha;
        }
        float ps = 0.f; const float eoff = bc - mrun;
#pragma unroll
        for (int kb = 0; kb < 2; ++kb)
#pragma unroll
            for (int i = 0; i < 16; ++i) { s[kb][i] = __builtin_amdgcn_exp2f(__builtin_fmaf(s[kb][i], esc, eoff)); ps += s[kb][i]; }
        ps += __shfl_xor(ps, 32);
        lrun += ps;
#pragma unroll
        for (int kb = 0; kb < 2; ++kb)
#pragma unroll
            for (int st = 0; st < 2; ++st) {
                u32x4 pp; pp.x = pk2(s[kb][8 * st + 0], s[kb][8 * st + 1]); pp.y = pk2(s[kb][8 * st + 2], s[kb][8 * st + 3]); pp.z = pk2(s[kb][8 * st + 4], s[kb][8 * st + 5]); pp.w = pk2(s[kb][8 * st + 6], s[kb][8 * st + 7]);
                const bf16x8 pf = __builtin_bit_cast(bf16x8, pp);
#pragma unroll
                for (int db = 0; db < 4; ++db) {
                    s16x4 v2[2];
#pragma unroll
                    for (int t = 0; t < 2; ++t) {
                        const int f = (q << 2) | ((2 * t + h) & 3);
                        v2[t] = __builtin_amdgcn_ds_read_tr16_b64_v4i16((LAS s16x4*)(Vt + 256 * (32 * kb + 16 * st + 8 * t) + 16 * ((4 * db + vlo) ^ f)));
                    }
                    const bf16x8 vf = __builtin_shufflevector(v2[0], v2[1], 0, 1, 2, 3, 4, 5, 6, 7);
                    o[db] = MFMA32(vf, pf, o[db]);
                }
            }
    }
#undef AQ_ISSUE
    asm volatile("s_waitcnt lgkmcnt(0)" ::: "memory"); __builtin_amdgcn_s_barrier(); asm volatile("" ::: "memory");
    const float inv = 1.0f / lrun;
#pragma unroll
    for (int db = 0; db < 4; ++db)
#pragma unroll
        for (int g = 0; g < 4; ++g) {
            u32x2 wv; wv.x = pk2(o[db][4 * g] * inv, o[db][4 * g + 1] * inv); wv.y = pk2(o[db][4 * g + 2] * inv, o[db][4 * g + 3] * inv);
            *(u32x2*)(Op + (size_t)r * 3072 + db * 32 + 8 * g + 4 * h) = wv;
        }
}
struct SrcSwa {
    const bf16_t* Z; const bf16_t* KcB; const bf16_t* VcB; int chunk, kv;
    DI void get(int jj, int t, bool isV, const bf16_t*& base, int& st) const {
        if (chunk < 256) { const int cc = chunk - 2 + jj; base = Z + (size_t)cc * 64 * ZLD + (isV ? C_VB : C_KB) + kv * 128; st = ZLD; return; }
        const int bs = chunk - 256;
        if (jj < 2) { base = (isV ? VcB : KcB) + (size_t)(bs * 128 + jj * 64) * 256 + kv * 128; st = 256; return; }
        base = Z + (size_t)chunk * 64 * ZLD + (isV ? C_VB : C_KB) + kv * 128; st = ZLD;
    }
};
struct SrcCb {
    const bf16_t* Z; const bf16_t* KcC; const bf16_t* VcC; int chunk, head0;
    DI void get(int jj, int t, bool isV, const bf16_t*& base, int& st) const {
        const int head = head0 + t;
        if (chunk < 256) { const int cc = chunk - 8 + jj; base = Z + (size_t)cc * 64 * ZLD + (isV ? C_VC : C_KC) + head * 128; st = ZLD; return; }
        const int bs = chunk - 256;
        if (jj < 8) { base = (isV ? VcC : KcC) + (size_t)(bs * 512 + jj * 64) * 1024 + head * 128; st = 1024; return; }
        base = Z + (size_t)chunk * 64 * ZLD + (isV ? C_VC : C_KC) + head * 128; st = ZLD;
    }
};

DI void copy_state(const Ctx& c, float* dst, int nb, int rows, int width, int row0, int bstride, int col) {
    const bf16_t* Z = (const bf16_t*)(kws() + WS_Z);
    const int w8 = width >> 3; const size_t total = (size_t)nb * rows * w8;
    for (size_t i = (size_t)c.bid * NTHR + c.tid; i < total; i += (size_t)c.G * NTHR) {
        const int e = (int)(i % w8); const size_t rt = i / w8; const int t = (int)(rt % rows), b = (int)(rt / rows);
        const u32x4 v = *(const u32x4*)(Z + (size_t)(row0 + b * bstride + t) * ZLD + col + 8 * e);
        f32x4* d = (f32x4*)(dst + ((size_t)(b * rows + t) * width + 8 * e));
        d[0] = (f32x4){bflo(v.x), bfhi(v.x), bflo(v.y), bfhi(v.y)}; d[1] = (f32x4){bflo(v.z), bfhi(v.z), bflo(v.w), bfhi(v.w)};
    }
}

DI void inproj_tail_combine(const Ctx& c) {
    const float* part = (const float*)(kws() + WS_PART); const float* rs = (const float*)(kws() + WS_RS); bf16_t* Z = (bf16_t*)(kws() + WS_Z);
    for (int i = c.bid * NTHR + c.tid; i < 16 * 8192; i += c.G * NTHR) {
        const int tile = i >> 13, e = i & 8191, r = e >> 5, c8 = (e & 31) * 8, row = 71 * 256 + r;
        const float* p = part + ((size_t)tile * 256 + r) * 256 + c8;
        f32x4 v0 = *(const f32x4*)p, v1 = *(const f32x4*)(p + 4);
#pragma unroll
        for (int ks = 1; ks < 8; ++ks) { v0 += *(const f32x4*)(p + (size_t)ks * 16 * 65536); v1 += *(const f32x4*)(p + (size_t)ks * 16 * 65536 + 4); }
        const float sc = rs[row];
#pragma unroll
        for (int j = 0; j < 4; ++j) { v0[j] = __builtin_amdgcn_rcpf(1.0f + __expf(-v0[j] * sc)); v1[j] = __builtin_amdgcn_rcpf(1.0f + __expf(-v1[j] * sc)); }
        *(u32x2*)((unsigned char*)(kws() + WS_GATE) + (((size_t)71 * 24 + tile) * 256 + r) * 256 + c8) = pg8::packq8(v0, v1);
    }
}
DI void phase_postD(const Ctx& c) {
    const float* part = (const float*)(kws() + WS_PART); bf16_t* act = (bf16_t*)(kws() + WS_ACT2) + (size_t)MP * DM;
    const size_t total = (size_t)MS * DM / 8;
    for (size_t i = (size_t)c.bid * NTHR + c.tid; i < total; i += (size_t)c.G * NTHR) {
        const f32x4* p = (const f32x4*)part + 2 * i; const size_t st = (size_t)MS * DM / 4;
        const f32x4 v0 = p[0] + p[st] + p[2 * st], v1 = p[1] + p[st + 1] + p[2 * st + 1];
        ((u32x4*)act)[i] = pg8::pack8(v0, v1);
    }
}
DI void phase_postRes(const Ctx& c, const float* xinS  ) {
    const int gw = c.bid * NWAVES + c.wave, NGW = c.G * NWAVES;
    bf16_t* act = (bf16_t*)(kws() + WS_ACT); float* rs = (float*)(kws() + WS_RS); const float* part = (const float*)(kws() + WS_PART);
    for (int row = MP + gw; row < M; row += NGW) {
        const f32x4* pr = (const f32x4*)(part + (size_t)(row - MP) * DM) + c.lane; const size_t st = (size_t)MS * DM / 4;
        u32x2* ao = (u32x2*)(act + (size_t)row * DM) + c.lane;
        float s = 0.f;
#pragma unroll
        for (int j = 0; j < 8; ++j) {
            f32x4 xi;
            if (xinS) xi = ((const f32x4*)(xinS + (size_t)(row - MP) * DM) + c.lane)[64 * j];
            else { const u32x2 w = ao[64 * j]; xi = (f32x4){bflo(w.x), bfhi(w.x), bflo(w.y), bfhi(w.y)}; }
            const f32x4 v = xi + ((pr[64 * j] + pr[st + 64 * j]) + (pr[2 * st + 64 * j] + pr[3 * st + 64 * j]));
            u32x2 w; w.x = pk2(v[0], v[1]); w.y = pk2(v[2], v[3]); ao[64 * j] = w;
            s += (v[0] * v[0] + v[1] * v[1]) + (v[2] * v[2] + v[3] * v[3]);
        }
        s = wave_sum(s);
        if (c.lane == 0) rs[row] = 1.0f / sqrtf(s * (1.0f / DM) + EPS);
    }
    const float* ssq = (const float*)(kws() + WS_SSQ);
    for (int row = c.bid * NTHR + c.tid; row < MP; row += c.G * NTHR) {
        const f32x4* q = (const f32x4*)(ssq + (size_t)row * 32); float s = 0.f;
#pragma unroll
        for (int j = 0; j < 8; ++j) { const f32x4 v = q[j]; s += (v[0] + v[1]) + (v[2] + v[3]); }
        rs[row] = 1.0f / sqrtf(s * (1.0f / DM) + EPS);
    }
}

DI void phase_postRes_final(const Ctx& c) {
    const int gw = c.bid * NWAVES + c.wave, NGW = c.G * NWAVES;
    const bf16_t* act = (const bf16_t*)(kws() + WS_ACT); const float* part = (const float*)(kws() + WS_PART); const float* ssq = (const float*)(kws() + WS_SSQ);
    const f32x4* gp = (const f32x4*)kin<24>() + c.lane;
    f32x4 gv[8];
#pragma unroll
    for (int j = 0; j < 8; ++j) gv[j] = gp[64 * j];
    for (int row = MP + gw; row < M; row += NGW) {
        const f32x4* pr = (const f32x4*)(part + (size_t)(row - MP) * DM) + c.lane; const size_t st = (size_t)MS * DM / 4;
        const u32x2* ai = (const u32x2*)(act + (size_t)row * DM) + c.lane; f32x4* yr = (f32x4*)(kout() + (size_t)row * DM) + c.lane;
        f32x4 v[8]; float s = 0.f;
#pragma unroll
        for (int j = 0; j < 8; ++j) { const u32x2 w = ai[64 * j]; const f32x4 xi = {bflo(w.x), bfhi(w.x), bflo(w.y), bfhi(w.y)};
            v[j] = xi + ((pr[64 * j] + pr[st + 64 * j]) + (pr[2 * st + 64 * j] + pr[3 * st + 64 * j])); s += (v[j][0] * v[j][0] + v[j][1] * v[j][1]) + (v[j][2] * v[j][2] + v[j][3] * v[j][3]); }
        s = wave_sum(s); const float r = 1.0f / sqrtf(s * (1.0f / DM) + EPS);
#pragma unroll
        for (int j = 0; j < 8; ++j) yr[64 * j] = v[j] * r * gv[j];
    }
    for (int row = gw; row < MP; row += NGW) {
        float s = c.lane < 32 ? ssq[(size_t)row * 32 + c.lane] : 0.f; s = wave_sum(s); const float r = 1.0f / sqrtf(s * (1.0f / DM) + EPS);
        const u32x2* xr = (const u32x2*)(act + (size_t)row * DM) + c.lane; f32x4* yr = (f32x4*)(kout() + (size_t)row * DM) + c.lane;
#pragma unroll
        for (int j = 0; j < 8; ++j) { const u32x2 w = xr[64 * j]; yr[64 * j] = (f32x4){bflo(w.x), bfhi(w.x), bflo(w.y), bfhi(w.y)} * r * gv[j]; }
    }
}

struct Args { const float* in[25]; float* out; unsigned char* ws; int ph_lo, ph_hi; };
constexpr int PH_PER_LAYER = 11, PH_FINAL = 1 + DEPTH * PH_PER_LAYER, PH_COUNT = PH_FINAL + 1;

__global__ void __launch_bounds__(NTHR, 2) fwd_kernel(Args args) {
    extern __shared__ __attribute__((aligned(16))) unsigned char lds_raw[];
    LAS unsigned char* const lds = (LAS unsigned char*)lds_raw;
    volatile LAS unsigned* misc = (volatile LAS unsigned*)(lds + LDS_MISC);
    if (threadIdx.x < 4) misc[threadIdx.x] = 0u;
    __syncthreads();
    const int lo = args.ph_lo, hi = args.ph_hi;
    XcdBarrier bar; bar.bar = (unsigned*)(kws() + WS_BAR); bar.x = 0; bar.st = misc;
    if (hi - lo > 1) bar = xcd_barrier_post((unsigned*)(kws() + WS_BAR), misc);
#define IN(k) (lo <= (k) && (k) < hi)
#define SEAM(k) do { if ((k) + 1 < hi) { bar.bar = (unsigned*)(kws() + WS_BAR); xcd_barrier(bar); } } while (0)
#define WSP(T, off) ((T*)(kws() + (off)))
#ifndef PHMASK
#define PHMASK 0xFFFF
#endif
#define PHON(j) ((PHMASK >> (j)) & 1)
#ifndef PROBE_MASK
#define PROBE_MASK 0
#endif
#define REP(j) for (int rep_ = 0; rep_ < 1 + ((PROBE_MASK >> (j)) & 1); ++rep_)
    if (PHON(14) && IN(0)) { REP(14) { const Ctx c = make_ctx(lds); phase_prologue(c); phase_norm(c, kin<0>(), kin<1>() - (size_t)MP * DM); } SEAM(0); }

    for (int l = 0; l < DEPTH; ++l) {
        const int pb = 1 + l * PH_PER_LAYER;
        if (PHON(1) && IN(pb + 1)) {
            pg8::InprojOrder S{{WSP(bf16_t, WS_ACT), WSP(bf16_t, WS_W) + (size_t)l * WL_SIZE + WL_IN, DM, DM}, (int)gridDim.x, (int)blockIdx.x};
            pg8::EpiInproj E{WSP(bf16_t, WS_Z), WSP(float, WS_RS), WSP(float, WS_PART), WSP(unsigned char, WS_GATE)};
            REP(1) pg8::gemm_phase(lds, S, E);
            {
                const Ctx c = make_ctx(lds); const int extra = (3584 + 128) % c.G;
                if (extra == 0 || c.bid >= extra) phase_cacheconv(c, l, extra == 0 ? c.bid : c.bid - extra, extra == 0 ? c.G : c.G - extra);
            }
            SEAM(pb + 1);
        }
        if (PHON(2) && IN(pb + 2)) {
            const Ctx c = make_ctx(lds);
            inproj_tail_combine(c);
            REP(12) lru_local_phase(c, l);
            REP(13) for (int u = c.bid; u < (c.G >= 128 ? 512 : NCHUNK * 2); u += c.G) {
                const int chunk = u >> 1, kv = u & 1, head = kv * 4 + (c.wave >> 1), qh = c.wave & 1;
                const bf16_t* Z = WSP(bf16_t, WS_Z);
                SrcSwa src{Z, WSP(bf16_t, WS_KCB), WSP(bf16_t, WS_VTCB), chunk, kv};
                const int n = chunk & 127, jj0 = (chunk < 256 && n < 2) ? 2 - n : 0;
                attn_item<0>(c.lds, src, Z + (size_t)(chunk * 64 + qh * 32) * ZLD + C_QB + head * 128, WSP(bf16_t, WS_BR) + (size_t)(chunk * 64 + qh * 32) * 3072 + 1024 + head * 128, 3, jj0,
                             kin<17>()[l * 8 + head] * LOG2E, nullptr, 0, c.tid);
            }
            SEAM(pb + 2);
        }
        if (PHON(3) && IN(pb + 3)) {
            const Ctx c = make_ctx(lds);
            LAS float* tbl = (LAS float*)(c.lds + LDS_TBL);
            for (int i = c.tid; i < 8 * 257; i += NTHR) { const int hh = i / 257, e = i - hh * 257; tbl[hh * 260 + e] = kin<18>()[(size_t)l * 8 * 257 + i] * LOG2E; }
            __syncthreads();
            REP(3) {
            {
                const bf16_t* Z = WSP(bf16_t, WS_Z);
                for (int u = c.bid; u < 512; u += c.G) {
                    const int x = u & 7, k = u >> 3;
                    attn_quad(c.lds, Z, WSP(bf16_t, WS_BR), 4 * k, x, tbl + x * 260, c.tid);
                }
            }
            {
                const int nsmp = c.G >= 128 ? 64 : 0;
                if (c.bid < nsmp || nsmp == 0) {
                    for (int u = c.bid; u < 64; u += (nsmp ? nsmp : c.G)) {
                        const int hg = u & 1, chunk = 256 + (u >> 1), head = hg * 4 + (c.wave >> 1), qh = c.wave & 1;
                        const bf16_t* Z = WSP(bf16_t, WS_Z);
                        SrcCb src{Z, WSP(bf16_t, WS_KCC), WSP(bf16_t, WS_VTCC), chunk, hg * 4};
                        attn_item<1>(c.lds, src, Z + (size_t)(chunk * 64 + qh * 32) * ZLD + C_QC + head * 128, WSP(bf16_t, WS_BR) + (size_t)(chunk * 64 + qh * 32) * 3072 + 2048 + head * 128, 9, 0,
                                     0.f, tbl + head * 260, qh * 32, c.tid);
                    }
                    if (nsmp) {
                        const int u = 512 + c.bid, chunk = u >> 1, kv = u & 1, head = kv * 4 + (c.wave >> 1), qh = c.wave & 1;
                        const bf16_t* Z = WSP(bf16_t, WS_Z);
                        SrcSwa src{Z, WSP(bf16_t, WS_KCB), WSP(bf16_t, WS_VTCB), chunk, kv};
                        attn_item<0>(c.lds, src, Z + (size_t)(chunk * 64 + qh * 32) * ZLD + C_QB + head * 128, WSP(bf16_t, WS_BR) + (size_t)(chunk * 64 + qh * 32) * 3072 + 1024 + head * 128, 3, 0,
                                     kin<17>()[l * 8 + head] * LOG2E, nullptr, 0, c.tid);
                    }
                }
                if (c.bid >= nsmp) for (int u = c.bid - nsmp; u < NCHUNK * 2; u += c.G - nsmp) lru_fix_unit(c, l, u >> 1, u & 1);
            }
            copy_state(c, kout() + O_PCONV + (size_t)l * 2 * 3 * 1024, 2, 3, 1024, 8189, 8192, C_AX);
            copy_state(c, kout() + O_SCONV + (size_t)l * 32 * 3 * 1024, 32, 3, 1024, MP + 61, 64, C_AX);
            copy_state(c, kout() + O_PSWAK + (size_t)l * 2 * 128 * 256, 2, 128, 256, 8192 - 128, 8192, C_KB);
            copy_state(c, kout() + O_PSWAV + (size_t)l * 2 * 128 * 256, 2, 128, 256, 8192 - 128, 8192, C_VB);
            copy_state(c, kout() + O_PCBK + (size_t)l * 2 * 512 * 1024, 2, 512, 1024, 8192 - 512, 8192, C_KC);
            copy_state(c, kout() + O_PCBV + (size_t)l * 2 * 512 * 1024, 2, 512, 1024, 8192 - 512, 8192, C_VC);
            copy_state(c, kout() + O_SSWAK + (size_t)l * 32 * 64 * 256, 32, 64, 256, MP, 64, C_KB);
            copy_state(c, kout() + O_SSWAV + (size_t)l * 32 * 64 * 256, 32, 64, 256, MP, 64, C_VB);
            copy_state(c, kout() + O_SCBK + (size_t)l * 32 * 64 * 1024, 32, 64, 1024, MP, 64, C_KC);
            copy_state(c, kout() + O_SCBV + (size_t)l * 32 * 64 * 1024, 32, 64, 1024, MP, 64, C_VC);
            }
            SEAM(pb + 3);
        }
        if (PHON(4) && IN(pb + 4)) {
            pg8::SplitOrder S{{WSP(bf16_t, WS_BR), WSP(bf16_t, WS_W) + (size_t)l * WL_SIZE + WL_BR, 3 * BW, 3 * BW}, (int)gridDim.x, (int)blockIdx.x, 3 * BW / 64, 3, BW / 64};
            pg8::EpiD E{WSP(unsigned char, WS_GATE), WSP(bf16_t, WS_ACT2), WSP(float, WS_PART)};
            pg8::gemm_phase(lds, S, E);
            SEAM(pb + 4);
        }
        if (PHON(5) && IN(pb + 5)) { const Ctx c = make_ctx(lds); phase_postD(c); SEAM(pb + 5); }
        if (PHON(6) && IN(pb + 6)) {
            pg8::SplitOrder S{{WSP(bf16_t, WS_ACT2), WSP(bf16_t, WS_W) + (size_t)l * WL_SIZE + WL_OUT, DM, DM}, (int)gridDim.x, (int)blockIdx.x, DM / 64, 4, DM / 256};
            if (l == 0) { pg8::EpiRes<true> E{kin<0>(), WSP(bf16_t, WS_ACT), WSP(float, WS_SSQ), WSP(float, WS_PART)}; pg8::gemm_phase(lds, S, E); }
            else { pg8::EpiRes<false> E{nullptr, WSP(bf16_t, WS_ACT), WSP(float, WS_SSQ), WSP(float, WS_PART)}; pg8::gemm_phase(lds, S, E); }
            SEAM(pb + 6);
        }
        if (PHON(7) && IN(pb + 7)) { const Ctx c = make_ctx(lds); phase_postRes(c, l == 0 ? kin<1>() : nullptr); SEAM(pb + 7); }
        if (PHON(8) && IN(pb + 8)) {
            pg8::FullOrder S{{WSP(bf16_t, WS_ACT), WSP(bf16_t, WS_W) + (size_t)l * WL_SIZE + WL_UP, DM, DM}, M / 256, DFF / 256, (int)gridDim.x, (int)blockIdx.x, DM / 64};
            pg8::EpiUp E{WSP(bf16_t, WS_Z)  , WSP(float, WS_RS)};
            REP(8) pg8::gemm_phase(lds, S, E);
            SEAM(pb + 8);
        }
        if (PHON(9) && IN(pb + 9)) {
            pg8::SplitOrder S{{WSP(bf16_t, WS_Z), WSP(bf16_t, WS_W) + (size_t)l * WL_SIZE + WL_DOWN, DFF, DFF}, (int)gridDim.x, (int)blockIdx.x, DFF / 64, 4, DFF / 256};
            pg8::EpiRes<false> E{nullptr, WSP(bf16_t, WS_ACT), WSP(float, WS_SSQ), WSP(float, WS_PART)};
            pg8::gemm_phase(lds, S, E);
            SEAM(pb + 9);
        }
        if (PHON(10) && IN(pb + 10)) { const Ctx c = make_ctx(lds); if (l == DEPTH - 1) phase_postRes_final(c); else { phase_postRes(c, nullptr); SEAM(pb + 10); } }
    }
#undef IN
#undef SEAM
}

#ifndef N_LAUNCH_MODE
#define N_LAUNCH_MODE 1
#endif
extern "C" void kernel_launch(void* const* d_in, const int* in_sizes, int n_in, void* d_out, int out_size, void* d_ws, size_t ws_size, hipStream_t stream) {
    static int grid = 0;
    if (grid == 0) {
        if (n_in != 25 || (size_t)out_size != O_END || ws_size < WS_END) { fprintf(stderr, "kernel_launch: unexpected sizes (n_in %d out %d ws %zu need %zu)\n", n_in, out_size, ws_size, (size_t)WS_END); grid = -1; return; }
        int dev = 0, cus = 0, per_cu = 0;
        if (hipGetDevice(&dev) != hipSuccess || hipDeviceGetAttribute(&cus, hipDeviceAttributeMultiprocessorCount, dev) != hipSuccess) { grid = -1; return; }
        if (hipFuncSetAttribute((const void*)fwd_kernel, hipFuncAttributeMaxDynamicSharedMemorySize, LDS_BYTES) != hipSuccess) { fprintf(stderr, "kernel_launch: hipFuncSetAttribute failed\n"); grid = -1; return; }
        if (hipOccupancyMaxActiveBlocksPerMultiprocessor(&per_cu, (const void*)fwd_kernel, NTHR, LDS_BYTES) != hipSuccess || per_cu < 1) { fprintf(stderr, "kernel_launch: occupancy query says %d\n", per_cu); (void)hipGetLastError(); grid = -1; return; }
        grid = cus;
    }
    if (grid < 0) return;
    (void)hipMemsetAsync((char*)d_ws + WS_BAR, 0, 16384, stream);
    Args a{};
    for (int i = 0; i < 25; ++i) a.in[i] = (const float*)d_in[i];
    a.out = (float*)d_out; a.ws = (unsigned char*)d_ws;
#if N_LAUNCH_MODE == 1
    a.ph_lo = 0; a.ph_hi = PH_COUNT;
    hipLaunchKernelGGL(fwd_kernel, dim3(grid), dim3(NTHR), LDS_BYTES, stream, a);
#else
    for (int p = 0; p < PH_COUNT; ++p) { a.ph_lo = p; a.ph_hi = p + 1; hipLaunchKernelGGL(fwd_kernel, dim3(grid), dim3(NTHR), LDS_BYTES, stream, a); }
#endif
}
```

```cpp
#include <hip/hip_runtime.h>
#include <cstdio>
#include <cstdint>

#define LAS __attribute__((address_space(3)))
typedef unsigned short bf16_t;
typedef short bf16x8 __attribute__((ext_vector_type(8)));
typedef float f32x2 __attribute__((ext_vector_type(2)));
typedef float f32x4 __attribute__((ext_vector_type(4)));
typedef float f32x16 __attribute__((ext_vector_type(16)));
typedef unsigned u32x2 __attribute__((ext_vector_type(2)));
typedef unsigned u32x4 __attribute__((ext_vector_type(4)));
typedef __bf16 bf16v2 __attribute__((ext_vector_type(2)));
#define DI __device__ __forceinline__

constexpr int MP = 16384, MS = 2048, M = MP + MS, DM = 2048, DIN = 12800, DFF = 8192, BW = 1024, DEPTH = 4, NCHUNK = M / 64;
constexpr int ZLD = 6656;
constexpr int C_AX = 0, C_AG = 1024, C_QB = 2048, C_KB = 3072, C_VB = 3328, C_QC = 3584, C_KC = 4608, C_VC = 5632, C_G = 6656;
constexpr int NWAVES = 8, NTHR = 512;
constexpr float EPS = 1e-6f, LOG2E = 1.4426950408889634f;
constexpr size_t O_YP = 0, O_YS = O_YP + (size_t)MP * DM, O_PCONV = O_YS + (size_t)MS * DM, O_PLRU = O_PCONV + 4 * 2 * 3 * 1024, O_PSWAK = O_PLRU + 4 * 2 * 1024,
                 O_PSWAV = O_PSWAK + 4 * 2 * 128 * 256, O_PCBK = O_PSWAV + 4 * 2 * 128 * 256, O_PCBV = O_PCBK + (size_t)4 * 2 * 512 * 1024, O_SCONV = O_PCBV + (size_t)4 * 2 * 512 * 1024,
                 O_SLRU = O_SCONV + 4 * 32 * 3 * 1024, O_SSWAK = O_SLRU + 4 * 32 * 1024, O_SSWAV = O_SSWAK + (size_t)4 * 32 * 64 * 256, O_SCBK = O_SSWAV + (size_t)4 * 32 * 64 * 256,
                 O_SCBV = O_SCBK + (size_t)4 * 32 * 64 * 1024, O_END = O_SCBV + (size_t)4 * 32 * 64 * 1024;
constexpr size_t WL_IN = 0, WL_BR = WL_IN + (size_t)DIN * DM, WL_OUT = WL_BR + (size_t)3 * DM * BW, WL_UP = WL_OUT + (size_t)DM * DM, WL_DOWN = WL_UP + (size_t)DFF * DM, WL_SIZE = WL_DOWN + (size_t)DM * DFF;
constexpr size_t al256(size_t x) { return (x + 255) & ~(size_t)255; }
constexpr size_t WS_BAR = 0, WS_RS = 16384, WS_AGG = al256(WS_RS + (size_t)M * 4), WS_LRUW = al256(WS_AGG + (size_t)NCHUNK * 1024 * 2 * 4),
                 WS_W = al256(WS_LRUW + (size_t)DEPTH * 2 * 8 * 128 * 128 * 2), WS_ACT = al256(WS_W + (size_t)DEPTH * WL_SIZE * 2), WS_Z = al256(WS_ACT + (size_t)M * DM * 2),
                 WS_KCB = al256(WS_Z + (size_t)M * DFF * 2),
                 WS_VTCB = al256(WS_KCB + (size_t)32 * 128 * 256 * 2), WS_KCC = al256(WS_VTCB + (size_t)32 * 2 * 2 * 8192 * 2), WS_VTCC = al256(WS_KCC + (size_t)32 * 512 * 1024 * 2),
                 WS_R1 = al256(WS_VTCC + (size_t)32 * 8 * 8 * 8192 * 2), WS_BR = al256(WS_R1 + (size_t)2 * M * 1024 * 4), WS_SSQ = al256(WS_BR + (size_t)M * 3 * BW * 2),
                 WS_PART = al256(WS_SSQ + (size_t)MP * 32 * 4), WS_ACT2 = al256(WS_PART + (size_t)4 * MS * DM * 4), WS_GATE = al256(WS_ACT2 + (size_t)M * DM * 2), WS_END = al256(WS_GATE + (size_t)M * 3 * DM * 2);
constexpr int LDS_STAGE = 131072, LDS_MISC = LDS_STAGE, LDS_TBL = LDS_STAGE + 256, LDS_BYTES = LDS_STAGE + 256 + 8 * 260 * 4 + 64;


template <int OFF> DI unsigned long long karg64() { auto ka = __builtin_amdgcn_kernarg_segment_ptr(); unsigned long long p;
    asm volatile("s_load_dwordx2 %0, %1, %2\n\ts_waitcnt lgkmcnt(0)" : "=s"(p) : "s"(ka), "n"(OFF)); return p; }
template <int I> DI const float* kin() { return (const float*)karg64<I * 8>(); }
DI float* kout() { return (float*)karg64<200>(); }
DI unsigned char* kws() { return (unsigned char*)karg64<208>(); }
DI int launder_tid() { int t = threadIdx.x; asm volatile("" : "+v"(t)); return t; }
DI float bf2f(unsigned short b) { return __uint_as_float(((unsigned)b) << 16); }
DI float bflo(unsigned w) { return __uint_as_float(w << 16); }
DI float bfhi(unsigned w) { return __uint_as_float(w & 0xffff0000u); }
DI unsigned pk2(float a, float b) { f32x2 v = {a, b}; bf16v2 r = __builtin_convertvector(v, bf16v2); return __builtin_bit_cast(unsigned, r); }
DI float wave_sum(float v) {
#pragma unroll
    for (int o = 1; o < 64; o <<= 1) v += __shfl_xor(v, o);
    return v;
}
DI float sigmoidf_(float x) { return 1.0f / (1.0f + __expf(-x)); }
DI float gelu_tanh(float x) { const float u = 0.7978845608028654f * (x + 0.044715f * x * x * x); const float e = __expf(-2.0f * u); return x * (1.0f / (1.0f + e)); }

#define XB_TMO      128
#define XB_XCNT(j)  (256  + 64 * (j))
#define XB_XSUB(j)  (1280 + 64 * (j))
#define XB_XGEN(j)  (2304 + 64 * (j))
#define XB_TOP      3328
#define XB_TOPGEN   3392
#define XCD_BAR_WORDS 3456
#define XB_SPIN_CAP (1u << 20)
DI unsigned xb_ld(unsigned* p)              { return __hip_atomic_load(p, __ATOMIC_RELAXED, __HIP_MEMORY_SCOPE_AGENT); }
DI unsigned xb_add(unsigned* p, unsigned v) { return __hip_atomic_fetch_add(p, v, __ATOMIC_RELAXED, __HIP_MEMORY_SCOPE_AGENT); }
DI unsigned xb_xcc_id() { return (unsigned)__builtin_amdgcn_s_getreg((3 << 11) | 20) & 0xFu; }
#define XB_SPIN(cond, bar) do { unsigned _sp = 0; while (cond) { __builtin_amdgcn_s_sleep(1); \
    if ((++_sp & 255u) == 0u) { if (xb_ld(&(bar)[XB_TMO])) break; if (_sp > XB_SPIN_CAP) { atomicAdd(&(bar)[XB_TMO], 1u); break; } } } } while (0)
struct XcdBarrier { unsigned* bar; unsigned x; volatile LAS unsigned* st; };
DI XcdBarrier xcd_barrier_post(unsigned* bar, volatile LAS unsigned* st) {
    XcdBarrier b; b.bar = bar; b.x = xb_xcc_id(); b.st = st;
    if (threadIdx.x == 0) (void)xb_add(&bar[XB_XCNT(b.x)], 1u);
    return b;
}
DI void xcd_barrier_complete(unsigned* bar, unsigned x, unsigned& nloc, unsigned& nx) {
    const unsigned G = gridDim.x * gridDim.y * gridDim.z;
    unsigned sum, cnt, mine, sp = 0u;
    for (;;) {
        sum = 0u; cnt = 0u; mine = 0u;
#pragma unroll
        for (unsigned j = 0; j < 16; ++j) { const unsigned c = xb_ld(&bar[XB_XCNT(j)]); sum += c; cnt += (c > 0u) ? 1u : 0u; mine = (j == x) ? c : mine; }
        if (sum == G) break;
        __builtin_amdgcn_s_sleep(1);
        if ((++sp & 255u) == 0u) { if (xb_ld(&bar[XB_TMO])) break; if (sp > XB_SPIN_CAP) { atomicAdd(&bar[XB_TMO], 1u); break; } }
    }
    nloc = mine > 0u ? mine : 1u; nx = cnt > 0u ? cnt : 1u;
}
DI void xcd_barrier(const XcdBarrier& b) {
    asm volatile("s_waitcnt vmcnt(0)" ::: "memory");
    __syncthreads();
    if (threadIdx.x == 0) {
        unsigned* bar = b.bar;
        __builtin_amdgcn_s_waitcnt(0);
        unsigned nloc = b.st[0], nx = b.st[1];
        if (nloc == 0u) { xcd_barrier_complete(bar, b.x, nloc, nx); b.st[0] = nloc; b.st[1] = nx; }
        const unsigned old = xb_add(&bar[XB_XSUB(b.x)], 1u);
        const unsigned gen = old / nloc;
        if (old + 1u == (gen + 1u) * nloc) {
            __builtin_amdgcn_fence(__ATOMIC_RELEASE, "agent");
            asm volatile("s_waitcnt vmcnt(0)" ::: "memory");
            const unsigned og = xb_add(&bar[XB_TOP], 1u);
            const unsigned tg = og / nx;
            if (og + 1u == (tg + 1u) * nx) xb_add(&bar[XB_TOPGEN], 1u);
            else XB_SPIN(xb_ld(&bar[XB_TOPGEN]) == tg, bar);
            __builtin_amdgcn_fence(__ATOMIC_ACQUIRE, "agent");
            xb_add(&bar[XB_XGEN(b.x)], 1u);
            asm volatile("s_waitcnt vmcnt(0)" ::: "memory");
        } else {
            XB_SPIN(xb_ld(&bar[XB_XGEN(b.x)]) == gen, bar);
            __builtin_amdgcn_fence(__ATOMIC_ACQUIRE, "agent");
            asm volatile("s_waitcnt vmcnt(0)" ::: "memory");
        }
    }
    __syncthreads();
}

namespace pg8 {
constexpr int BM = 256, BK = 64, HALF = 128, HTB = HALF * BK * 2, STAGE_BYTES = 8 * HTB, NXCD = 8;
#ifndef WGM_FULL
#define WGM_FULL 8
#endif
#ifndef WGM_INPROJ
#define WGM_INPROJ 8
#endif
#ifndef WGM_SPLIT
#define WGM_SPLIT 4
#endif
DI int lds_byte(int r, int c) { const int st = (r >> 4) * 2 + (c >> 5), rr = r & 15, cc = c & 31, ob = rr * 64 + cc * 2; return st * 1024 + (ob ^ (((ob >> 9) & 1) << 5)); }
DI void stage_rc(int b, int& R, int& C) { const int st = b / 1024, sb = b % 1024, swz = sb ^ (((sb >> 9) & 1) << 5); R = (st >> 1) * 16 + swz / 64; C = (st & 1) * 32 + (swz % 64) / 2; }
DI int perm32(int rho) { const int n = rho >> 4, i = rho & 15; return 8 * (i >> 2) + 4 * n + (i & 3); }
struct Unit { int pm, pn, ks, nt; const char* a; const char* b; };
struct Geo { const bf16_t* A; const bf16_t* Bt; int lda, ldb; };
template <int WGM> DI void xcd_tile(int L, int nM, int nN, int& pm, int& pn) {
    const int nwg = nM * nN; int wgid = L; { const int q = nwg / NXCD, r = nwg % NXCD, xcd = wgid % NXCD, off = wgid / NXCD; wgid = (xcd < r ? xcd * (q + 1) : r * (q + 1) + (xcd - r) * q) + off; }
    const int nig = WGM * nN, gid = wgid / nig, fm = gid * WGM, gsz = (nM - fm) < WGM ? (nM - fm) : WGM;
    pm = fm + ((wgid % nig) % gsz); pn = (wgid % nig) / gsz;
}
struct FullOrder {
    Geo g; int nM, nN, G, c, nt;
    DI bool next(int i, Unit& u) const {
        const long L = (long)i * G + c; if (L >= (long)nM * nN) return false;
        xcd_tile<WGM_FULL>((int)L, nM, nN, u.pm, u.pn); u.ks = -1; u.nt = nt;
        u.a = (const char*)g.A + (size_t)u.pm * BM * g.lda * 2; u.b = (const char*)g.Bt + (size_t)u.pn * BM * g.ldb * 2; return true;
    }
};
struct InprojOrder {
    Geo g; int G, c;
    DI bool next(int i, Unit& u) const {
        const long L = (long)i * G + c;
        if (L < 3584) {
            if (L < 3550) xcd_tile<WGM_INPROJ>((int)L, 71, 50, u.pm, u.pn); else { const int idx = (int)L - 3550; u.pm = 71; u.pn = idx < 26 ? idx : idx + 16; }
            u.ks = -1; u.nt = DM / BK; u.a = (const char*)g.A + (size_t)u.pm * BM * g.lda * 2; u.b = (const char*)g.Bt + (size_t)u.pn * BM * g.ldb * 2; return true; }
        const long j = L - 3584; if (j >= 128) return false;
        u.pm = 71; u.pn = 26 + ((int)j & 15); u.ks = (int)(j >> 4); u.nt = 4;
        u.a = (const char*)g.A + ((size_t)u.pm * BM * g.lda + (size_t)u.ks * 256) * 2; u.b = (const char*)g.Bt + ((size_t)u.pn * BM * g.ldb + (size_t)u.ks * 256) * 2; return true;
    }
};
struct SplitOrder {
    Geo g; int G, c, ntFull, S, ntSplit;
    DI bool next(int i, Unit& u) const {
        const long L = (long)i * G + c;
        if (L < 512) { xcd_tile<WGM_SPLIT>((int)L, 64, 8, u.pm, u.pn); u.ks = -1; u.nt = ntFull;
            u.a = (const char*)g.A + (size_t)u.pm * BM * g.lda * 2; u.b = (const char*)g.Bt + (size_t)u.pn * BM * g.ldb * 2; return true; }
        const long j = L - 512; if (j >= 64 * S) return false;
        const int xq = (int)j & 7, sq = (int)j >> 3, combo = xq * S + (sq >> 3); u.pn = sq & 7; u.pm = 64 + (combo & 7); u.ks = combo >> 3; u.nt = ntSplit;
        u.a = (const char*)g.A + ((size_t)u.pm * BM * g.lda + (size_t)u.ks * ntSplit * BK) * 2; u.b = (const char*)g.Bt + ((size_t)u.pn * BM * g.ldb + (size_t)u.ks * ntSplit * BK) * 2; return true;
    }
};
template <class Epi, class Sched>
DI void gemm_phase(LAS unsigned char* lds, const Sched& S, const Epi& E) {
    const int tid = launder_tid(), wid = __builtin_amdgcn_readfirstlane(tid >> 6), lane = tid & 63, wr = wid >> 2, wc = wid & 3, fr = lane & 15, fq = lane >> 4;
    const int lda = S.g.lda, ldb = S.g.ldb;
    unsigned voffA[2], voffB[2];
#pragma unroll
    for (int i = 0; i < 2; ++i) { int R, C; stage_rc(tid * 16 + i * 8192, R, C); const int Rb = (R & ~31) + perm32(R & 31);
        voffA[i] = (unsigned)(R * lda + C) * 2u; voffB[i] = (unsigned)(Rb * ldb + C) * 2u; }
    const size_t kstep = (size_t)(BK * 2);
    const size_t hstepA = (size_t)HALF * lda * 2, hstepB = (size_t)HALF * ldb * 2;
    const unsigned ldsw = (unsigned)wid * 1024u;
    const int aoff = lds_byte(wr * 64 + fr, fq * 8), boff = lds_byte(wc * 32 + fr, fq * 8);
#define PG8_SA(b, h) (((b) * 2 + (h)) * HTB)
#define PG8_SB(b, h) ((4 + (b) * 2 + (h)) * HTB)
#define PG8_STAGE(bufoff, gbase, voff) do { _Pragma("unroll") for (int _i = 0; _i < 2; ++_i) \
        __builtin_amdgcn_global_load_lds((const unsigned*)((const char*)(gbase) + (voff)[_i]), (LAS unsigned*)(lds + (bufoff) + ldsw + _i * 8192), 16, 0, 0); } while (0)
#define PG8_LDA(dst, b, h) do { _Pragma("unroll") for (int m = 0; m < 4; ++m) _Pragma("unroll") for (int k = 0; k < 2; ++k) dst[m][k] = *(const LAS bf16x8*)(lds + PG8_SA(b, h) + aoff + m * 2048 + k * 1024); } while (0)
#define PG8_LDB(dst, b, h) do { _Pragma("unroll") for (int n = 0; n < 2; ++n) _Pragma("unroll") for (int k = 0; k < 2; ++k) dst[n][k] = *(const LAS bf16x8*)(lds + PG8_SB(b, h) + boff + n * 2048 + k * 1024); } while (0)
#define PG8_MMA(ai, bj, At, Bt) do { __builtin_amdgcn_s_setprio(1); _Pragma("unroll") for (int m = 0; m < 4; ++m) _Pragma("unroll") for (int n = 0; n < 2; ++n) _Pragma("unroll") for (int k = 0; k < 2; ++k) \
        acc[ai][bj][m][n] = __builtin_amdgcn_mfma_f32_16x16x32_bf16(Bt[n][k], At[m][k], acc[ai][bj][m][n], 0, 0, 0); __builtin_amdgcn_s_setprio(0); } while (0)
#define PG8_WAIT_V(n) asm volatile("s_waitcnt vmcnt(" #n ")" ::: "memory")
#define PG8_WAIT_L(n) asm volatile("s_waitcnt lgkmcnt(" #n ")" ::: "memory")
#define PG8_BAR __builtin_amdgcn_s_barrier()
#define PG8_SCHED __builtin_amdgcn_sched_barrier(0)
    Unit cur, nxt; int ui = 0;
    if (!S.next(0, cur)) return;
    f32x4 acc[2][2][4][2];
#pragma unroll
    for (int a = 0; a < 2; ++a)
#pragma unroll
        for (int b = 0; b < 2; ++b)
#pragma unroll
            for (int m = 0; m < 4; ++m)
#pragma unroll
                for (int n = 0; n < 2; ++n) acc[a][b][m][n] = (f32x4){0.f, 0.f, 0.f, 0.f};
    bf16x8 At[4][2], B0[2][2], B1[2][2];
    const char* cA = cur.a; const char* cB = cur.b;
#define PG8_RSDMA(unit_, par_) do { if constexpr (Epi::RSLDS) { if (wid < 4) __builtin_amdgcn_global_load_lds((const unsigned*)(E.rs + (unit_).pm * BM + wid * 64 + lane), \
        (LAS unsigned*)(lds + LDS_TBL + (par_) * 1024 + wid * 256), 4, 0, 0); } } while (0)
    PG8_RSDMA(cur, 0);
    PG8_STAGE(PG8_SB(0, 0), cB, voffB); PG8_STAGE(PG8_SB(0, 1), cB + hstepB, voffB); PG8_STAGE(PG8_SA(0, 0), cA, voffA); PG8_STAGE(PG8_SA(0, 1), cA + hstepA, voffA);
    if (wr == 1) PG8_BAR;
    PG8_WAIT_V(2); PG8_BAR;
    PG8_STAGE(PG8_SB(1, 0), cB + kstep, voffB); PG8_STAGE(PG8_SA(1, 0), cA + kstep, voffA); PG8_STAGE(PG8_SB(1, 1), cB + hstepB + kstep, voffB);
    PG8_WAIT_V(6); PG8_BAR;
    for (;;) {
        const bool has_next = S.next(ui + 1, nxt);
        const char* nA = has_next ? nxt.a : cA; const char* nB = has_next ? nxt.b : cB;
        const int nt = cur.nt;
        for (int t = 0; t < nt; t += 2) {
            const bool last = (t == nt - 2);
            const char* a1 = cA + (size_t)(t + 1) * kstep;
            const char* a2 = last ? nA : cA + (size_t)(t + 2) * kstep; const char* b2 = last ? nB : cB + (size_t)(t + 2) * kstep;
            const char* a3 = a2 + kstep; const char* b3 = b2 + kstep;
            if constexpr (Epi::HOOK) { if (cur.ks < 0 && (t == 16 || t == 32)) E.hook(acc, cur, t >> 4, wr, wc, fr, fq); }
            PG8_LDB(B0, 0, 0); PG8_LDB(B1, 0, 1); PG8_SCHED; PG8_LDA(At, 0, 0); PG8_STAGE(PG8_SA(1, 1), a1 + hstepA, voffA);
            PG8_WAIT_V(8); PG8_WAIT_L(0); PG8_BAR; PG8_MMA(0, 0, At, B0); PG8_MMA(0, 1, At, B1); PG8_BAR; PG8_SCHED;
            PG8_LDA(At, 0, 1); PG8_STAGE(PG8_SB(0, 0), b2, voffB); PG8_STAGE(PG8_SB(0, 1), b2 + hstepB, voffB); PG8_STAGE(PG8_SA(0, 0), a2, voffA);
            PG8_WAIT_V(8); PG8_WAIT_L(0); PG8_BAR; PG8_MMA(1, 0, At, B0); PG8_MMA(1, 1, At, B1); PG8_BAR; PG8_SCHED;
            PG8_LDB(B0, 1, 0); PG8_LDB(B1, 1, 1); PG8_SCHED; PG8_LDA(At, 1, 0); PG8_STAGE(PG8_SA(0, 1), a2 + hstepA, voffA);
            PG8_WAIT_V(8); PG8_WAIT_L(0); PG8_BAR; PG8_MMA(0, 0, At, B0); PG8_MMA(0, 1, At, B1); PG8_BAR; PG8_SCHED;
            PG8_LDA(At, 1, 1); PG8_STAGE(PG8_SB(1, 0), b3, voffB); PG8_STAGE(PG8_SB(1, 1), b3 + hstepB, voffB); PG8_STAGE(PG8_SA(1, 0), a3, voffA);
            PG8_WAIT_V(8); PG8_WAIT_L(0); PG8_BAR; PG8_MMA(1, 0, At, B0); PG8_MMA(1, 1, At, B1); PG8_BAR; PG8_SCHED;
        }
        if (wr == 0) PG8_BAR;
        E(acc, cur, wr, wc, fr, fq, (const LAS float*)(lds + LDS_TBL + (ui & 1) * 1024));
        if (!has_next) break;
#pragma unroll
        for (int a = 0; a < 2; ++a)
#pragma unroll
            for (int b = 0; b < 2; ++b)
#pragma unroll
                for (int m = 0; m < 4; ++m)
#pragma unroll
                    for (int n = 0; n < 2; ++n) acc[a][b][m][n] = (f32x4){0.f, 0.f, 0.f, 0.f};
        cur = nxt; cA = nA; cB = nB; ++ui;
        PG8_RSDMA(cur, ui & 1);
        if (wr == 1) PG8_BAR;
    }
    PG8_WAIT_V(0);
    PG8_BAR;
#undef PG8_RSDMA
#undef PG8_SA
#undef PG8_SB
#undef PG8_STAGE
#undef PG8_LDA
#undef PG8_LDB
#undef PG8_MMA
#undef PG8_WAIT_V
#undef PG8_WAIT_L
#undef PG8_BAR
#undef PG8_SCHED
}

DI unsigned q8(float s) { const float t = fminf(fmaxf(s * 255.0f + 0.5f, 1.0f), 255.0f); return (unsigned)(int)t; }
DI unsigned pk4q8(const f32x4 v) {
    unsigned w = 0u;
    w = __builtin_amdgcn_cvt_pk_u8_f32(fmaxf(__builtin_rintf(v[0] * 255.0f), 1.0f), 0, w); w = __builtin_amdgcn_cvt_pk_u8_f32(fmaxf(__builtin_rintf(v[1] * 255.0f), 1.0f), 1, w);
    w = __builtin_amdgcn_cvt_pk_u8_f32(fmaxf(__builtin_rintf(v[2] * 255.0f), 1.0f), 2, w); w = __builtin_amdgcn_cvt_pk_u8_f32(fmaxf(__builtin_rintf(v[3] * 255.0f), 1.0f), 3, w);
    return w;
}
DI u32x2 packq8(const f32x4 v0, const f32x4 v1) { u32x2 w; w.x = pk4q8(v0); w.y = pk4q8(v1); return w; }
DI void unpackq8(const u32x2 w, f32x4& v0, f32x4& v1) {
    v0 = (f32x4){(float)(w.x & 0xffu), (float)((w.x >> 8) & 0xffu), (float)((w.x >> 16) & 0xffu), (float)(w.x >> 24)};
    v1 = (f32x4){(float)(w.y & 0xffu), (float)((w.y >> 8) & 0xffu), (float)((w.y >> 16) & 0xffu), (float)(w.y >> 24)}; }
DI u32x4 pack8(const f32x4 v0, const f32x4 v1) { u32x4 w; w.x = pk2(v0[0], v0[1]); w.y = pk2(v0[2], v0[3]); w.z = pk2(v1[0], v1[1]); w.w = pk2(v1[2], v1[3]); return w; }
DI void unpack8(const u32x4 w, f32x4& v0, f32x4& v1) { v0 = (f32x4){bflo(w.x), bfhi(w.x), bflo(w.y), bfhi(w.y)}; v1 = (f32x4){bflo(w.z), bfhi(w.z), bflo(w.w), bfhi(w.w)}; }
struct EpiInproj {
    static constexpr bool HOOK = false, RSLDS = true;
    bf16_t* Z; const float* rs; float* part; unsigned char* GT;
    DI void operator()(const f32x4 (&acc)[2][2][4][2], const Unit& u, int wr, int wc, int fr, int fq, const LAS float* rsl) const {
        const int row0 = u.pm * BM + wr * 64 + fr, col0 = u.pn * BM + wc * 32 + 8 * fq;
        const bool gate = u.pn >= C_G / BM;
#pragma unroll
        for (int ai = 0; ai < 2; ++ai)
#pragma unroll
            for (int m = 0; m < 4; ++m) {
                const int row = row0 + ai * HALF + m * 16;
                if (u.ks < 0) {
                    const float s = rsl[wr * 64 + fr + ai * HALF + m * 16];
                    bf16_t* rowp = Z + (size_t)row * ZLD + col0;
                    unsigned char* gq = GT + (((size_t)u.pm * 24 + (u.pn - 26)) * 256 + (row & 255)) * 256 + wc * 32 + 8 * fq;
#pragma unroll
                    for (int bj = 0; bj < 2; ++bj) {
                        f32x4 v0 = acc[ai][bj][m][0] * s, v1 = acc[ai][bj][m][1] * s;
                        if (gate) {
#pragma unroll
                            for (int j = 0; j < 4; ++j) { v0[j] = __builtin_amdgcn_rcpf(1.0f + __expf(-v0[j])); v1[j] = __builtin_amdgcn_rcpf(1.0f + __expf(-v1[j])); }
                            *(u32x2*)(gq + bj * HALF) = packq8(v0, v1);
                        } else *(u32x4*)(rowp + bj * HALF) = pack8(v0, v1);
                    }
                } else {
                    float* pp = part + (((size_t)u.ks * 16 + (u.pn - 26)) * 256 + (row - 71 * BM)) * 256 + wc * 32 + 8 * fq;
#pragma unroll
                    for (int bj = 0; bj < 2; ++bj) { *(f32x4*)(pp + bj * HALF) = acc[ai][bj][m][0]; *(f32x4*)(pp + bj * HALF + 4) = acc[ai][bj][m][1]; }
                }
            }
    }
};
struct EpiUp {
    static constexpr bool HOOK = false, RSLDS = true;
    bf16_t* H; const float* rs;
    DI void operator()(const f32x4 (&acc)[2][2][4][2], const Unit& u, int wr, int wc, int fr, int fq, const LAS float* rsl) const {
        const int row0 = u.pm * BM + wr * 64 + fr, col0 = u.pn * BM + wc * 32 + 8 * fq;
#pragma unroll
        for (int ai = 0; ai < 2; ++ai)
#pragma unroll
            for (int m = 0; m < 4; ++m) {
                const int row = row0 + ai * HALF + m * 16; const float s = rsl[wr * 64 + fr + ai * HALF + m * 16];
                bf16_t* rowp = H + (size_t)row * DFF + col0;
#pragma unroll
                for (int bj = 0; bj < 2; ++bj) {
                    f32x4 v0 = acc[ai][bj][m][0] * s, v1 = acc[ai][bj][m][1] * s;
#pragma unroll
                    for (int j = 0; j < 4; ++j) { v0[j] = fmaxf(v0[j], 0.f); v0[j] *= v0[j]; v1[j] = fmaxf(v1[j], 0.f); v1[j] *= v1[j]; }
                    *(u32x4*)(rowp + bj * HALF) = pack8(v0, v1);
                }
            }
    }
};
struct EpiD {
    static constexpr bool HOOK = true, RSLDS = false;
    const unsigned char* Z; bf16_t* act; float* part;
    DI void hook(f32x4 (&acc)[2][2][4][2], const Unit& u, int r, int wr, int wc, int fr_, int fq_) const {
        int fr = fr_, fq = fq_; asm volatile("" : "+v"(fr), "+v"(fq));
        const int row0 = u.pm * BM + wr * 64 + fr, col0 = u.pn * BM + wc * 32 + 8 * fq;
#pragma unroll
        for (int ai = 0; ai < 2; ++ai) {
#pragma unroll
            for (int m = 0; m < 4; ++m) {
                const unsigned char* gp = Z + (((size_t)u.pm * 24 + (r - 1) * 8 + u.pn) * 256 + (wr * 64 + fr + ai * HALF + m * 16)) * 256 + wc * 32 + 8 * fq;
#pragma unroll
                for (int bj = 0; bj < 2; ++bj) {
                    f32x4 n0, n1, d0, d1; unpackq8(*(const u32x2*)(gp + bj * HALF), n0, n1); unpackq8(*(const u32x2*)(gp + 8 * 65536 + bj * HALF), d0, d1);
#pragma unroll
                    for (int j = 0; j < 4; ++j) { acc[ai][bj][m][0][j] *= n0[j] * __builtin_amdgcn_rcpf(d0[j]); acc[ai][bj][m][1][j] *= n1[j] * __builtin_amdgcn_rcpf(d1[j]); }
                }
            }
            asm volatile("" : "+v"(acc[ai][0][0][0]), "+v"(acc[ai][0][1][0]), "+v"(acc[ai][0][2][0]), "+v"(acc[ai][0][3][0]), "+v"(acc[ai][1][0][0]), "+v"(acc[ai][1][1][0]), "+v"(acc[ai][1][2][0]), "+v"(acc[ai][1][3][0]));
        }
    }
    DI void operator()(const f32x4 (&acc)[2][2][4][2], const Unit& u, int wr, int wc, int fr, int fq, const LAS float* rsl) const {
        const int row0 = u.pm * BM + wr * 64 + fr, col0 = u.pn * BM + wc * 32 + 8 * fq;
        const int r = u.ks < 0 ? 2 : u.ks;
#pragma unroll
        for (int ai = 0; ai < 2; ++ai)
#pragma unroll
            for (int m = 0; m < 4; ++m) {
                const int row = row0 + ai * HALF + m * 16;
                const unsigned char* gp = Z + (((size_t)u.pm * 24 + r * 8 + u.pn) * 256 + (row & 255)) * 256 + wc * 32 + 8 * fq;
#pragma unroll
                for (int bj = 0; bj < 2; ++bj) {
                    f32x4 s0, s1; unpackq8(*(const u32x2*)(gp + bj * HALF), s0, s1);
                    const f32x4 v0 = acc[ai][bj][m][0] * (s0 * (1.0f / 255.0f)), v1 = acc[ai][bj][m][1] * (s1 * (1.0f / 255.0f));
                    if (u.ks < 0) *(u32x4*)(act + (size_t)row * DM + col0 + bj * HALF) = pack8(v0, v1);
                    else { float* pp = part + ((size_t)u.ks * MS + (row - MP)) * DM + col0 + bj * HALF; *(f32x4*)pp = v0; *(f32x4*)(pp + 4) = v1; }
                }
            }
    }
};
template <bool XF32> struct EpiRes {
    static constexpr bool HOOK = false, RSLDS = false;
    const float* Xin; bf16_t* act; float* ssq; float* part;
    DI void operator()(const f32x4 (&acc)[2][2][4][2], const Unit& u, int wr, int wc, int fr, int fq, const LAS float* rsl) const {
        const int row0 = u.pm * BM + wr * 64 + fr, col0 = u.pn * BM + wc * 32 + 8 * fq;
        u32x4 xin[2][4][2];
        if (!XF32 && u.ks < 0) {
#pragma unroll
            for (int ai = 0; ai < 2; ++ai)
#pragma unroll
                for (int m = 0; m < 4; ++m)
#pragma unroll
                    for (int bj = 0; bj < 2; ++bj) xin[ai][m][bj] = *(const u32x4*)(act + (size_t)(row0 + ai * HALF + m * 16) * DM + col0 + bj * HALF);
        }
#pragma unroll
        for (int ai = 0; ai < 2; ++ai)
#pragma unroll
            for (int m = 0; m < 4; ++m) {
                const int row = row0 + ai * HALF + m * 16;
                if (u.ks < 0) {
                    const size_t off = (size_t)row * DM + col0; float sq = 0.f;
#pragma unroll
                    for (int bj = 0; bj < 2; ++bj) {
                        f32x4 x0, x1;
                        if (XF32) { x0 = *(const f32x4*)(Xin + off + bj * HALF); x1 = *(const f32x4*)(Xin + off + bj * HALF + 4); }
                        else unpack8(xin[ai][m][bj], x0, x1);
                        x0 += acc[ai][bj][m][0]; x1 += acc[ai][bj][m][1];
                        *(u32x4*)(act + off + bj * HALF) = pack8(x0, x1);
                        sq += (x0[0] * x0[0] + x0[1] * x0[1]) + (x0[2] * x0[2] + x0[3] * x0[3]) + (x1[0] * x1[0] + x1[1] * x1[1]) + (x1[2] * x1[2] + x1[3] * x1[3]);
                    }
                    sq += __shfl_xor(sq, 16); sq += __shfl_xor(sq, 32);
                    if (fq == 0) ssq[(size_t)row * 32 + u.pn * 4 + wc] = sq;
                } else {
#pragma unroll
                    for (int bj = 0; bj < 2; ++bj) { float* pp = part + ((size_t)u.ks * MS + (row - MP)) * DM + col0 + bj * HALF; *(f32x4*)pp = acc[ai][bj][m][0]; *(f32x4*)(pp + 4) = acc[ai][bj][m][1]; }
                }
            }
    }
};
}

DI void tr_item(const float* src, size_t sld, bf16_t* dst, size_t dld, const float* ksc, LAS unsigned* scr, int lane) {
    const int ng = lane & 15, kq = lane >> 4;
#pragma unroll
    for (int i = 0; i < 8; ++i) {
        const int k = 8 * i + 2 * kq;
        f32x4 a = *(const f32x4*)(src + (size_t)k * sld + 4 * ng);
        f32x4 b = *(const f32x4*)(src + (size_t)(k + 1) * sld + 4 * ng);
        if (ksc) { a *= ksc[k]; b *= ksc[k + 1]; }
        LAS unsigned* d = scr + (4 * ng) * 33 + 4 * i + kq;
        d[0] = pk2(a[0], b[0]); d[33] = pk2(a[1], b[1]); d[66] = pk2(a[2], b[2]); d[99] = pk2(a[3], b[3]);
    }
    asm volatile("s_waitcnt lgkmcnt(0)" ::: "memory");
#pragma unroll
    for (int j = 0; j < 8; ++j) {
        const int n = (lane >> 3) + 8 * j, c = lane & 7;
        const LAS unsigned* s = scr + n * 33 + 4 * c;
        u32x4 o; o.x = s[0]; o.y = s[1]; o.z = s[2]; o.w = s[3];
        *(u32x4*)(dst + (size_t)n * dld + 8 * c) = o;
    }
    asm volatile("s_waitcnt lgkmcnt(0)" ::: "memory");
}

struct Ctx {
    LAS unsigned char* lds;
    int tid, lane, wave, bid, G;
};
DI Ctx make_ctx(LAS unsigned char* lds) { Ctx c; c.lds = lds; c.tid = launder_tid(); c.lane = c.tid & 63; c.wave = __builtin_amdgcn_readfirstlane(c.tid >> 6); c.bid = blockIdx.x; c.G = gridDim.x; return c; }

DI void conv_matrix_item(const float* W, int K, int N, bf16_t* Wt, const float* ksc, int item, LAS unsigned* scr, int lane) {
    const int nb = N >> 6, kb = item / nb, nn = item - kb * nb;
    tr_item(W + (size_t)kb * 64 * N + nn * 64, (size_t)N, Wt + (size_t)nn * 64 * K + kb * 64, (size_t)K, ksc ? ksc + kb * 64 : nullptr, scr, lane);
}
DI void phase_prologue(const Ctx& c) {
    LAS unsigned* scr = (LAS unsigned*)(c.lds + c.wave * 16384);
    const int gw = c.bid * NWAVES + c.wave, NGW = c.G * NWAVES;
    constexpr int I_IN = 32 * 200, I_BR = 16 * 32, I_OUT = 32 * 32, I_UP = 32 * 128, I_DN = 128 * 32, I_LRU = 4, I_L = I_IN + 3 * I_BR + I_OUT + I_UP + I_DN + 16 * I_LRU;
    bf16_t* Wall = (bf16_t*)(kws() + WS_W); bf16_t* lruw = (bf16_t*)(kws() + WS_LRUW);
    for (int it = gw; it < DEPTH * I_L; it += NGW) {
        const int l = it / I_L; int r = it - l * I_L;
        bf16_t* Wl = Wall + (size_t)l * WL_SIZE;
        if (r < I_IN) { conv_matrix_item(kin<9>() + (size_t)l * DM * DIN, DM, DIN, Wl + WL_IN, kin<8>() + l * DM, r, scr, c.lane); continue; } r -= I_IN;
        if (r < 3 * I_BR) { const int b = r / I_BR, it2 = r - b * I_BR, kb = it2 / (DM / 64), nn = it2 - kb * (DM / 64);
            tr_item(kin<19>() + ((size_t)l * 3 + b) * BW * DM + (size_t)kb * 64 * DM + nn * 64, (size_t)DM, Wl + WL_BR + (size_t)nn * 64 * (3 * BW) + b * BW + kb * 64, (size_t)(3 * BW), nullptr, scr, c.lane); continue; } r -= 3 * I_BR;
        if (r < I_OUT) { conv_matrix_item(kin<20>() + (size_t)l * DM * DM, DM, DM, Wl + WL_OUT, nullptr, r, scr, c.lane); continue; } r -= I_OUT;
        if (r < I_UP) { conv_matrix_item(kin<22>() + (size_t)l * DM * DFF, DM, DFF, Wl + WL_UP, kin<21>() + l * DM, r, scr, c.lane); continue; } r -= I_UP;
        if (r < I_DN) { conv_matrix_item(kin<23>() + (size_t)l * DFF * DM, DFF, DM, Wl + WL_DOWN, nullptr, r, scr, c.lane); continue; } r -= I_DN;
        { const int wsel = r / (8 * I_LRU), rr = r - wsel * 8 * I_LRU, blk = rr / I_LRU, sub = rr - blk * I_LRU;
          conv_matrix_item((wsel ? kin<14>() : kin<12>()) + ((size_t)l * 8 + blk) * 16384, 128, 128, lruw + (((size_t)l * 2 + wsel) * 8 + blk) * 16384, nullptr, sub, scr, c.lane); }
    }
}

DI void phase_norm(const Ctx& c, const float* xP, const float* xS) {
    const int gw = c.bid * NWAVES + c.wave, NGW = c.G * NWAVES;
    bf16_t* act = (bf16_t*)(kws() + WS_ACT); float* rs = (float*)(kws() + WS_RS);
    for (int row = gw; row < M; row += NGW) {
        const f32x4* xr = (const f32x4*)((row < MP ? xP : xS) + (size_t)row * DM) + c.lane;
        f32x4 v[8]; float s = 0.f;
#pragma unroll
        for (int j = 0; j < 8; ++j) { v[j] = xr[64 * j]; s += (v[j][0] * v[j][0] + v[j][1] * v[j][1]) + (v[j][2] * v[j][2] + v[j][3] * v[j][3]); }
        s = wave_sum(s);
        if (c.lane == 0) rs[row] = 1.0f / sqrtf(s * (1.0f / DM) + EPS);
        u32x2* o = (u32x2*)(act + (size_t)row * DM) + c.lane;
#pragma unroll
        for (int j = 0; j < 8; ++j) { u32x2 w; w.x = pk2(v[j][0], v[j][1]); w.y = pk2(v[j][2], v[j][3]); o[64 * j] = w; }
    }
}
DI void phase_final(const Ctx& c) {
    const int gw = c.bid * NWAVES + c.wave, NGW = c.G * NWAVES;
    const f32x4* gp = (const f32x4*)kin<24>() + c.lane; const float* rs = (const float*)(kws() + WS_RS); const bf16_t* act = (const bf16_t*)(kws() + WS_ACT);
    f32x4 gv[8];
#pragma unroll
    for (int j = 0; j < 8; ++j) gv[j] = gp[64 * j];
    for (int row = gw; row < M; row += NGW) {
        f32x4* yr = (f32x4*)(kout() + (size_t)row * DM) + c.lane; const u32x2* xr = (const u32x2*)(act + (size_t)row * DM) + c.lane; const float r = rs[row];
#pragma unroll
        for (int j = 0; j < 8; ++j) { const u32x2 w = xr[64 * j]; yr[64 * j] = (f32x4){bflo(w.x), bfhi(w.x), bflo(w.y), bfhi(w.y)} * r * gv[j]; }
    }
}
DI void cvt_f32_bf16(const float* s, bf16_t* d, size_t n8, size_t gt, size_t NT) {
    for (size_t i = gt; i < n8; i += NT) { const f32x4 a = ((const f32x4*)s)[2 * i], b = ((const f32x4*)s)[2 * i + 1]; u32x4 w; w.x = pk2(a[0], a[1]); w.y = pk2(a[2], a[3]); w.z = pk2(b[0], b[1]); w.w = pk2(b[2], b[3]); ((u32x4*)d)[i] = w; }
}
DI void phase_cacheconv(const Ctx& c, int l, int pidx, int pcount) {
    const size_t gt = (size_t)pidx * NTHR + c.tid, NT = (size_t)pcount * NTHR;
    cvt_f32_bf16(kin<4>() + (size_t)l * 32 * 128 * 256, (bf16_t*)(kws() + WS_KCB), (size_t)32 * 128 * 256 / 8, gt, NT);
    cvt_f32_bf16(kin<5>() + (size_t)l * 32 * 128 * 256, (bf16_t*)(kws() + WS_VTCB), (size_t)32 * 128 * 256 / 8, gt, NT);
    cvt_f32_bf16(kin<6>() + (size_t)l * 32 * 512 * 1024, (bf16_t*)(kws() + WS_KCC), (size_t)32 * 512 * 1024 / 8, gt, NT);
    cvt_f32_bf16(kin<7>() + (size_t)l * 32 * 512 * 1024, (bf16_t*)(kws() + WS_VTCC), (size_t)32 * 512 * 1024 / 8, gt, NT);
}

DI void lru_local_phase(const Ctx& c, int l) {
    LAS float* uf = (LAS float*)c.lds;
    LAS unsigned char* ub = c.lds + 33792;
    LAS float* sa = (LAS float*)(c.lds + 33792 + 17408);
    LAS float* sb = sa + 8192;
    LAS float* tot = sb + 8192;
    const bf16_t* Z = (const bf16_t*)(kws() + WS_Z);
    const int nunits = NCHUNK * 8;
    int u = c.bid; if (u >= nunits) return;
    const int cg = c.tid & 15, tk = c.tid >> 4;
    const int fr = c.lane & 15, fq = c.lane >> 4, w = c.wave;
    const int chl = c.tid & 127, q = c.tid >> 7;
    int nblk_cur = -1;
    LAS float* cwl = tot + 1024;
    bf16x8 bwa[4], bwx[4]; float ba = 0.f, bx = 0.f, c8 = 0.f;
    u32x4 pre[2][4];
#define LRU_PREFETCH(uu) do { const int chunk_ = (uu) >> 3, nb_ = (uu) & 7; const bool smp_ = chunk_ >= 256, first_ = !smp_ && (chunk_ & 127) == 0; \
        _Pragma("unroll") for (int hh = 0; hh < 2; ++hh) _Pragma("unroll") for (int k = 0; k < 4; ++k) { const int ts = tk + 32 * hh - 3 + k; \
            if (ts >= 0 || (!smp_ && !first_)) pre[hh][k] = *(const u32x4*)(Z + (size_t)(chunk_ * 64 + ts) * ZLD + C_AX + nb_ * 128 + 8 * cg); } } while (0)
    LRU_PREFETCH(u);
    for (; u < nunits; u += c.G) {
        const int chunk = u >> 3, nblk = u & 7;
        const int row0 = chunk * 64, ch0 = nblk * 128; const bool smp = chunk >= 256; const bool first = !smp && (chunk & 127) == 0; const int bs = chunk - 256;
        if (nblk != nblk_cur) {
            nblk_cur = nblk;
            __syncthreads();
            for (int i = c.tid; i < 640; i += NTHR) { const int k = i >> 7, cc = i & 127; cwl[i] = k < 4 ? kin<10>()[(size_t)l * 4 * 1024 + k * 1024 + ch0 + cc] : kin<11>()[(size_t)l * 1024 + ch0 + cc]; }
            __syncthreads();
            const bf16_t* wat = (const bf16_t*)(kws() + WS_LRUW) + (((size_t)l * 2 + 0) * 8 + nblk) * 16384 + (size_t)(16 * w + fr) * 128 + 8 * fq;
            const bf16_t* wxt = wat + (size_t)8 * 16384;
#pragma unroll
            for (int ks = 0; ks < 4; ++ks) { bwa[ks] = *(const bf16x8*)(wat + 32 * ks); bwx[ks] = *(const bf16x8*)(wxt + 32 * ks); }
            const int ch = ch0 + 16 * w + fr;
            ba = kin<13>()[(size_t)l * 1024 + ch]; bx = kin<15>()[(size_t)l * 1024 + ch]; c8 = 8.0f * log1pf(expf(-kin<16>()[(size_t)l * 1024 + ch]));
        }
#pragma unroll
        for (int hh = 0; hh < 2; ++hh) {
            const int tt = tk + 32 * hh;
            f32x4 a0 = *(const LAS f32x4*)(cwl + 512 + 8 * cg), a1 = *(const LAS f32x4*)(cwl + 512 + 8 * cg + 4);
#pragma unroll
            for (int k = 0; k < 4; ++k) {
                const int ts = tt - 3 + k;
                f32x4 x0, x1;
                if (ts >= 0 || (!smp && !first)) { const u32x4 v = pre[hh][k];
                    x0 = (f32x4){bflo(v.x), bfhi(v.x), bflo(v.y), bfhi(v.y)}; x1 = (f32x4){bflo(v.z), bfhi(v.z), bflo(v.w), bfhi(v.w)};
                } else if (smp) {
                    const float* sp = kin<2>() + (((size_t)l * 32 + bs) * 3 + (3 + ts)) * 1024 + ch0 + 8 * cg;
                    x0 = *(const f32x4*)sp; x1 = *(const f32x4*)(sp + 4);
                } else { x0 = (f32x4){0.f, 0.f, 0.f, 0.f}; x1 = x0; }
                a0 += *(const LAS f32x4*)(cwl + k * 128 + 8 * cg) * x0; a1 += *(const LAS f32x4*)(cwl + k * 128 + 8 * cg + 4) * x1;
            }
            *(LAS f32x4*)(uf + tt * 132 + 8 * cg) = a0; *(LAS f32x4*)(uf + tt * 132 + 8 * cg + 4) = a1;
            u32x4 pw; pw.x = pk2(a0[0], a0[1]); pw.y = pk2(a0[2], a0[3]); pw.z = pk2(a1[0], a1[1]); pw.w = pk2(a1[2], a1[3]);
            *(LAS u32x4*)(ub + tt * 272 + 16 * cg) = pw;
        }
        if (u + c.G < nunits) LRU_PREFETCH(u + c.G);
        __syncthreads();
        {
            f32x4 ar[4], ai[4];
#pragma unroll
            for (int mt = 0; mt < 4; ++mt) { ar[mt] = (f32x4){0.f, 0.f, 0.f, 0.f}; ai[mt] = ar[mt]; }
#pragma unroll
            for (int ks = 0; ks < 4; ++ks)
#pragma unroll
                for (int mt = 0; mt < 4; ++mt) {
                    const bf16x8 af = *(const LAS bf16x8*)(ub + (mt * 16 + fr) * 272 + (ks * 32 + fq * 8) * 2);
                    ar[mt] = __builtin_amdgcn_mfma_f32_16x16x32_bf16(af, bwa[ks], ar[mt], 0, 0, 0);
                    ai[mt] = __builtin_amdgcn_mfma_f32_16x16x32_bf16(af, bwx[ks], ai[mt], 0, 0, 0);
                }
            const int chw = 16 * w + fr;
#pragma unroll
            for (int mt = 0; mt < 4; ++mt)
#pragma unroll
                for (int j = 0; j < 4; ++j) {
                    const int tok = mt * 16 + fq * 4 + j;
                    const float r = __builtin_amdgcn_rcpf(1.0f + __expf(-(ar[mt][j] + ba))), ig = __builtin_amdgcn_rcpf(1.0f + __expf(-(ai[mt][j] + bx)));
                    const float la = -c8 * r, a = __expf(la), x2 = 2.0f * la;
                    const float omt = -x2 * (1.0f + x2 * (0.5f + x2 * (0.16666667f + x2 * (0.041666668f + x2 * (0.0083333338f + x2 * 0.0013888889f)))));
                    const float om = x2 > -0.25f ? omt : 1.0f - a * a;
                    const float bb = __builtin_amdgcn_sqrtf(om) * (ig * uf[tok * 132 + chw]);
                    sa[tok * 128 + chw] = a; sb[tok * 128 + chw] = bb;
                }
        }
        __syncthreads();
        {
            float h = (smp && q == 0) ? kin<3>()[((size_t)l * 32 + bs) * 1024 + ch0 + chl] : 0.f, A = 1.f;
#pragma unroll 4
            for (int t = 16 * q; t < 16 * q + 16; ++t) { const float a = sa[t * 128 + chl], b = sb[t * 128 + chl]; h = a * h + b; A *= a; sb[t * 128 + chl] = h; sa[t * 128 + chl] = A; }
            tot[(q * 128 + chl) * 2] = A; tot[(q * 128 + chl) * 2 + 1] = h;
        }
        __syncthreads();
        {
            float cin = 0.f, Apre = 1.f;
            for (int qq = 0; qq < q; ++qq) { const float A = tot[(qq * 128 + chl) * 2], h = tot[(qq * 128 + chl) * 2 + 1]; cin = A * cin + h; Apre *= A; }
            unsigned* hc = (unsigned*)(kws() + WS_R1) + (size_t)row0 * 1024 + ch0 + chl;
            float h = 0.f, A = 1.f;
#pragma unroll 4
            for (int t = 16 * q; t < 16 * q + 16; ++t) { h = sb[t * 128 + chl] + sa[t * 128 + chl] * cin; A = sa[t * 128 + chl] * Apre; hc[(size_t)t * 1024] = pk2(h, A); }
            if (q == 3) { f32x2 ag = {A, h}; *(f32x2*)((float*)(kws() + WS_AGG) + ((size_t)chunk * 1024 + ch0 + chl) * 2) = ag; }
        }
        __syncthreads();
    }
#undef LRU_PREFETCH
}

DI void lru_fix_unit(const Ctx& c, int l, int chunk, int half) {
    const int cg4 = c.tid & 127, tq = c.tid >> 7, ch = half * 512 + 4 * cg4; const bool smp = chunk >= 256; const int n = smp ? 0 : (chunk & 127);
    f32x4 cr = {0.f, 0.f, 0.f, 0.f};
    const f32x4* ag = (const f32x4*)((const float*)(kws() + WS_AGG) + ((size_t)(chunk - n) * 1024 + ch) * 2);
    int i = 0;
    for (; i + 8 <= n; i += 8) {
        f32x4 a[8][2];
#pragma unroll
        for (int j = 0; j < 8; ++j) { a[j][0] = ag[(size_t)(i + j) * 512]; a[j][1] = ag[(size_t)(i + j) * 512 + 1]; }
#pragma unroll
        for (int j = 0; j < 8; ++j) { cr[0] = a[j][0][0] * cr[0] + a[j][0][1]; cr[1] = a[j][0][2] * cr[1] + a[j][0][3]; cr[2] = a[j][1][0] * cr[2] + a[j][1][1]; cr[3] = a[j][1][2] * cr[3] + a[j][1][3]; }
    }
    for (; i < n; ++i) { const f32x4 a0 = ag[(size_t)i * 512], a1 = ag[(size_t)i * 512 + 1]; cr[0] = a0[0] * cr[0] + a0[1]; cr[1] = a0[2] * cr[1] + a0[3]; cr[2] = a1[0] * cr[2] + a1[1]; cr[3] = a1[2] * cr[3] + a1[3]; }
    const unsigned* hc = (const unsigned*)(kws() + WS_R1) + (size_t)(chunk * 64 + tq) * 1024 + ch;
    const bf16_t* zg = (const bf16_t*)(kws() + WS_Z) + (size_t)(chunk * 64 + tq) * ZLD + C_AG + ch;
    bf16_t* br = (bf16_t*)(kws() + WS_BR) + (size_t)(chunk * 64 + tq) * 3072 + ch;
    u32x4 hv[16]; u32x2 gv[16];
#pragma unroll
    for (int k = 0; k < 16; ++k) { hv[k] = *(const u32x4*)(hc + (size_t)(4 * k) * 1024); gv[k] = *(const u32x2*)(zg + (size_t)(4 * k) * ZLD); }
    f32x4 h = {0.f, 0.f, 0.f, 0.f};
#pragma unroll
    for (int k = 0; k < 16; ++k) {
        h[0] = bflo(hv[k].x) + bfhi(hv[k].x) * cr[0]; h[1] = bflo(hv[k].y) + bfhi(hv[k].y) * cr[1]; h[2] = bflo(hv[k].z) + bfhi(hv[k].z) * cr[2]; h[3] = bflo(hv[k].w) + bfhi(hv[k].w) * cr[3];
        u32x2 w; w.x = pk2(h[0] * gelu_tanh(bflo(gv[k].x)), h[1] * gelu_tanh(bfhi(gv[k].x))); w.y = pk2(h[2] * gelu_tanh(bflo(gv[k].y)), h[3] * gelu_tanh(bfhi(gv[k].y)));
        *(u32x2*)(br + (size_t)(4 * k) * 3072) = w;
    }
    if (tq == 3) {
        if (smp) *(f32x4*)(kout() + O_SLRU + ((size_t)l * 32 + (chunk - 256)) * 1024 + ch) = h;
        else if (n == 127) *(f32x4*)(kout() + O_PLRU + ((size_t)l * 2 + (chunk >> 7)) * 1024 + ch) = h;
    }
}

#define MFMA32(a, b, cc) __builtin_amdgcn_mfma_f32_32x32x16_bf16((a), (b), (cc), 0, 0, 0)
typedef short s16x4 __attribute__((ext_vector_type(4)));
template <int MODE, class Src>
DI void attn_item(LAS unsigned char* lds, const Src& src, const bf16_t* Qp  , bf16_t* Op  , int nband, int jj0, float sink_l2, const LAS float* tbl, int qbase, int tid) {
    constexpr int NT = MODE ? 4 : 1, NL = 2 * NT;
    const int lane = tid & 63, w = __builtin_amdgcn_readfirstlane(tid >> 6), r = lane & 31, h = lane >> 5;
    const int hl = MODE ? (w >> 1) : 0;
    const int lq = lane >> 4, chp = lane & 15;
#define ATT_ISSUE(jj_, isV_) do { _Pragma("unroll") for (int i_ = 0; i_ < NL; ++i_) { \
        const int t_ = MODE ? (w >> 1) : 0, rowb_ = MODE ? ((w & 1) * 32 + 4 * i_) : (8 * w + 4 * i_); \
        const int row_ = rowb_ + lq, ch_ = chp ^ ((lq << 2) | ((rowb_ >> 2) & 3)); \
        const bf16_t* base_; int st_; src.get((jj_), t_, (isV_), base_, st_); \
        __builtin_amdgcn_global_load_lds((const unsigned*)(base_ + (size_t)row_ * st_ + ch_ * 8), (LAS unsigned*)(lds + ((isV_) ? 65536 : 0) + t_ * 16384 + rowb_ * 256), 16, 0, 0); } } while (0)
    bf16x8 qf[8];
#pragma unroll
    for (int ks = 0; ks < 8; ++ks) qf[ks] = *(const bf16x8*)(Qp + (size_t)r * ZLD + ks * 16 + h * 8);
    f32x16 o[4];
#pragma unroll
    for (int db = 0; db < 4; ++db)
#pragma unroll
        for (int i = 0; i < 16; ++i) o[db][i] = 0.f;
    float mrun = MODE == 0 ? sink_l2 : -1e30f, lrun = MODE == 0 ? 1.f : 0.f;
    const float sc = 0.08838834764831845f * LOG2E;
    const LAS unsigned char* Kt = lds + hl * 16384 + 256 * r;
    const int kx = 16 * (h ^ (((r & 3) << 2) | ((r >> 2) & 3)));
    const int blk = (lane >> 4) & 1, q = (lane & 15) >> 2, p = lane & 3;
    const LAS unsigned char* Vt = lds + 65536 + hl * 16384 + 256 * (4 * h + q) + 8 * (p & 1);
    const int vlo = 2 * blk + (p >> 1);
    ATT_ISSUE(jj0, false); ATT_ISSUE(jj0, true);
    for (int jj = jj0; jj < nband; ++jj) {
        const bool last = (jj == nband - 1);
        if (MODE) asm volatile("s_waitcnt vmcnt(8)" ::: "memory"); else asm volatile("s_waitcnt vmcnt(2)" ::: "memory");
        __builtin_amdgcn_s_barrier(); asm volatile("" ::: "memory");
        f32x16 s[2];
#pragma unroll
        for (int kb = 0; kb < 2; ++kb) {
#pragma unroll
            for (int i = 0; i < 16; ++i) s[kb][i] = 0.f;
#pragma unroll
            for (int ks = 0; ks < 8; ++ks) { const bf16x8 kf = *(const LAS bf16x8*)(Kt + 8192 * kb + ((32 * ks) ^ kx)); s[kb] = MFMA32(kf, qf[ks], s[kb]); }
        }
        asm volatile("s_waitcnt lgkmcnt(0)" ::: "memory"); __builtin_amdgcn_s_barrier(); asm volatile("" ::: "memory");
        if (!last) ATT_ISSUE(jj + 1, false);
        const bool cb = MODE == 0 || jj <= 5; const float bc = (MODE == 1 && cb) ? tbl[256] : 0.f, esc = cb ? sc : 1.0f;
        if (!cb) {
#pragma unroll
            for (int kb = 0; kb < 2; ++kb) {
                const int dbase = qbase + r - kb * 32 - 4 * h + (8 - jj) * 64 + 128;
#pragma unroll
                for (int i = 0; i < 16; ++i) { int idx = dbase - ((i & 3) + 8 * (i >> 2)); idx = idx > 256 ? 256 : idx; idx = idx < 0 ? 0 : idx; s[kb][i] = s[kb][i] * sc + tbl[idx]; }
            }
        }
        float bm = fmaxf(s[0][0], s[1][0]);
#pragma unroll
        for (int i = 1; i < 16; ++i) bm = fmaxf(bm, fmaxf(s[0][i], s[1][i]));
        bm = bm * esc + bc;
        bm = fmaxf(bm, __shfl_xor(bm, 32));
        if (__builtin_amdgcn_ballot_w64(bm > mrun + 8.0f) != 0ull) {
            const float mnew = fmaxf(mrun, bm), alpha = __builtin_amdgcn_exp2f(mrun - mnew);
            lrun *= alpha; mrun = mnew;
#pragma unroll
            for (int db = 0; db < 4; ++db)
#pragma unroll
                for (int i = 0; i < 16; ++i) o[db][i] *= alpha;
        }
        float ps = 0.f; const float eoff = bc - mrun;
#pragma unroll
        for (int kb = 0; kb < 2; ++kb)
#pragma unroll
            for (int i = 0; i < 16; ++i) { s[kb][i] = __builtin_amdgcn_exp2f(__builtin_fmaf(s[kb][i], esc, eoff)); ps += s[kb][i]; }
        ps += __shfl_xor(ps, 32);
        lrun += ps;
        if (last) asm volatile("s_waitcnt vmcnt(0)" ::: "memory"); else { if (MODE) asm volatile("s_waitcnt vmcnt(8)" ::: "memory"); else asm volatile("s_waitcnt vmcnt(2)" ::: "memory"); }
        __builtin_amdgcn_s_barrier(); asm volatile("" ::: "memory");
#pragma unroll
        for (int kb = 0; kb < 2; ++kb)
#pragma unroll
            for (int st = 0; st < 2; ++st) {
                u32x4 pp; pp.x = pk2(s[kb][8 * st + 0], s[kb][8 * st + 1]); pp.y = pk2(s[kb][8 * st + 2], s[kb][8 * st + 3]); pp.z = pk2(s[kb][8 * st + 4], s[kb][8 * st + 5]); pp.w = pk2(s[kb][8 * st + 6], s[kb][8 * st + 7]);
                const bf16x8 pf = __builtin_bit_cast(bf16x8, pp);
#pragma unroll
                for (int db = 0; db < 4; ++db) {
                    s16x4 v2[2];
#pragma unroll
                    for (int t = 0; t < 2; ++t) {
                        const int f = (q << 2) | ((2 * t + h) & 3);
                        v2[t] = __builtin_amdgcn_ds_read_tr16_b64_v4i16((LAS s16x4*)(Vt + 256 * (32 * kb + 16 * st + 8 * t) + 16 * ((4 * db + vlo) ^ f)));
                    }
                    const bf16x8 vf = __builtin_shufflevector(v2[0], v2[1], 0, 1, 2, 3, 4, 5, 6, 7);
                    o[db] = MFMA32(vf, pf, o[db]);
                }
            }
        asm volatile("s_waitcnt lgkmcnt(0)" ::: "memory"); __builtin_amdgcn_s_barrier(); asm volatile("" ::: "memory");
        if (!last) ATT_ISSUE(jj + 1, true);
    }
#undef ATT_ISSUE
    const float inv = 1.0f / lrun;
#pragma unroll
    for (int db = 0; db < 4; ++db)
#pragma unroll
        for (int gp = 0; gp < 4; gp += 2) {
            u32x2 a, b;
            a.x = pk2(o[db][4 * gp] * inv, o[db][4 * gp + 1] * inv); a.y = pk2(o[db][4 * gp + 2] * inv, o[db][4 * gp + 3] * inv);
            b.x = pk2(o[db][4 * gp + 4] * inv, o[db][4 * gp + 5] * inv); b.y = pk2(o[db][4 * gp + 6] * inv, o[db][4 * gp + 7] * inv);
            const auto r0 = __builtin_amdgcn_permlane32_swap(a.x, b.x, false, false); const auto r1 = __builtin_amdgcn_permlane32_swap(a.y, b.y, false, false);
            u32x4 w; w.x = r0[0]; w.y = r1[0]; w.z = r0[1]; w.w = r1[1];
            *(u32x4*)(Op + (size_t)r * 3072 + db * 32 + 8 * gp + 8 * h) = w;
        }
}
DI void attn_quad(LAS unsigned char* lds, const bf16_t* Z, bf16_t* BR, int c0  , int head, const LAS float* tbl, int tid) {
    const int lane = tid & 63, w = __builtin_amdgcn_readfirstlane(tid >> 6), r = lane & 31, h = lane >> 5;
    const int qc = w >> 1, qh = w & 1;
    const int lq = lane >> 4, chp = lane & 15;
    const int n0 = c0 & 127, j0 = n0 < 8 ? 8 - n0 : 0;
    const bf16_t* Qp = Z + (size_t)((c0 + qc) * 64 + qh * 32) * ZLD + C_QC + head * 128;
    bf16_t* Op = BR + (size_t)((c0 + qc) * 64 + qh * 32) * 3072 + 2048 + head * 128;
#define AQ_ISSUE(j_) do { const bf16_t* kb_ = Z + (size_t)(c0 - 8 + (j_)) * 64 * ZLD + C_KC + head * 128; LAS unsigned char* st_ = lds + ((j_) & 3) * 32768; \
        _Pragma("unroll") for (int i_ = 0; i_ < 2; ++i_) { const int rowb_ = 8 * w + 4 * i_, row_ = rowb_ + lq, ch_ = chp ^ ((lq << 2) | ((rowb_ >> 2) & 3)); \
            __builtin_amdgcn_global_load_lds((const unsigned*)(kb_ + (size_t)row_ * ZLD + ch_ * 8), (LAS unsigned*)(st_ + rowb_ * 256), 16, 0, 0); \
            __builtin_amdgcn_global_load_lds((const unsigned*)(kb_ + (C_VC - C_KC) + (size_t)row_ * ZLD + ch_ * 8), (LAS unsigned*)(st_ + 16384 + rowb_ * 256), 16, 0, 0); } } while (0)
    bf16x8 qf[8];
#pragma unroll
    for (int ks = 0; ks < 8; ++ks) qf[ks] = *(const bf16x8*)(Qp + (size_t)r * ZLD + ks * 16 + h * 8);
    f32x16 o[4];
#pragma unroll
    for (int db = 0; db < 4; ++db)
#pragma unroll
        for (int i = 0; i < 16; ++i) o[db][i] = 0.f;
    float mrun = -1e30f, lrun = 0.f;
    const float sc = 0.08838834764831845f * LOG2E;
    const int kx = 16 * (h ^ (((r & 3) << 2) | ((r >> 2) & 3)));
    const int blk = (lane >> 4) & 1, q = (lane & 15) >> 2, p = lane & 3;
    const int vlo = 2 * blk + (p >> 1);
    const int qbase = qh * 32;
    AQ_ISSUE(j0); if (j0 + 1 < 12) AQ_ISSUE(j0 + 1); if (j0 + 2 < 12) AQ_ISSUE(j0 + 2);
    for (int j = j0; j < 12; ++j) {
        if (j + 2 < 12) asm volatile("s_waitcnt vmcnt(8)" ::: "memory"); else if (j + 1 < 12) asm volatile("s_waitcnt vmcnt(4)" ::: "memory"); else asm volatile("s_waitcnt vmcnt(0)" ::: "memory");
        asm volatile("s_waitcnt lgkmcnt(0)" ::: "memory"); __builtin_amdgcn_s_barrier(); asm volatile("" ::: "memory");
        if (j + 3 < 12) AQ_ISSUE(j + 3);
        const int jj = j - qc;
        if (jj < 0 || jj > 8) continue;
        const LAS unsigned char* Kt = lds + (j & 3) * 32768 + 256 * r;
        const LAS unsigned char* Vt = lds + (j & 3) * 32768 + 16384 + 256 * (4 * h + q) + 8 * (p & 1);
        f32x16 s[2];
#pragma unroll
        for (int kb = 0; kb < 2; ++kb) {
#pragma unroll
            for (int i = 0; i < 16; ++i) s[kb][i] = 0.f;
#pragma unroll
            for (int ks = 0; ks < 8; ++ks) { const bf16x8 kf = *(const LAS bf16x8*)(Kt + 8192 * kb + ((32 * ks) ^ kx)); s[kb] = MFMA32(kf, qf[ks], s[kb]); }
        }
        const bool cb = jj <= 5; const float bc = cb ? tbl[256] : 0.f, esc = cb ? sc : 1.0f;
        if (!cb) {
#pragma unroll
            for (int kb = 0; kb < 2; ++kb) {
                const int dbase = qbase + r - kb * 32 - 4 * h + (8 - jj) * 64 + 128;
#pragma unroll
                for (int i = 0; i < 16; ++i) { int idx = dbase - ((i & 3) + 8 * (i >> 2)); idx = idx > 256 ? 256 : idx; idx = idx < 0 ? 0 : idx; s[kb][i] = s[kb][i] * sc + tbl[idx]; }
            }
        }
        float bm = fmaxf(s[0][0], s[1][0]);
#pragma unroll
        for (int i = 1; i < 16; ++i) bm = fmaxf(bm, fmaxf(s[0][i], s[1][i]));
        bm = bm * esc + bc;
        bm = fmaxf(bm, __shfl_xor(bm, 32));
        if (__builtin_amdgcn_ballot_w64(bm > mrun + 8.0f) != 0ull) {
            const float mnew = fmaxf(mrun, bm), alpha = __builtin_amdgcn_exp2f(mrun - mnew);
            lrun *= alpha; mrun = mnew;
#pragma unroll
            for (int db = 0; db < 4; ++db)
#pragma unroll
                for (int i = 0; i < 16; ++i) o[db][i] *= alpha;
        }
        float ps = 0.f; const float eoff = bc - mrun;
#pragma unroll
        for (int kb = 0; kb < 2; ++kb)
#pragma unroll
            for (int i = 0; i < 16; ++i) { s[kb][i] = __builtin_amdgcn_exp2f(__builtin_fmaf(s[kb][i], esc, eoff)); ps += s[kb][i]; }
        ps += __shfl_xor(ps, 32);
        lrun += ps;
#pragma unroll
        for (int kb = 0; kb < 2; ++kb)
#pragma unroll
            for (int st = 0; st < 2; ++st) {
                u32x4 pp; pp.x = pk2(s[kb][8 * st + 0], s[kb][8 * st + 1]); pp.y = pk2(s[kb][8 * st + 2], s[kb][8 * st + 3]); pp.z = pk2(s[kb][8 * st + 4], s[kb][8 * st + 5]); pp.w = pk2(s[kb][8 * st + 6], s[kb][8 * st + 7]);
                const bf16x8 pf = __builtin_bit_cast(bf16x8, pp);
#pragma unroll
                for (int db = 0; db < 4; ++db) {
                    s16x4 v2[2];
#pragma unroll
                    for (int t = 0; t < 2; ++t) {
                        const int f = (q << 2) | ((2 * t + h) & 3);
                        v2[t] = __builtin_amdgcn_ds_read_tr16_b64_v4i16((LAS s16x4*)(Vt + 256 * (32 * kb + 16 * st + 8 * t) + 16 * ((4 * db + vlo) ^ f)));
                    }
                    const bf16x8 vf = __builtin_shufflevector(v2[0], v2[1], 0, 1, 2, 3, 4, 5, 6, 7);
                    o[db] = MFMA32(vf, pf, o[db]);
                }
            }
    }
#undef AQ_ISSUE
    asm volatile("s_waitcnt lgkmcnt(0)" ::: "memory"); __builtin_amdgcn_s_barrier(); asm volatile("" ::: "memory");
    const float inv = 1.0f / lrun;
#pragma unroll
    for (int db = 0; db < 4; ++db)
#pragma unroll
        for (int gp = 0; gp < 4; gp += 2) {
            u32x2 a, b;
            a.x = pk2(o[db][4 * gp] * inv, o[db][4 * gp + 1] * inv); a.y = pk2(o[db][4 * gp + 2] * inv, o[db][4 * gp + 3] * inv);
            b.x = pk2(o[db][4 * gp + 4] * inv, o[db][4 * gp + 5] * inv); b.y = pk2(o[db][4 * gp + 6] * inv, o[db][4 * gp + 7] * inv);
            const auto r0 = __builtin_amdgcn_permlane32_swap(a.x, b.x, false, false); const auto r1 = __builtin_amdgcn_permlane32_swap(a.y, b.y, false, false);
            u32x4 w; w.x = r0[0]; w.y = r1[0]; w.z = r0[1]; w.w = r1[1];
            *(u32x4*)(Op + (size_t)r * 3072 + db * 32 + 8 * gp + 8 * h) = w;
        }
}
struct SrcSwa {
    const bf16_t* Z; const bf16_t* KcB; const bf16_t* VcB; int chunk, kv;
    DI void get(int jj, int t, bool isV, const bf16_t*& base, int& st) const {
        if (chunk < 256) { const int cc = chunk - 2 + jj; base = Z + (size_t)cc * 64 * ZLD + (isV ? C_VB : C_KB) + kv * 128; st = ZLD; return; }
        const int bs = chunk - 256;
        if (jj < 2) { base = (isV ? VcB : KcB) + (size_t)(bs * 128 + jj * 64) * 256 + kv * 128; st = 256; return; }
        base = Z + (size_t)chunk * 64 * ZLD + (isV ? C_VB : C_KB) + kv * 128; st = ZLD;
    }
};
struct SrcCb {
    const bf16_t* Z; const bf16_t* KcC; const bf16_t* VcC; int chunk, head0;
    DI void get(int jj, int t, bool isV, const bf16_t*& base, int& st) const {
        const int head = head0 + t;
        if (chunk < 256) { const int cc = chunk - 8 + jj; base = Z + (size_t)cc * 64 * ZLD + (isV ? C_VC : C_KC) + head * 128; st = ZLD; return; }
        const int bs = chunk - 256;
        if (jj < 8) { base = (isV ? VcC : KcC) + (size_t)(bs * 512 + jj * 64) * 1024 + head * 128; st = 1024; return; }
        base = Z + (size_t)chunk * 64 * ZLD + (isV ? C_VC : C_KC) + head * 128; st = ZLD;
    }
};

DI void copy_state(const Ctx& c, float* dst, int nb, int rows, int width, int row0, int bstride, int col) {
    const bf16_t* Z = (const bf16_t*)(kws() + WS_Z);
    const int w8 = width >> 3; const size_t total = (size_t)nb * rows * w8;
    for (size_t i = (size_t)c.bid * NTHR + c.tid; i < total; i += (size_t)c.G * NTHR) {
        const int e = (int)(i % w8); const size_t rt = i / w8; const int t = (int)(rt % rows), b = (int)(rt / rows);
        const u32x4 v = *(const u32x4*)(Z + (size_t)(row0 + b * bstride + t) * ZLD + col + 8 * e);
        f32x4* d = (f32x4*)(dst + ((size_t)(b * rows + t) * width + 8 * e));
        d[0] = (f32x4){bflo(v.x), bfhi(v.x), bflo(v.y), bfhi(v.y)}; d[1] = (f32x4){bflo(v.z), bfhi(v.z), bflo(v.w), bfhi(v.w)};
    }
}

DI void inproj_tail_combine(const Ctx& c) {
    const float* part = (const float*)(kws() + WS_PART); const float* rs = (const float*)(kws() + WS_RS); bf16_t* Z = (bf16_t*)(kws() + WS_Z);
    for (int i = c.bid * NTHR + c.tid; i < 16 * 8192; i += c.G * NTHR) {
        const int tile = i >> 13, e = i & 8191, r = e >> 5, c8 = (e & 31) * 8, row = 71 * 256 + r;
        const float* p = part + ((size_t)tile * 256 + r) * 256 + c8;
        f32x4 v0 = *(const f32x4*)p, v1 = *(const f32x4*)(p + 4);
#pragma unroll
        for (int ks = 1; ks < 8; ++ks) { v0 += *(const f32x4*)(p + (size_t)ks * 16 * 65536); v1 += *(const f32x4*)(p + (size_t)ks * 16 * 65536 + 4); }
        const float sc = rs[row];
#pragma unroll
        for (int j = 0; j < 4; ++j) { v0[j] = __builtin_amdgcn_rcpf(1.0f + __expf(-v0[j] * sc)); v1[j] = __builtin_amdgcn_rcpf(1.0f + __expf(-v1[j] * sc)); }
        *(u32x2*)((unsigned char*)(kws() + WS_GATE) + (((size_t)71 * 24 + tile) * 256 + r) * 256 + c8) = pg8::packq8(v0, v1);
    }
}
DI void phase_postD(const Ctx& c) {
    const float* part = (const float*)(kws() + WS_PART); bf16_t* act = (bf16_t*)(kws() + WS_ACT2) + (size_t)MP * DM;
    const size_t total = (size_t)MS * DM / 8;
    for (size_t i = (size_t)c.bid * NTHR + c.tid; i < total; i += (size_t)c.G * NTHR) {
        const f32x4* p = (const f32x4*)part + 2 * i; const size_t st = (size_t)MS * DM / 4;
        const f32x4 v0 = p[0] + p[st] + p[2 * st], v1 = p[1] + p[st + 1] + p[2 * st + 1];
        ((u32x4*)act)[i] = pg8::pack8(v0, v1);
    }
}
DI void phase_postRes(const Ctx& c, const float* xinS  ) {
    const int gw = c.bid * NWAVES + c.wave, NGW = c.G * NWAVES;
    bf16_t* act = (bf16_t*)(kws() + WS_ACT); float* rs = (float*)(kws() + WS_RS); const float* part = (const float*)(kws() + WS_PART);
    for (int row = MP + gw; row < M; row += NGW) {
        const f32x4* pr = (const f32x4*)(part + (size_t)(row - MP) * DM) + c.lane; const size_t st = (size_t)MS * DM / 4;
        u32x2* ao = (u32x2*)(act + (size_t)row * DM) + c.lane;
        float s = 0.f;
#pragma unroll
        for (int j = 0; j < 8; ++j) {
            f32x4 xi;
            if (xinS) xi = ((const f32x4*)(xinS + (size_t)(row - MP) * DM) + c.lane)[64 * j];
            else { const u32x2 w = ao[64 * j]; xi = (f32x4){bflo(w.x), bfhi(w.x), bflo(w.y), bfhi(w.y)}; }
            const f32x4 v = xi + ((pr[64 * j] + pr[st + 64 * j]) + (pr[2 * st + 64 * j] + pr[3 * st + 64 * j]));
            u32x2 w; w.x = pk2(v[0], v[1]); w.y = pk2(v[2], v[3]); ao[64 * j] = w;
            s += (v[0] * v[0] + v[1] * v[1]) + (v[2] * v[2] + v[3] * v[3]);
        }
        s = wave_sum(s);
        if (c.lane == 0) rs[row] = 1.0f / sqrtf(s * (1.0f / DM) + EPS);
    }
    const float* ssq = (const float*)(kws() + WS_SSQ);
    for (int row = c.bid * NTHR + c.tid; row < MP; row += c.G * NTHR) {
        const f32x4* q = (const f32x4*)(ssq + (size_t)row * 32); float s = 0.f;
#pragma unroll
        for (int j = 0; j < 8; ++j) { const f32x4 v = q[j]; s += (v[0] + v[1]) + (v[2] + v[3]); }
        rs[row] = 1.0f / sqrtf(s * (1.0f / DM) + EPS);
    }
}

DI void phase_postRes_final(const Ctx& c) {
    const int gw = c.bid * NWAVES + c.wave, NGW = c.G * NWAVES;
    const bf16_t* act = (const bf16_t*)(kws() + WS_ACT); const float* part = (const float*)(kws() + WS_PART); const float* ssq = (const float*)(kws() + WS_SSQ);
    const f32x4* gp = (const f32x4*)kin<24>() + c.lane;
    f32x4 gv[8];
#pragma unroll
    for (int j = 0; j < 8; ++j) gv[j] = gp[64 * j];
    for (int row = MP + gw; row < M; row += NGW) {
        const f32x4* pr = (const f32x4*)(part + (size_t)(row - MP) * DM) + c.lane; const size_t st = (size_t)MS * DM / 4;
        const u32x2* ai = (const u32x2*)(act + (size_t)row * DM) + c.lane; f32x4* yr = (f32x4*)(kout() + (size_t)row * DM) + c.lane;
        f32x4 v[8]; float s = 0.f;
#pragma unroll
        for (int j = 0; j < 8; ++j) { const u32x2 w = ai[64 * j]; const f32x4 xi = {bflo(w.x), bfhi(w.x), bflo(w.y), bfhi(w.y)};
            v[j] = xi + ((pr[64 * j] + pr[st + 64 * j]) + (pr[2 * st + 64 * j] + pr[3 * st + 64 * j])); s += (v[j][0] * v[j][0] + v[j][1] * v[j][1]) + (v[j][2] * v[j][2] + v[j][3] * v[j][3]); }
        s = wave_sum(s); const float r = 1.0f / sqrtf(s * (1.0f / DM) + EPS);
#pragma unroll
        for (int j = 0; j < 8; ++j) yr[64 * j] = v[j] * r * gv[j];
    }
    for (int row = gw; row < MP; row += NGW) {
        float s = c.lane < 32 ? ssq[(size_t)row * 32 + c.lane] : 0.f; s = wave_sum(s); const float r = 1.0f / sqrtf(s * (1.0f / DM) + EPS);
        const u32x2* xr = (const u32x2*)(act + (size_t)row * DM) + c.lane; f32x4* yr = (f32x4*)(kout() + (size_t)row * DM) + c.lane;
#pragma unroll
        for (int j = 0; j < 8; ++j) { const u32x2 w = xr[64 * j]; yr[64 * j] = (f32x4){bflo(w.x), bfhi(w.x), bflo(w.y), bfhi(w.y)} * r * gv[j]; }
    }
}

struct Args { const float* in[25]; float* out; unsigned char* ws; int ph_lo, ph_hi; };
constexpr int PH_PER_LAYER = 11, PH_FINAL = 1 + DEPTH * PH_PER_LAYER, PH_COUNT = PH_FINAL + 1;

__global__ void __launch_bounds__(NTHR, 2) fwd_kernel(Args args) {
    extern __shared__ __attribute__((aligned(16))) unsigned char lds_raw[];
    LAS unsigned char* const lds = (LAS unsigned char*)lds_raw;
    volatile LAS unsigned* misc = (volatile LAS unsigned*)(lds + LDS_MISC);
    if (threadIdx.x < 4) misc[threadIdx.x] = 0u;
    __syncthreads();
    const int lo = args.ph_lo, hi = args.ph_hi;
    XcdBarrier bar; bar.bar = (unsigned*)(kws() + WS_BAR); bar.x = 0; bar.st = misc;
    if (hi - lo > 1) bar = xcd_barrier_post((unsigned*)(kws() + WS_BAR), misc);
#define IN(k) (lo <= (k) && (k) < hi)
#define SEAM(k) do { if ((k) + 1 < hi) { bar.bar = (unsigned*)(kws() + WS_BAR); xcd_barrier(bar); } } while (0)
#define WSP(T, off) ((T*)(kws() + (off)))
#ifndef PHMASK
#define PHMASK 0xFFFF
#endif
#define PHON(j) ((PHMASK >> (j)) & 1)
#ifndef PROBE_MASK
#define PROBE_MASK 0
#endif
#define REP(j) for (int rep_ = 0; rep_ < 1 + ((PROBE_MASK >> (j)) & 1); ++rep_)
    if (PHON(14) && IN(0)) { REP(14) { const Ctx c = make_ctx(lds); phase_prologue(c); phase_norm(c, kin<0>(), kin<1>() - (size_t)MP * DM); } SEAM(0); }

    for (int l = 0; l < DEPTH; ++l) {
        const int pb = 1 + l * PH_PER_LAYER;
        if (PHON(1) && IN(pb + 1)) {
            pg8::InprojOrder S{{WSP(bf16_t, WS_ACT), WSP(bf16_t, WS_W) + (size_t)l * WL_SIZE + WL_IN, DM, DM}, (int)gridDim.x, (int)blockIdx.x};
            pg8::EpiInproj E{WSP(bf16_t, WS_Z), WSP(float, WS_RS), WSP(float, WS_PART), WSP(unsigned char, WS_GATE)};
            REP(1) pg8::gemm_phase(lds, S, E);
            {
                const Ctx c = make_ctx(lds); const int extra = (3584 + 128) % c.G;
                if (extra == 0 || c.bid >= extra) phase_cacheconv(c, l, extra == 0 ? c.bid : c.bid - extra, extra == 0 ? c.G : c.G - extra);
            }
            SEAM(pb + 1);
        }
        if (PHON(2) && IN(pb + 2)) {
            const Ctx c = make_ctx(lds);
            inproj_tail_combine(c);
            REP(12) lru_local_phase(c, l);
            REP(13) for (int u = c.bid; u < (c.G >= 128 ? 512 : NCHUNK * 2); u += c.G) {
                const int chunk = u >> 1, kv = u & 1, head = kv * 4 + (c.wave >> 1), qh = c.wave & 1;
                const bf16_t* Z = WSP(bf16_t, WS_Z);
                SrcSwa src{Z, WSP(bf16_t, WS_KCB), WSP(bf16_t, WS_VTCB), chunk, kv};
                const int n = chunk & 127, jj0 = (chunk < 256 && n < 2) ? 2 - n : 0;
                attn_item<0>(c.lds, src, Z + (size_t)(chunk * 64 + qh * 32) * ZLD + C_QB + head * 128, WSP(bf16_t, WS_BR) + (size_t)(chunk * 64 + qh * 32) * 3072 + 1024 + head * 128, 3, jj0,
                             kin<17>()[l * 8 + head] * LOG2E, nullptr, 0, c.tid);
            }
            SEAM(pb + 2);
        }
        if (PHON(3) && IN(pb + 3)) {
            const Ctx c = make_ctx(lds);
            LAS float* tbl = (LAS float*)(c.lds + LDS_TBL);
            for (int i = c.tid; i < 8 * 257; i += NTHR) { const int hh = i / 257, e = i - hh * 257; tbl[hh * 260 + e] = kin<18>()[(size_t)l * 8 * 257 + i] * LOG2E; }
            __syncthreads();
            REP(3) {
            {
                const bf16_t* Z = WSP(bf16_t, WS_Z);
                for (int u = c.bid; u < 512; u += c.G) {
                    const int x = u & 7, k = u >> 3;
                    attn_quad(c.lds, Z, WSP(bf16_t, WS_BR), 4 * k, x, tbl + x * 260, c.tid);
                }
            }
            {
                const int nsmp = c.G >= 128 ? 64 : 0;
                if (c.bid < nsmp || nsmp == 0) {
                    for (int u = c.bid; u < 64; u += (nsmp ? nsmp : c.G)) {
                        const int hg = u & 1, chunk = 256 + (u >> 1), head = hg * 4 + (c.wave >> 1), qh = c.wave & 1;
                        const bf16_t* Z = WSP(bf16_t, WS_Z);
                        SrcCb src{Z, WSP(bf16_t, WS_KCC), WSP(bf16_t, WS_VTCC), chunk, hg * 4};
                        attn_item<1>(c.lds, src, Z + (size_t)(chunk * 64 + qh * 32) * ZLD + C_QC + head * 128, WSP(bf16_t, WS_BR) + (size_t)(chunk * 64 + qh * 32) * 3072 + 2048 + head * 128, 9, 0,
                                     0.f, tbl + head * 260, qh * 32, c.tid);
                    }
                    if (nsmp) {
                        const int u = 512 + c.bid, chunk = u >> 1, kv = u & 1, head = kv * 4 + (c.wave >> 1), qh = c.wave & 1;
                        const bf16_t* Z = WSP(bf16_t, WS_Z);
                        SrcSwa src{Z, WSP(bf16_t, WS_KCB), WSP(bf16_t, WS_VTCB), chunk, kv};
                        attn_item<0>(c.lds, src, Z + (size_t)(chunk * 64 + qh * 32) * ZLD + C_QB + head * 128, WSP(bf16_t, WS_BR) + (size_t)(chunk * 64 + qh * 32) * 3072 + 1024 + head * 128, 3, 0,
                                     kin<17>()[l * 8 + head] * LOG2E, nullptr, 0, c.tid);
                    }
                }
                if (c.bid >= nsmp) for (int u = c.bid - nsmp; u < NCHUNK * 2; u += c.G - nsmp) lru_fix_unit(c, l, u >> 1, u & 1);
            }
            copy_state(c, kout() + O_PCONV + (size_t)l * 2 * 3 * 1024, 2, 3, 1024, 8189, 8192, C_AX);
            copy_state(c, kout() + O_SCONV + (size_t)l * 32 * 3 * 1024, 32, 3, 1024, MP + 61, 64, C_AX);
            copy_state(c, kout() + O_PSWAK + (size_t)l * 2 * 128 * 256, 2, 128, 256, 8192 - 128, 8192, C_KB);
            copy_state(c, kout() + O_PSWAV + (size_t)l * 2 * 128 * 256, 2, 128, 256, 8192 - 128, 8192, C_VB);
            copy_state(c, kout() + O_PCBK + (size_t)l * 2 * 512 * 1024, 2, 512, 1024, 8192 - 512, 8192, C_KC);
            copy_state(c, kout() + O_PCBV + (size_t)l * 2 * 512 * 1024, 2, 512, 1024, 8192 - 512, 8192, C_VC);
            copy_state(c, kout() + O_SSWAK + (size_t)l * 32 * 64 * 256, 32, 64, 256, MP, 64, C_KB);
            copy_state(c, kout() + O_SSWAV + (size_t)l * 32 * 64 * 256, 32, 64, 256, MP, 64, C_VB);
            copy_state(c, kout() + O_SCBK + (size_t)l * 32 * 64 * 1024, 32, 64, 1024, MP, 64, C_KC);
            copy_state(c, kout() + O_SCBV + (size_t)l * 32 * 64 * 1024, 32, 64, 1024, MP, 64, C_VC);
            }
            SEAM(pb + 3);
        }
        if (PHON(4) && IN(pb + 4)) {
            pg8::SplitOrder S{{WSP(bf16_t, WS_BR), WSP(bf16_t, WS_W) + (size_t)l * WL_SIZE + WL_BR, 3 * BW, 3 * BW}, (int)gridDim.x, (int)blockIdx.x, 3 * BW / 64, 3, BW / 64};
            pg8::EpiD E{WSP(unsigned char, WS_GATE), WSP(bf16_t, WS_ACT2), WSP(float, WS_PART)};
            pg8::gemm_phase(lds, S, E);
            SEAM(pb + 4);
        }
        if (PHON(5) && IN(pb + 5)) { const Ctx c = make_ctx(lds); phase_postD(c); SEAM(pb + 5); }
        if (PHON(6) && IN(pb + 6)) {
            pg8::SplitOrder S{{WSP(bf16_t, WS_ACT2), WSP(bf16_t, WS_W) + (size_t)l * WL_SIZE + WL_OUT, DM, DM}, (int)gridDim.x, (int)blockIdx.x, DM / 64, 4, DM / 256};
            if (l == 0) { pg8::EpiRes<true> E{kin<0>(), WSP(bf16_t, WS_ACT), WSP(float, WS_SSQ), WSP(float, WS_PART)}; pg8::gemm_phase(lds, S, E); }
            else { pg8::EpiRes<false> E{nullptr, WSP(bf16_t, WS_ACT), WSP(float, WS_SSQ), WSP(float, WS_PART)}; pg8::gemm_phase(lds, S, E); }
            SEAM(pb + 6);
        }
        if (PHON(7) && IN(pb + 7)) { const Ctx c = make_ctx(lds); phase_postRes(c, l == 0 ? kin<1>() : nullptr); SEAM(pb + 7); }
        if (PHON(8) && IN(pb + 8)) {
            pg8::FullOrder S{{WSP(bf16_t, WS_ACT), WSP(bf16_t, WS_W) + (size_t)l * WL_SIZE + WL_UP, DM, DM}, M / 256, DFF / 256, (int)gridDim.x, (int)blockIdx.x, DM / 64};
            pg8::EpiUp E{WSP(bf16_t, WS_Z)  , WSP(float, WS_RS)};
            REP(8) pg8::gemm_phase(lds, S, E);
            SEAM(pb + 8);
        }
        if (PHON(9) && IN(pb + 9)) {
            pg8::SplitOrder S{{WSP(bf16_t, WS_Z), WSP(bf16_t, WS_W) + (size_t)l * WL_SIZE + WL_DOWN, DFF, DFF}, (int)gridDim.x, (int)blockIdx.x, DFF / 64, 4, DFF / 256};
            pg8::EpiRes<false> E{nullptr, WSP(bf16_t, WS_ACT), WSP(float, WS_SSQ), WSP(float, WS_PART)};
            pg8::gemm_phase(lds, S, E);
            SEAM(pb + 9);
        }
        if (PHON(10) && IN(pb + 10)) { const Ctx c = make_ctx(lds); if (l == DEPTH - 1) phase_postRes_final(c); else { phase_postRes(c, nullptr); SEAM(pb + 10); } }
    }
#undef IN
#undef SEAM
}

#ifndef N_LAUNCH_MODE
#define N_LAUNCH_MODE 1
#endif
extern "C" void kernel_launch(void* const* d_in, const int* in_sizes, int n_in, void* d_out, int out_size, void* d_ws, size_t ws_size, hipStream_t stream) {
    static int grid = 0;
    if (grid == 0) {
        if (n_in != 25 || (size_t)out_size != O_END || ws_size < WS_END) { fprintf(stderr, "kernel_launch: unexpected sizes (n_in %d out %d ws %zu need %zu)\n", n_in, out_size, ws_size, (size_t)WS_END); grid = -1; return; }
        int dev = 0, cus = 0, per_cu = 0;
        if (hipGetDevice(&dev) != hipSuccess || hipDeviceGetAttribute(&cus, hipDeviceAttributeMultiprocessorCount, dev) != hipSuccess) { grid = -1; return; }
        if (hipFuncSetAttribute((const void*)fwd_kernel, hipFuncAttributeMaxDynamicSharedMemorySize, LDS_BYTES) != hipSuccess) { fprintf(stderr, "kernel_launch: hipFuncSetAttribute failed\n"); grid = -1; return; }
        if (hipOccupancyMaxActiveBlocksPerMultiprocessor(&per_cu, (const void*)fwd_kernel, NTHR, LDS_BYTES) != hipSuccess || per_cu < 1) { fprintf(stderr, "kernel_launch: occupancy query says %d\n", per_cu); (void)hipGetLastError(); grid = -1; return; }
        grid = cus;
    }
    if (grid < 0) return;
    (void)hipMemsetAsync((char*)d_ws + WS_BAR, 0, 16384, stream);
    Args a{};
    for (int i = 0; i < 25; ++i) a.in[i] = (const float*)d_in[i];
    a.out = (float*)d_out; a.ws = (unsigned char*)d_ws;
#if N_LAUNCH_MODE == 1
    a.ph_lo = 0; a.ph_hi = PH_COUNT;
    hipLaunchKernelGGL(fwd_kernel, dim3(grid), dim3(NTHR), LDS_BYTES, stream, a);
#else
    for (int p = 0; p < PH_COUNT; ++p) { a.ph_lo = p; a.ph_hi = p + 1; hipLaunchKernelGGL(fwd_kernel, dim3(grid), dim3(NTHR), LDS_BYTES, stream, a); }
#endif
}
```

```cpp
#include <hip/hip_runtime.h>
#include <cstdio>
#include <cstdint>

#define LAS __attribute__((address_space(3)))
typedef unsigned short bf16_t;
typedef short bf16x8 __attribute__((ext_vector_type(8)));
typedef float f32x2 __attribute__((ext_vector_type(2)));
typedef float f32x4 __attribute__((ext_vector_type(4)));
typedef float f32x16 __attribute__((ext_vector_type(16)));
typedef unsigned u32x2 __attribute__((ext_vector_type(2)));
typedef unsigned u32x4 __attribute__((ext_vector_type(4)));
typedef __bf16 bf16v2 __attribute__((ext_vector_type(2)));
#define DI __device__ __forceinline__

constexpr int MP = 16384, MS = 2048, M = MP + MS, DM = 2048, DIN = 12800, DFF = 8192, BW = 1024, DEPTH = 4, NCHUNK = M / 64;
constexpr int ZLD = 6656;
constexpr int C_AX = 0, C_AG = 1024, C_QB = 2048, C_KB = 3072, C_VB = 3328, C_QC = 3584, C_KC = 4608, C_VC = 5632, C_G = 6656;
constexpr int NWAVES = 8, NTHR = 512;
constexpr float EPS = 1e-6f, LOG2E = 1.4426950408889634f;
constexpr size_t O_YP = 0, O_YS = O_YP + (size_t)MP * DM, O_PCONV = O_YS + (size_t)MS * DM, O_PLRU = O_PCONV + 4 * 2 * 3 * 1024, O_PSWAK = O_PLRU + 4 * 2 * 1024,
                 O_PSWAV = O_PSWAK + 4 * 2 * 128 * 256, O_PCBK = O_PSWAV + 4 * 2 * 128 * 256, O_PCBV = O_PCBK + (size_t)4 * 2 * 512 * 1024, O_SCONV = O_PCBV + (size_t)4 * 2 * 512 * 1024,
                 O_SLRU = O_SCONV + 4 * 32 * 3 * 1024, O_SSWAK = O_SLRU + 4 * 32 * 1024, O_SSWAV = O_SSWAK + (size_t)4 * 32 * 64 * 256, O_SCBK = O_SSWAV + (size_t)4 * 32 * 64 * 256,
                 O_SCBV = O_SCBK + (size_t)4 * 32 * 64 * 1024, O_END = O_SCBV + (size_t)4 * 32 * 64 * 1024;
constexpr size_t WL_IN = 0, WL_BR = WL_IN + (size_t)DIN * DM, WL_OUT = WL_BR + (size_t)3 * DM * BW, WL_UP = WL_OUT + (size_t)DM * DM, WL_DOWN = WL_UP + (size_t)DFF * DM, WL_SIZE = WL_DOWN + (size_t)DM * DFF;
constexpr size_t al256(size_t x) { return (x + 255) & ~(size_t)255; }
constexpr size_t WS_BAR = 0, WS_RS = 16384, WS_AGG = al256(WS_RS + (size_t)M * 4), WS_LRUW = al256(WS_AGG + (size_t)NCHUNK * 1024 * 2 * 4),
                 WS_W = al256(WS_LRUW + (size_t)DEPTH * 2 * 8 * 128 * 128 * 2), WS_ACT = al256(WS_W + (size_t)DEPTH * WL_SIZE * 2), WS_Z = al256(WS_ACT + (size_t)M * DM * 2),
                 WS_KCB = al256(WS_Z + (size_t)M * DFF * 2),
                 WS_VTCB = al256(WS_KCB + (size_t)32 * 128 * 256 * 2), WS_KCC = al256(WS_VTCB + (size_t)32 * 2 * 2 * 8192 * 2), WS_VTCC = al256(WS_KCC + (size_t)32 * 512 * 1024 * 2),
                 WS_R1 = al256(WS_VTCC + (size_t)32 * 8 * 8 * 8192 * 2), WS_BR = al256(WS_R1 + (size_t)2 * M * 1024 * 4), WS_SSQ = al256(WS_BR + (size_t)M * 3 * BW * 2),
                 WS_PART = al256(WS_SSQ + (size_t)MP * 32 * 4), WS_ACT2 = al256(WS_PART + (size_t)4 * MS * DM * 4), WS_GATE = al256(WS_ACT2 + (size_t)M * DM * 2), WS_END = al256(WS_GATE + (size_t)M * 3 * DM * 2);
constexpr int LDS_STAGE = 131072, LDS_MISC = LDS_STAGE, LDS_TBL = LDS_STAGE + 256, LDS_BYTES = LDS_STAGE + 256 + 8 * 260 * 4 + 64;


template <int OFF> DI unsigned long long karg64() { auto ka = __builtin_amdgcn_kernarg_segment_ptr(); unsigned long long p;
    asm volatile("s_load_dwordx2 %0, %1, %2\n\ts_waitcnt lgkmcnt(0)" : "=s"(p) : "s"(ka), "n"(OFF)); return p; }
template <int I> DI const float* kin() { return (const float*)karg64<I * 8>(); }
DI float* kout() { return (float*)karg64<200>(); }
DI unsigned char* kws() { return (unsigned char*)karg64<208>(); }
DI int launder_tid() { int t = threadIdx.x; asm volatile("" : "+v"(t)); return t; }
DI float bf2f(unsigned short b) { return __uint_as_float(((unsigned)b) << 16); }
DI float bflo(unsigned w) { return __uint_as_float(w << 16); }
DI float bfhi(unsigned w) { return __uint_as_float(w & 0xffff0000u); }
DI unsigned pk2(float a, float b) { f32x2 v = {a, b}; bf16v2 r = __builtin_convertvector(v, bf16v2); return __builtin_bit_cast(unsigned, r); }
DI float wave_sum(float v) {
#pragma unroll
    for (int o = 1; o < 64; o <<= 1) v += __shfl_xor(v, o);
    return v;
}
DI float sigmoidf_(float x) { return 1.0f / (1.0f + __expf(-x)); }
DI float gelu_tanh(float x) { const float u = 0.7978845608028654f * (x + 0.044715f * x * x * x); const float e = __expf(-2.0f * u); return x * (1.0f / (1.0f + e)); }

#define XB_TMO      128
#define XB_XCNT(j)  (256  + 64 * (j))
#define XB_XSUB(j)  (1280 + 64 * (j))
#define XB_XGEN(j)  (2304 + 64 * (j))
#define XB_TOP      3328
#define XB_TOPGEN   3392
#define XCD_BAR_WORDS 3456
#define XB_SPIN_CAP (1u << 20)
DI unsigned xb_ld(unsigned* p)              { return __hip_atomic_load(p, __ATOMIC_RELAXED, __HIP_MEMORY_SCOPE_AGENT); }
DI unsigned xb_add(unsigned* p, unsigned v) { return __hip_atomic_fetch_add(p, v, __ATOMIC_RELAXED, __HIP_MEMORY_SCOPE_AGENT); }
DI unsigned xb_xcc_id() { return (unsigned)__builtin_amdgcn_s_getreg((3 << 11) | 20) & 0xFu; }
#define XB_SPIN(cond, bar) do { unsigned _sp = 0; while (cond) { __builtin_amdgcn_s_sleep(1); \
    if ((++_sp & 255u) == 0u) { if (xb_ld(&(bar)[XB_TMO])) break; if (_sp > XB_SPIN_CAP) { atomicAdd(&(bar)[XB_TMO], 1u); break; } } } } while (0)
struct XcdBarrier { unsigned* bar; unsigned x; volatile LAS unsigned* st; };
DI XcdBarrier xcd_barrier_post(unsigned* bar, volatile LAS unsigned* st) {
    XcdBarrier b; b.bar = bar; b.x = xb_xcc_id(); b.st = st;
    if (threadIdx.x == 0) (void)xb_add(&bar[XB_XCNT(b.x)], 1u);
    return b;
}
DI void xcd_barrier_complete(unsigned* bar, unsigned x, unsigned& nloc, unsigned& nx) {
    const unsigned G = gridDim.x * gridDim.y * gridDim.z;
    unsigned sum, cnt, mine, sp = 0u;
    for (;;) {
        sum = 0u; cnt = 0u; mine = 0u;
#pragma unroll
        for (unsigned j = 0; j < 16; ++j) { const unsigned c = xb_ld(&bar[XB_XCNT(j)]); sum += c; cnt += (c > 0u) ? 1u : 0u; mine = (j == x) ? c : mine; }
        if (sum == G) break;
        __builtin_amdgcn_s_sleep(1);
        if ((++sp & 255u) == 0u) { if (xb_ld(&bar[XB_TMO])) break; if (sp > XB_SPIN_CAP) { atomicAdd(&bar[XB_TMO], 1u); break; } }
    }
    nloc = mine > 0u ? mine : 1u; nx = cnt > 0u ? cnt : 1u;
}
DI void xcd_barrier(const XcdBarrier& b) {
    asm volatile("s_waitcnt vmcnt(0)" ::: "memory");
    __syncthreads();
    if (threadIdx.x == 0) {
        unsigned* bar = b.bar;
        __builtin_amdgcn_s_waitcnt(0);
        unsigned nloc = b.st[0], nx = b.st[1];
        if (nloc == 0u) { xcd_barrier_complete(bar, b.x, nloc, nx); b.st[0] = nloc; b.st[1] = nx; }
        const unsigned old = xb_add(&bar[XB_XSUB(b.x)], 1u);
        const unsigned gen = old / nloc;
        if (old + 1u == (gen + 1u) * nloc) {
            __builtin_amdgcn_fence(__ATOMIC_RELEASE, "agent");
            asm volatile("s_waitcnt vmcnt(0)" ::: "memory");
            const unsigned og = xb_add(&bar[XB_TOP], 1u);
            const unsigned tg = og / nx;
            if (og + 1u == (tg + 1u) * nx) xb_add(&bar[XB_TOPGEN], 1u);
            else XB_SPIN(xb_ld(&bar[XB_TOPGEN]) == tg, bar);
            __builtin_amdgcn_fence(__ATOMIC_ACQUIRE, "agent");
            xb_add(&bar[XB_XGEN(b.x)], 1u);
            asm volatile("s_waitcnt vmcnt(0)" ::: "memory");
        } else {
            XB_SPIN(xb_ld(&bar[XB_XGEN(b.x)]) == gen, bar);
            __builtin_amdgcn_fence(__ATOMIC_ACQUIRE, "agent");
            asm volatile("s_waitcnt vmcnt(0)" ::: "memory");
        }
    }
    __syncthreads();
}

namespace pg8 {
constexpr int BM = 256, BK = 64, HALF = 128, HTB = HALF * BK * 2, STAGE_BYTES = 8 * HTB, NXCD = 8;
#ifndef WGM_FULL
#define WGM_FULL 8
#endif
#ifndef WGM_INPROJ
#define WGM_INPROJ 8
#endif
#ifndef WGM_SPLIT
#define WGM_SPLIT 4
#endif
DI int lds_byte(int r, int c) { const int st = (r >> 4) * 2 + (c >> 5), rr = r & 15, cc = c & 31, ob = rr * 64 + cc * 2; return st * 1024 + (ob ^ (((ob >> 9) & 1) << 5)); }
DI void stage_rc(int b, int& R, int& C) { const int st = b / 1024, sb = b % 1024, swz = sb ^ (((sb >> 9) & 1) << 5); R = (st >> 1) * 16 + swz / 64; C = (st & 1) * 32 + (swz % 64) / 2; }
DI int perm32(int rho) { const int n = rho >> 4, i = rho & 15; return 8 * (i >> 2) + 4 * n + (i & 3); }
struct Unit { int pm, pn, ks, nt; const char* a; const char* b; };
struct Geo { const bf16_t* A; const bf16_t* Bt; int lda, ldb; };
template <int WGM> DI void xcd_tile(int L, int nM, int nN, int& pm, int& pn) {
    const int nwg = nM * nN; int wgid = L; { const int q = nwg / NXCD, r = nwg % NXCD, xcd = wgid % NXCD, off = wgid / NXCD; wgid = (xcd < r ? xcd * (q + 1) : r * (q + 1) + (xcd - r) * q) + off; }
    const int nig = WGM * nN, gid = wgid / nig, fm = gid * WGM, gsz = (nM - fm) < WGM ? (nM - fm) : WGM;
    pm = fm + ((wgid % nig) % gsz); pn = (wgid % nig) / gsz;
}
struct FullOrder {
    Geo g; int nM, nN, G, c, nt;
    DI bool next(int i, Unit& u) const {
        const long L = (long)i * G + c; if (L >= (long)nM * nN) return false;
        xcd_tile<WGM_FULL>((int)L, nM, nN, u.pm, u.pn); u.ks = -1; u.nt = nt;
        u.a = (const char*)g.A + (size_t)u.pm * BM * g.lda * 2; u.b = (const char*)g.Bt + (size_t)u.pn * BM * g.ldb * 2; return true;
    }
};
struct InprojOrder {
    Geo g; int G, c;
    DI bool next(int i, Unit& u) const {
        const long L = (long)i * G + c;
        if (L < 3584) {
            if (L < 3550) xcd_tile<WGM_INPROJ>((int)L, 71, 50, u.pm, u.pn); else { const int idx = (int)L - 3550; u.pm = 71; u.pn = idx < 26 ? idx : idx + 16; }
            u.ks = -1; u.nt = DM / BK; u.a = (const char*)g.A + (size_t)u.pm * BM * g.lda * 2; u.b = (const char*)g.Bt + (size_t)u.pn * BM * g.ldb * 2; return true; }
        const long j = L - 3584; if (j >= 128) return false;
        u.pm = 71; u.pn = 26 + ((int)j & 15); u.ks = (int)(j >> 4); u.nt = 4;
        u.a = (const char*)g.A + ((size_t)u.pm * BM * g.lda + (size_t)u.ks * 256) * 2; u.b = (const char*)g.Bt + ((size_t)u.pn * BM * g.ldb + (size_t)u.ks * 256) * 2; return true;
    }
};
struct SplitOrder {
    Geo g; int G, c, ntFull, S, ntSplit;
    DI bool next(int i, Unit& u) const {
        const long L = (long)i * G + c;
        if (L < 512) { xcd_tile<WGM_SPLIT>((int)L, 64, 8, u.pm, u.pn); u.ks = -1; u.nt = ntFull;
            u.a = (const char*)g.A + (size_t)u.pm * BM * g.lda * 2; u.b = (const char*)g.Bt + (size_t)u.pn * BM * g.ldb * 2; return true; }
        const long j = L - 512; if (j >= 64 * S) return false;
        const int xq = (int)j & 7, sq = (int)j >> 3, combo = xq * S + (sq >> 3); u.pn = sq & 7; u.pm = 64 + (combo & 7); u.ks = combo >> 3; u.nt = ntSplit;
        u.a = (const char*)g.A + ((size_t)u.pm * BM * g.lda + (size_t)u.ks * ntSplit * BK) * 2; u.b = (const char*)g.Bt + ((size_t)u.pn * BM * g.ldb + (size_t)u.ks * ntSplit * BK) * 2; return true;
    }
};
template <class Epi, class Sched>
DI void gemm_phase(LAS unsigned char* lds, const Sched& S, const Epi& E) {
    const int tid = launder_tid(), wid = __builtin_amdgcn_readfirstlane(tid >> 6), lane = tid & 63, wr = wid >> 2, wc = wid & 3, fr = lane & 15, fq = lane >> 4;
    const int lda = S.g.lda, ldb = S.g.ldb;
    unsigned voffA[2], voffB[2];
#pragma unroll
    for (int i = 0; i < 2; ++i) { int R, C; stage_rc(tid * 16 + i * 8192, R, C); const int Rb = (R & ~31) + perm32(R & 31);
        voffA[i] = (unsigned)(R * lda + C) * 2u; voffB[i] = (unsigned)(Rb * ldb + C) * 2u; }
    const size_t kstep = (size_t)(BK * 2);
    const size_t hstepA = (size_t)HALF * lda * 2, hstepB = (size_t)HALF * ldb * 2;
    const unsigned ldsw = (unsigned)wid * 1024u;
    const int aoff = lds_byte(wr * 64 + fr, fq * 8), boff = lds_byte(wc * 32 + fr, fq * 8);
#define PG8_SA(b, h) (((b) * 2 + (h)) * HTB)
#define PG8_SB(b, h) ((4 + (b) * 2 + (h)) * HTB)
#define PG8_STAGE(bufoff, gbase, voff) do { _Pragma("unroll") for (int _i = 0; _i < 2; ++_i) \
        __builtin_amdgcn_global_load_lds((const unsigned*)((const char*)(gbase) + (voff)[_i]), (LAS unsigned*)(lds + (bufoff) + ldsw + _i * 8192), 16, 0, 0); } while (0)
#define PG8_LDA(dst, b, h) do { _Pragma("unroll") for (int m = 0; m < 4; ++m) _Pragma("unroll") for (int k = 0; k < 2; ++k) dst[m][k] = *(const LAS bf16x8*)(lds + PG8_SA(b, h) + aoff + m * 2048 + k * 1024); } while (0)
#define PG8_LDB(dst, b, h) do { _Pragma("unroll") for (int n = 0; n < 2; ++n) _Pragma("unroll") for (int k = 0; k < 2; ++k) dst[n][k] = *(const LAS bf16x8*)(lds + PG8_SB(b, h) + boff + n * 2048 + k * 1024); } while (0)
#define PG8_MMA(ai, bj, At, Bt) do { __builtin_amdgcn_s_setprio(1); _Pragma("unroll") for (int m = 0; m < 4; ++m) _Pragma("unroll") for (int n = 0; n < 2; ++n) _Pragma("unroll") for (int k = 0; k < 2; ++k) \
        acc[ai][bj][m][n] = __builtin_amdgcn_mfma_f32_16x16x32_bf16(Bt[n][k], At[m][k], acc[ai][bj][m][n], 0, 0, 0); __builtin_amdgcn_s_setprio(0); } while (0)
#define PG8_WAIT_V(n) asm volatile("s_waitcnt vmcnt(" #n ")" ::: "memory")
#define PG8_WAIT_L(n) asm volatile("s_waitcnt lgkmcnt(" #n ")" ::: "memory")
#define PG8_BAR __builtin_amdgcn_s_barrier()
#define PG8_SCHED __builtin_amdgcn_sched_barrier(0)
    Unit cur, nxt; int ui = 0;
    if (!S.next(0, cur)) return;
    f32x4 acc[2][2][4][2];
#pragma unroll
    for (int a = 0; a < 2; ++a)
#pragma unroll
        for (int b = 0; b < 2; ++b)
#pragma unroll
            for (int m = 0; m < 4; ++m)
#pragma unroll
                for (int n = 0; n < 2; ++n) acc[a][b][m][n] = (f32x4){0.f, 0.f, 0.f, 0.f};
    bf16x8 At[4][2], B0[2][2], B1[2][2];
    const char* cA = cur.a; const char* cB = cur.b;
#define PG8_RSDMA(unit_, par_) do { if constexpr (Epi::RSLDS) { if (wid < 4) __builtin_amdgcn_global_load_lds((const unsigned*)(E.rs + (unit_).pm * BM + wid * 64 + lane), \
        (LAS unsigned*)(lds + LDS_TBL + (par_) * 1024 + wid * 256), 4, 0, 0); } } while (0)
    PG8_RSDMA(cur, 0);
    PG8_STAGE(PG8_SB(0, 0), cB, voffB); PG8_STAGE(PG8_SB(0, 1), cB + hstepB, voffB); PG8_STAGE(PG8_SA(0, 0), cA, voffA); PG8_STAGE(PG8_SA(0, 1), cA + hstepA, voffA);
    if (wr == 1) PG8_BAR;
    PG8_WAIT_V(2); PG8_BAR;
    PG8_STAGE(PG8_SB(1, 0), cB + kstep, voffB); PG8_STAGE(PG8_SA(1, 0), cA + kstep, voffA); PG8_STAGE(PG8_SB(1, 1), cB + hstepB + kstep, voffB);
    PG8_WAIT_V(6); PG8_BAR;
    for (;;) {
        const bool has_next = S.next(ui + 1, nxt);
        const char* nA = has_next ? nxt.a : cA; const char* nB = has_next ? nxt.b : cB;
        const int nt = cur.nt;
        for (int t = 0; t < nt; t += 2) {
            const bool last = (t == nt - 2);
            const char* a1 = cA + (size_t)(t + 1) * kstep;
            const char* a2 = last ? nA : cA + (size_t)(t + 2) * kstep; const char* b2 = last ? nB : cB + (size_t)(t + 2) * kstep;
            const char* a3 = a2 + kstep; const char* b3 = b2 + kstep;
            if constexpr (Epi::HOOK) { if (cur.ks < 0 && (t == 16 || t == 32)) E.hook(acc, cur, t >> 4, wr, wc, fr, fq); }
            PG8_LDB(B0, 0, 0); PG8_LDB(B1, 0, 1); PG8_SCHED; PG8_LDA(At, 0, 0); PG8_STAGE(PG8_SA(1, 1), a1 + hstepA, voffA);
            PG8_WAIT_V(8); PG8_WAIT_L(0); PG8_BAR; PG8_MMA(0, 0, At, B0); PG8_MMA(0, 1, At, B1); PG8_BAR; PG8_SCHED;
            PG8_LDA(At, 0, 1); PG8_STAGE(PG8_SB(0, 0), b2, voffB); PG8_STAGE(PG8_SB(0, 1), b2 + hstepB, voffB); PG8_STAGE(PG8_SA(0, 0), a2, voffA);
            PG8_WAIT_V(8); PG8_WAIT_L(0); PG8_BAR; PG8_MMA(1, 0, At, B0); PG8_MMA(1, 1, At, B1); PG8_BAR; PG8_SCHED;
            PG8_LDB(B0, 1, 0); PG8_LDB(B1, 1, 1); PG8_SCHED; PG8_LDA(At, 1, 0); PG8_STAGE(PG8_SA(0, 1), a2 + hstepA, voffA);
            PG8_WAIT_V(8); PG8_WAIT_L(0); PG8_BAR; PG8_MMA(0, 0, At, B0); PG8_MMA(0, 1, At, B1); PG8_BAR; PG8_SCHED;
            PG8_LDA(At, 1, 1); PG8_STAGE(PG8_SB(1, 0), b3, voffB); PG8_STAGE(PG8_SB(1, 1), b3 + hstepB, voffB); PG8_STAGE(PG8_SA(1, 0), a3, voffA);
            PG8_WAIT_V(8); PG8_WAIT_L(0); PG8_BAR; PG8_MMA(1, 0, At, B0); PG8_MMA(1, 1, At, B1); PG8_BAR; PG8_SCHED;
        }
        if (wr == 0) PG8_BAR;
        E(acc, cur, wr, wc, fr, fq, (const LAS float*)(lds + LDS_TBL + (ui & 1) * 1024));
        if (!has_next) break;
#pragma unroll
        for (int a = 0; a < 2; ++a)
#pragma unroll
            for (int b = 0; b < 2; ++b)
#pragma unroll
                for (int m = 0; m < 4; ++m)
#pragma unroll
                    for (int n = 0; n < 2; ++n) acc[a][b][m][n] = (f32x4){0.f, 0.f, 0.f, 0.f};
        cur = nxt; cA = nA; cB = nB; ++ui;
        PG8_RSDMA(cur, ui & 1);
        if (wr == 1) PG8_BAR;
    }
    PG8_WAIT_V(0);
    PG8_BAR;
#undef PG8_RSDMA
#undef PG8_SA
#undef PG8_SB
#undef PG8_STAGE
#undef PG8_LDA
#undef PG8_LDB
#undef PG8_MMA
#undef PG8_WAIT_V
#undef PG8_WAIT_L
#undef PG8_BAR
#undef PG8_SCHED
}

DI unsigned q8(float s) { const float t = fminf(fmaxf(s * 255.0f + 0.5f, 1.0f), 255.0f); return (unsigned)(int)t; }
DI unsigned pk4q8(const f32x4 v) {
    unsigned w = 0u;
    w = __builtin_amdgcn_cvt_pk_u8_f32(fmaxf(__builtin_rintf(v[0] * 255.0f), 1.0f), 0, w); w = __builtin_amdgcn_cvt_pk_u8_f32(fmaxf(__builtin_rintf(v[1] * 255.0f), 1.0f), 1, w);
    w = __builtin_amdgcn_cvt_pk_u8_f32(fmaxf(__builtin_rintf(v[2] * 255.0f), 1.0f), 2, w); w = __builtin_amdgcn_cvt_pk_u8_f32(fmaxf(__builtin_rintf(v[3] * 255.0f), 1.0f), 3, w);
    return w;
}
DI u32x2 packq8(const f32x4 v0, const f32x4 v1) { u32x2 w; w.x = pk4q8(v0); w.y = pk4q8(v1); return w; }
DI void unpackq8(const u32x2 w, f32x4& v0, f32x4& v1) {
    v0 = (f32x4){(float)(w.x & 0xffu), (float)((w.x >> 8) & 0xffu), (float)((w.x >> 16) & 0xffu), (float)(w.x >> 24)};
    v1 = (f32x4){(float)(w.y & 0xffu), (float)((w.y >> 8) & 0xffu), (float)((w.y >> 16) & 0xffu), (float)(w.y >> 24)}; }
DI u32x4 pack8(const f32x4 v0, const f32x4 v1) { u32x4 w; w.x = pk2(v0[0], v0[1]); w.y = pk2(v0[2], v0[3]); w.z = pk2(v1[0], v1[1]); w.w = pk2(v1[2], v1[3]); return w; }
DI void unpack8(const u32x4 w, f32x4& v0, f32x4& v1) { v0 = (f32x4){bflo(w.x), bfhi(w.x), bflo(w.y), bfhi(w.y)}; v1 = (f32x4){bflo(w.z), bfhi(w.z), bflo(w.w), bfhi(w.w)}; }
struct EpiInproj {
    static constexpr bool HOOK = false, RSLDS = true;
    bf16_t* Z; const float* rs; float* part; unsigned char* GT;
    DI void operator()(const f32x4 (&acc)[2][2][4][2], const Unit& u, int wr, int wc, int fr, int fq, const LAS float* rsl) const {
        const int row0 = u.pm * BM + wr * 64 + fr, col0 = u.pn * BM + wc * 32 + 8 * fq;
        const bool gate = u.pn >= C_G / BM;
#pragma unroll
        for (int ai = 0; ai < 2; ++ai)
#pragma unroll
            for (int m = 0; m < 4; ++m) {
                const int row = row0 + ai * HALF + m * 16;
                if (u.ks < 0) {
                    const float s = rsl[wr * 64 + fr + ai * HALF + m * 16];
                    bf16_t* rowp = Z + (size_t)row * ZLD + col0;
                    unsigned char* gq = GT + ((size_t)u.pm * 24 + (u.pn - 26)) * 65536 + (((((wr * 4 + wc) * 2 + ai) * 4 + m) * 64 + fq * 16 + fr) << 4);
                    u32x4 gw;
#pragma unroll
                    for (int bj = 0; bj < 2; ++bj) {
                        f32x4 v0 = acc[ai][bj][m][0] * s, v1 = acc[ai][bj][m][1] * s;
                        if (gate) {
#pragma unroll
                            for (int j = 0; j < 4; ++j) { v0[j] = __builtin_amdgcn_rcpf(1.0f + __expf(-v0[j])); v1[j] = __builtin_amdgcn_rcpf(1.0f + __expf(-v1[j])); }
                            const u32x2 w8 = packq8(v0, v1); if (bj == 0) { gw.x = w8.x; gw.y = w8.y; } else { gw.z = w8.x; gw.w = w8.y; }
                        } else *(u32x4*)(rowp + bj * HALF) = pack8(v0, v1);
                    }
                    if (gate) *(u32x4*)gq = gw;
                } else {
                    float* pp = part + (((size_t)u.ks * 16 + (u.pn - 26)) * 256 + (row - 71 * BM)) * 256 + wc * 32 + 8 * fq;
#pragma unroll
                    for (int bj = 0; bj < 2; ++bj) { *(f32x4*)(pp + bj * HALF) = acc[ai][bj][m][0]; *(f32x4*)(pp + bj * HALF + 4) = acc[ai][bj][m][1]; }
                }
            }
    }
};
struct EpiUp {
    static constexpr bool HOOK = false, RSLDS = true;
    bf16_t* H; const float* rs;
    DI void operator()(const f32x4 (&acc)[2][2][4][2], const Unit& u, int wr, int wc, int fr, int fq, const LAS float* rsl) const {
        const int row0 = u.pm * BM + wr * 64 + fr, col0 = u.pn * BM + wc * 32 + 8 * fq;
#pragma unroll
        for (int ai = 0; ai < 2; ++ai)
#pragma unroll
            for (int m = 0; m < 4; ++m) {
                const int row = row0 + ai * HALF + m * 16; const float s = rsl[wr * 64 + fr + ai * HALF + m * 16];
                bf16_t* rowp = H + (size_t)row * DFF + col0;
#pragma unroll
                for (int bj = 0; bj < 2; ++bj) {
                    f32x4 v0 = acc[ai][bj][m][0] * s, v1 = acc[ai][bj][m][1] * s;
#pragma unroll
                    for (int j = 0; j < 4; ++j) { v0[j] = fmaxf(v0[j], 0.f); v0[j] *= v0[j]; v1[j] = fmaxf(v1[j], 0.f); v1[j] *= v1[j]; }
                    *(u32x4*)(rowp + bj * HALF) = pack8(v0, v1);
                }
            }
    }
};
struct EpiD {
    static constexpr bool HOOK = true, RSLDS = false;
    const unsigned char* Z; bf16_t* act; float* part;
    DI void hook(f32x4 (&acc)[2][2][4][2], const Unit& u, int r, int wr, int wc, int fr_, int fq_) const {
        int fr = fr_, fq = fq_; asm volatile("" : "+v"(fr), "+v"(fq));
        const int row0 = u.pm * BM + wr * 64 + fr, col0 = u.pn * BM + wc * 32 + 8 * fq;
#pragma unroll
        for (int ai = 0; ai < 2; ++ai) {
#pragma unroll
            for (int m = 0; m < 4; ++m) {
                const unsigned char* gp = Z + ((size_t)u.pm * 24 + (r - 1) * 8 + u.pn) * 65536 + (((((wr * 4 + wc) * 2 + ai) * 4 + m) * 64 + fq * 16 + fr) << 4);
                const u32x4 gn = *(const u32x4*)gp, gd = *(const u32x4*)(gp + 8 * 65536);
#pragma unroll
                for (int bj = 0; bj < 2; ++bj) {
                    f32x4 n0, n1, d0, d1; unpackq8(bj ? (u32x2){gn.z, gn.w} : (u32x2){gn.x, gn.y}, n0, n1); unpackq8(bj ? (u32x2){gd.z, gd.w} : (u32x2){gd.x, gd.y}, d0, d1);
#pragma unroll
                    for (int j = 0; j < 4; ++j) { acc[ai][bj][m][0][j] *= n0[j] * __builtin_amdgcn_rcpf(d0[j]); acc[ai][bj][m][1][j] *= n1[j] * __builtin_amdgcn_rcpf(d1[j]); }
                }
            }
            asm volatile("" : "+v"(acc[ai][0][0][0]), "+v"(acc[ai][0][1][0]), "+v"(acc[ai][0][2][0]), "+v"(acc[ai][0][3][0]), "+v"(acc[ai][1][0][0]), "+v"(acc[ai][1][1][0]), "+v"(acc[ai][1][2][0]), "+v"(acc[ai][1][3][0]));
        }
    }
    DI void operator()(const f32x4 (&acc)[2][2][4][2], const Unit& u, int wr, int wc, int fr, int fq, const LAS float* rsl) const {
        const int row0 = u.pm * BM + wr * 64 + fr, col0 = u.pn * BM + wc * 32 + 8 * fq;
        const int r = u.ks < 0 ? 2 : u.ks;
#pragma unroll
        for (int ai = 0; ai < 2; ++ai)
#pragma unroll
            for (int m = 0; m < 4; ++m) {
                const int row = row0 + ai * HALF + m * 16;
                const u32x4 gs = *(const u32x4*)(Z + ((size_t)u.pm * 24 + r * 8 + u.pn) * 65536 + (((((wr * 4 + wc) * 2 + ai) * 4 + m) * 64 + fq * 16 + fr) << 4));
#pragma unroll
                for (int bj = 0; bj < 2; ++bj) {
                    f32x4 s0, s1; unpackq8(bj ? (u32x2){gs.z, gs.w} : (u32x2){gs.x, gs.y}, s0, s1);
                    const f32x4 v0 = acc[ai][bj][m][0] * (s0 * (1.0f / 255.0f)), v1 = acc[ai][bj][m][1] * (s1 * (1.0f / 255.0f));
                    if (u.ks < 0) *(u32x4*)(act + (size_t)row * DM + col0 + bj * HALF) = pack8(v0, v1);
                    else { float* pp = part + ((size_t)u.ks * MS + (row - MP)) * DM + col0 + bj * HALF; *(f32x4*)pp = v0; *(f32x4*)(pp + 4) = v1; }
                }
            }
    }
};
template <bool XF32> struct EpiRes {
    static constexpr bool HOOK = false, RSLDS = false;
    const float* Xin; bf16_t* act; float* ssq; float* part;
    DI void operator()(const f32x4 (&acc)[2][2][4][2], const Unit& u, int wr, int wc, int fr, int fq, const LAS float* rsl) const {
        const int row0 = u.pm * BM + wr * 64 + fr, col0 = u.pn * BM + wc * 32 + 8 * fq;
        u32x4 xin[2][4][2];
        if (!XF32 && u.ks < 0) {
#pragma unroll
            for (int ai = 0; ai < 2; ++ai)
#pragma unroll
                for (int m = 0; m < 4; ++m)
#pragma unroll
                    for (int bj = 0; bj < 2; ++bj) xin[ai][m][bj] = *(const u32x4*)(act + (size_t)(row0 + ai * HALF + m * 16) * DM + col0 + bj * HALF);
        }
#pragma unroll
        for (int ai = 0; ai < 2; ++ai)
#pragma unroll
            for (int m = 0; m < 4; ++m) {
                const int row = row0 + ai * HALF + m * 16;
                if (u.ks < 0) {
                    const size_t off = (size_t)row * DM + col0; float sq = 0.f;
#pragma unroll
                    for (int bj = 0; bj < 2; ++bj) {
                        f32x4 x0, x1;
                        if (XF32) { x0 = *(const f32x4*)(Xin + off + bj * HALF); x1 = *(const f32x4*)(Xin + off + bj * HALF + 4); }
                        else unpack8(xin[ai][m][bj], x0, x1);
                        x0 += acc[ai][bj][m][0]; x1 += acc[ai][bj][m][1];
                        *(u32x4*)(act + off + bj * HALF) = pack8(x0, x1);
                        sq += (x0[0] * x0[0] + x0[1] * x0[1]) + (x0[2] * x0[2] + x0[3] * x0[3]) + (x1[0] * x1[0] + x1[1] * x1[1]) + (x1[2] * x1[2] + x1[3] * x1[3]);
                    }
                    sq += __shfl_xor(sq, 16); sq += __shfl_xor(sq, 32);
                    if (fq == 0) ssq[(size_t)row * 32 + u.pn * 4 + wc] = sq;
                } else {
#pragma unroll
                    for (int bj = 0; bj < 2; ++bj) { float* pp = part + ((size_t)u.ks * MS + (row - MP)) * DM + col0 + bj * HALF; *(f32x4*)pp = acc[ai][bj][m][0]; *(f32x4*)(pp + 4) = acc[ai][bj][m][1]; }
                }
            }
    }
};
}

DI void tr_item(const float* src, size_t sld, bf16_t* dst, size_t dld, const float* ksc, LAS unsigned* scr, int lane) {
    const int ng = lane & 15, kq = lane >> 4;
#pragma unroll
    for (int i = 0; i < 8; ++i) {
        const int k = 8 * i + 2 * kq;
        f32x4 a = *(const f32x4*)(src + (size_t)k * sld + 4 * ng);
        f32x4 b = *(const f32x4*)(src + (size_t)(k + 1) * sld + 4 * ng);
        if (ksc) { a *= ksc[k]; b *= ksc[k + 1]; }
        LAS unsigned* d = scr + (4 * ng) * 33 + 4 * i + kq;
        d[0] = pk2(a[0], b[0]); d[33] = pk2(a[1], b[1]); d[66] = pk2(a[2], b[2]); d[99] = pk2(a[3], b[3]);
    }
    asm volatile("s_waitcnt lgkmcnt(0)" ::: "memory");
#pragma unroll
    for (int j = 0; j < 8; ++j) {
        const int n = (lane >> 3) + 8 * j, c = lane & 7;
        const LAS unsigned* s = scr + n * 33 + 4 * c;
        u32x4 o; o.x = s[0]; o.y = s[1]; o.z = s[2]; o.w = s[3];
        *(u32x4*)(dst + (size_t)n * dld + 8 * c) = o;
    }
    asm volatile("s_waitcnt lgkmcnt(0)" ::: "memory");
}

struct Ctx {
    LAS unsigned char* lds;
    int tid, lane, wave, bid, G;
};
DI Ctx make_ctx(LAS unsigned char* lds) { Ctx c; c.lds = lds; c.tid = launder_tid(); c.lane = c.tid & 63; c.wave = __builtin_amdgcn_readfirstlane(c.tid >> 6); c.bid = blockIdx.x; c.G = gridDim.x; return c; }

DI void conv_matrix_item(const float* W, int K, int N, bf16_t* Wt, const float* ksc, int item, LAS unsigned* scr, int lane) {
    const int nb = N >> 6, kb = item / nb, nn = item - kb * nb;
    tr_item(W + (size_t)kb * 64 * N + nn * 64, (size_t)N, Wt + (size_t)nn * 64 * K + kb * 64, (size_t)K, ksc ? ksc + kb * 64 : nullptr, scr, lane);
}
DI void phase_prologue(const Ctx& c) {
    LAS unsigned* scr = (LAS unsigned*)(c.lds + c.wave * 16384);
    const int gw = c.bid * NWAVES + c.wave, NGW = c.G * NWAVES;
    constexpr int I_IN = 32 * 200, I_BR = 16 * 32, I_OUT = 32 * 32, I_UP = 32 * 128, I_DN = 128 * 32, I_LRU = 4, I_L = I_IN + 3 * I_BR + I_OUT + I_UP + I_DN + 16 * I_LRU;
    bf16_t* Wall = (bf16_t*)(kws() + WS_W); bf16_t* lruw = (bf16_t*)(kws() + WS_LRUW);
    for (int it = gw; it < DEPTH * I_L; it += NGW) {
        const int l = it / I_L; int r = it - l * I_L;
        bf16_t* Wl = Wall + (size_t)l * WL_SIZE;
        if (r < I_IN) { conv_matrix_item(kin<9>() + (size_t)l * DM * DIN, DM, DIN, Wl + WL_IN, kin<8>() + l * DM, r, scr, c.lane); continue; } r -= I_IN;
        if (r < 3 * I_BR) { const int b = r / I_BR, it2 = r - b * I_BR, kb = it2 / (DM / 64), nn = it2 - kb * (DM / 64);
            tr_item(kin<19>() + ((size_t)l * 3 + b) * BW * DM + (size_t)kb * 64 * DM + nn * 64, (size_t)DM, Wl + WL_BR + (size_t)nn * 64 * (3 * BW) + b * BW + kb * 64, (size_t)(3 * BW), nullptr, scr, c.lane); continue; } r -= 3 * I_BR;
        if (r < I_OUT) { conv_matrix_item(kin<20>() + (size_t)l * DM * DM, DM, DM, Wl + WL_OUT, nullptr, r, scr, c.lane); continue; } r -= I_OUT;
        if (r < I_UP) { conv_matrix_item(kin<22>() + (size_t)l * DM * DFF, DM, DFF, Wl + WL_UP, kin<21>() + l * DM, r, scr, c.lane); continue; } r -= I_UP;
        if (r < I_DN) { conv_matrix_item(kin<23>() + (size_t)l * DFF * DM, DFF, DM, Wl + WL_DOWN, nullptr, r, scr, c.lane); continue; } r -= I_DN;
        { const int wsel = r / (8 * I_LRU), rr = r - wsel * 8 * I_LRU, blk = rr / I_LRU, sub = rr - blk * I_LRU;
          conv_matrix_item((wsel ? kin<14>() : kin<12>()) + ((size_t)l * 8 + blk) * 16384, 128, 128, lruw + (((size_t)l * 2 + wsel) * 8 + blk) * 16384, nullptr, sub, scr, c.lane); }
    }
}

DI void phase_norm(const Ctx& c, const float* xP, const float* xS) {
    const int gw = c.bid * NWAVES + c.wave, NGW = c.G * NWAVES;
    bf16_t* act = (bf16_t*)(kws() + WS_ACT); float* rs = (float*)(kws() + WS_RS);
    for (int row = gw; row < M; row += NGW) {
        const f32x4* xr = (const f32x4*)((row < MP ? xP : xS) + (size_t)row * DM) + c.lane;
        f32x4 v[8]; float s = 0.f;
#pragma unroll
        for (int j = 0; j < 8; ++j) { v[j] = xr[64 * j]; s += (v[j][0] * v[j][0] + v[j][1] * v[j][1]) + (v[j][2] * v[j][2] + v[j][3] * v[j][3]); }
        s = wave_sum(s);
        if (c.lane == 0) rs[row] = 1.0f / sqrtf(s * (1.0f / DM) + EPS);
        u32x2* o = (u32x2*)(act + (size_t)row * DM) + c.lane;
#pragma unroll
        for (int j = 0; j < 8; ++j) { u32x2 w; w.x = pk2(v[j][0], v[j][1]); w.y = pk2(v[j][2], v[j][3]); o[64 * j] = w; }
    }
}
DI void phase_final(const Ctx& c) {
    const int gw = c.bid * NWAVES + c.wave, NGW = c.G * NWAVES;
    const f32x4* gp = (const f32x4*)kin<24>() + c.lane; const float* rs = (const float*)(kws() + WS_RS); const bf16_t* act = (const bf16_t*)(kws() + WS_ACT);
    f32x4 gv[8];
#pragma unroll
    for (int j = 0; j < 8; ++j) gv[j] = gp[64 * j];
    for (int row = gw; row < M; row += NGW) {
        f32x4* yr = (f32x4*)(kout() + (size_t)row * DM) + c.lane; const u32x2* xr = (const u32x2*)(act + (size_t)row * DM) + c.lane; const float r = rs[row];
#pragma unroll
        for (int j = 0; j < 8; ++j) { const u32x2 w = xr[64 * j]; yr[64 * j] = (f32x4){bflo(w.x), bfhi(w.x), bflo(w.y), bfhi(w.y)} * r * gv[j]; }
    }
}
DI void cvt_f32_bf16(const float* s, bf16_t* d, size_t n8, size_t gt, size_t NT) {
    for (size_t i = gt; i < n8; i += NT) { const f32x4 a = ((const f32x4*)s)[2 * i], b = ((const f32x4*)s)[2 * i + 1]; u32x4 w; w.x = pk2(a[0], a[1]); w.y = pk2(a[2], a[3]); w.z = pk2(b[0], b[1]); w.w = pk2(b[2], b[3]); ((u32x4*)d)[i] = w; }
}
DI void phase_cacheconv(const Ctx& c, int l, int pidx, int pcount) {
    const size_t gt = (size_t)pidx * NTHR + c.tid, NT = (size_t)pcount * NTHR;
    cvt_f32_bf16(kin<4>() + (size_t)l * 32 * 128 * 256, (bf16_t*)(kws() + WS_KCB), (size_t)32 * 128 * 256 / 8, gt, NT);
    cvt_f32_bf16(kin<5>() + (size_t)l * 32 * 128 * 256, (bf16_t*)(kws() + WS_VTCB), (size_t)32 * 128 * 256 / 8, gt, NT);
    cvt_f32_bf16(kin<6>() + (size_t)l * 32 * 512 * 1024, (bf16_t*)(kws() + WS_KCC), (size_t)32 * 512 * 1024 / 8, gt, NT);
    cvt_f32_bf16(kin<7>() + (size_t)l * 32 * 512 * 1024, (bf16_t*)(kws() + WS_VTCC), (size_t)32 * 512 * 1024 / 8, gt, NT);
}

DI void lru_local_phase(const Ctx& c, int l) {
    LAS float* uf = (LAS float*)c.lds;
    LAS unsigned char* ub = c.lds + 33792;
    LAS float* sa = (LAS float*)(c.lds + 33792 + 17408);
    LAS float* sb = sa + 8192;
    LAS float* tot = sb + 8192;
    const bf16_t* Z = (const bf16_t*)(kws() + WS_Z);
    const int nunits = NCHUNK * 8;
    int u = c.bid; if (u >= nunits) return;
    const int cg = c.tid & 15, tk = c.tid >> 4;
    const int fr = c.lane & 15, fq = c.lane >> 4, w = c.wave;
    const int chl = c.tid & 127, q = c.tid >> 7;
    int nblk_cur = -1;
    LAS float* cwl = tot + 1024;
    bf16x8 bwa[4], bwx[4]; float ba = 0.f, bx = 0.f, c8 = 0.f;
    u32x4 pre[2][4];
#define LRU_PREFETCH(uu) do { const int chunk_ = (uu) >> 3, nb_ = (uu) & 7; const bool smp_ = chunk_ >= 256, first_ = !smp_ && (chunk_ & 127) == 0; \
        _Pragma("unroll") for (int hh = 0; hh < 2; ++hh) _Pragma("unroll") for (int k = 0; k < 4; ++k) { const int ts = tk + 32 * hh - 3 + k; \
            if (ts >= 0 || (!smp_ && !first_)) pre[hh][k] = *(const u32x4*)(Z + (size_t)(chunk_ * 64 + ts) * ZLD + C_AX + nb_ * 128 + 8 * cg); } } while (0)
    LRU_PREFETCH(u);
    for (; u < nunits; u += c.G) {
        const int chunk = u >> 3, nblk = u & 7;
        const int row0 = chunk * 64, ch0 = nblk * 128; const bool smp = chunk >= 256; const bool first = !smp && (chunk & 127) == 0; const int bs = chunk - 256;
        if (nblk != nblk_cur) {
            nblk_cur = nblk;
            __syncthreads();
            for (int i = c.tid; i < 640; i += NTHR) { const int k = i >> 7, cc = i & 127; cwl[i] = k < 4 ? kin<10>()[(size_t)l * 4 * 1024 + k * 1024 + ch0 + cc] : kin<11>()[(size_t)l * 1024 + ch0 + cc]; }
            __syncthreads();
            const bf16_t* wat = (const bf16_t*)(kws() + WS_LRUW) + (((size_t)l * 2 + 0) * 8 + nblk) * 16384 + (size_t)(16 * w + fr) * 128 + 8 * fq;
            const bf16_t* wxt = wat + (size_t)8 * 16384;
#pragma unroll
            for (int ks = 0; ks < 4; ++ks) { bwa[ks] = *(const bf16x8*)(wat + 32 * ks); bwx[ks] = *(const bf16x8*)(wxt + 32 * ks); }
            const int ch = ch0 + 16 * w + fr;
            ba = kin<13>()[(size_t)l * 1024 + ch]; bx = kin<15>()[(size_t)l * 1024 + ch]; c8 = 8.0f * log1pf(expf(-kin<16>()[(size_t)l * 1024 + ch]));
        }
#pragma unroll
        for (int hh = 0; hh < 2; ++hh) {
            const int tt = tk + 32 * hh;
            f32x4 a0 = *(const LAS f32x4*)(cwl + 512 + 8 * cg), a1 = *(const LAS f32x4*)(cwl + 512 + 8 * cg + 4);
#pragma unroll
            for (int k = 0; k < 4; ++k) {
                const int ts = tt - 3 + k;
                f32x4 x0, x1;
                if (ts >= 0 || (!smp && !first)) { const u32x4 v = pre[hh][k];
                    x0 = (f32x4){bflo(v.x), bfhi(v.x), bflo(v.y), bfhi(v.y)}; x1 = (f32x4){bflo(v.z), bfhi(v.z), bflo(v.w), bfhi(v.w)};
                } else if (smp) {
                    const float* sp = kin<2>() + (((size_t)l * 32 + bs) * 3 + (3 + ts)) * 1024 + ch0 + 8 * cg;
                    x0 = *(const f32x4*)sp; x1 = *(const f32x4*)(sp + 4);
                } else { x0 = (f32x4){0.f, 0.f, 0.f, 0.f}; x1 = x0; }
                a0 += *(const LAS f32x4*)(cwl + k * 128 + 8 * cg) * x0; a1 += *(const LAS f32x4*)(cwl + k * 128 + 8 * cg + 4) * x1;
            }
            *(LAS f32x4*)(uf + tt * 132 + 8 * cg) = a0; *(LAS f32x4*)(uf + tt * 132 + 8 * cg + 4) = a1;
            u32x4 pw; pw.x = pk2(a0[0], a0[1]); pw.y = pk2(a0[2], a0[3]); pw.z = pk2(a1[0], a1[1]); pw.w = pk2(a1[2], a1[3]);
            *(LAS u32x4*)(ub + tt * 272 + 16 * cg) = pw;
        }
        if (u + c.G < nunits) LRU_PREFETCH(u + c.G);
        __syncthreads();
        {
            f32x4 ar[4], ai[4];
#pragma unroll
            for (int mt = 0; mt < 4; ++mt) { ar[mt] = (f32x4){0.f, 0.f, 0.f, 0.f}; ai[mt] = ar[mt]; }
#pragma unroll
            for (int ks = 0; ks < 4; ++ks)
#pragma unroll
                for (int mt = 0; mt < 4; ++mt) {
                    const bf16x8 af = *(const LAS bf16x8*)(ub + (mt * 16 + fr) * 272 + (ks * 32 + fq * 8) * 2);
                    ar[mt] = __builtin_amdgcn_mfma_f32_16x16x32_bf16(af, bwa[ks], ar[mt], 0, 0, 0);
                    ai[mt] = __builtin_amdgcn_mfma_f32_16x16x32_bf16(af, bwx[ks], ai[mt], 0, 0, 0);
                }
            const int chw = 16 * w + fr;
#pragma unroll
            for (int mt = 0; mt < 4; ++mt)
#pragma unroll
                for (int j = 0; j < 4; ++j) {
                    const int tok = mt * 16 + fq * 4 + j;
                    const float r = __builtin_amdgcn_rcpf(1.0f + __expf(-(ar[mt][j] + ba))), ig = __builtin_amdgcn_rcpf(1.0f + __expf(-(ai[mt][j] + bx)));
                    const float la = -c8 * r, a = __expf(la), x2 = 2.0f * la;
                    const float omt = -x2 * (1.0f + x2 * (0.5f + x2 * (0.16666667f + x2 * (0.041666668f + x2 * (0.0083333338f + x2 * 0.0013888889f)))));
                    const float om = x2 > -0.25f ? omt : 1.0f - a * a;
                    const float bb = __builtin_amdgcn_sqrtf(om) * (ig * uf[tok * 132 + chw]);
                    sa[tok * 128 + chw] = a; sb[tok * 128 + chw] = bb;
                }
        }
        __syncthreads();
        {
            float h = (smp && q == 0) ? kin<3>()[((size_t)l * 32 + bs) * 1024 + ch0 + chl] : 0.f, A = 1.f;
#pragma unroll 4
            for (int t = 16 * q; t < 16 * q + 16; ++t) { const float a = sa[t * 128 + chl], b = sb[t * 128 + chl]; h = a * h + b; A *= a; sb[t * 128 + chl] = h; sa[t * 128 + chl] = A; }
            tot[(q * 128 + chl) * 2] = A; tot[(q * 128 + chl) * 2 + 1] = h;
        }
        __syncthreads();
        {
            float cin = 0.f, Apre = 1.f;
            for (int qq = 0; qq < q; ++qq) { const float A = tot[(qq * 128 + chl) * 2], h = tot[(qq * 128 + chl) * 2 + 1]; cin = A * cin + h; Apre *= A; }
            unsigned* hc = (unsigned*)(kws() + WS_R1) + (size_t)row0 * 1024 + ch0 + chl;
            float h = 0.f, A = 1.f;
#pragma unroll 4
            for (int t = 16 * q; t < 16 * q + 16; ++t) { h = sb[t * 128 + chl] + sa[t * 128 + chl] * cin; A = sa[t * 128 + chl] * Apre; hc[(size_t)t * 1024] = pk2(h, A); }
            if (q == 3) { f32x2 ag = {A, h}; *(f32x2*)((float*)(kws() + WS_AGG) + ((size_t)chunk * 1024 + ch0 + chl) * 2) = ag; }
        }
        __syncthreads();
    }
#undef LRU_PREFETCH
}

DI void lru_fix_unit(const Ctx& c, int l, int chunk, int half) {
    const int cg4 = c.tid & 127, tq = c.tid >> 7, ch = half * 512 + 4 * cg4; const bool smp = chunk >= 256; const int n = smp ? 0 : (chunk & 127);
    f32x4 cr = {0.f, 0.f, 0.f, 0.f};
    const f32x4* ag = (const f32x4*)((const float*)(kws() + WS_AGG) + ((size_t)(chunk - n) * 1024 + ch) * 2);
    int i = 0;
    for (; i + 8 <= n; i += 8) {
        f32x4 a[8][2];
#pragma unroll
        for (int j = 0; j < 8; ++j) { a[j][0] = ag[(size_t)(i + j) * 512]; a[j][1] = ag[(size_t)(i + j) * 512 + 1]; }
#pragma unroll
        for (int j = 0; j < 8; ++j) { cr[0] = a[j][0][0] * cr[0] + a[j][0][1]; cr[1] = a[j][0][2] * cr[1] + a[j][0][3]; cr[2] = a[j][1][0] * cr[2] + a[j][1][1]; cr[3] = a[j][1][2] * cr[3] + a[j][1][3]; }
    }
    for (; i < n; ++i) { const f32x4 a0 = ag[(size_t)i * 512], a1 = ag[(size_t)i * 512 + 1]; cr[0] = a0[0] * cr[0] + a0[1]; cr[1] = a0[2] * cr[1] + a0[3]; cr[2] = a1[0] * cr[2] + a1[1]; cr[3] = a1[2] * cr[3] + a1[3]; }
    const unsigned* hc = (const unsigned*)(kws() + WS_R1) + (size_t)(chunk * 64 + tq) * 1024 + ch;
    const bf16_t* zg = (const bf16_t*)(kws() + WS_Z) + (size_t)(chunk * 64 + tq) * ZLD + C_AG + ch;
    bf16_t* br = (bf16_t*)(kws() + WS_BR) + (size_t)(chunk * 64 + tq) * 3072 + ch;
    u32x4 hv[16]; u32x2 gv[16];
#pragma unroll
    for (int k = 0; k < 16; ++k) { hv[k] = *(const u32x4*)(hc + (size_t)(4 * k) * 1024); gv[k] = *(const u32x2*)(zg + (size_t)(4 * k) * ZLD); }
    f32x4 h = {0.f, 0.f, 0.f, 0.f};
#pragma unroll
    for (int k = 0; k < 16; ++k) {
        h[0] = bflo(hv[k].x) + bfhi(hv[k].x) * cr[0]; h[1] = bflo(hv[k].y) + bfhi(hv[k].y) * cr[1]; h[2] = bflo(hv[k].z) + bfhi(hv[k].z) * cr[2]; h[3] = bflo(hv[k].w) + bfhi(hv[k].w) * cr[3];
        u32x2 w; w.x = pk2(h[0] * gelu_tanh(bflo(gv[k].x)), h[1] * gelu_tanh(bfhi(gv[k].x))); w.y = pk2(h[2] * gelu_tanh(bflo(gv[k].y)), h[3] * gelu_tanh(bfhi(gv[k].y)));
        *(u32x2*)(br + (size_t)(4 * k) * 3072) = w;
    }
    if (tq == 3) {
        if (smp) *(f32x4*)(kout() + O_SLRU + ((size_t)l * 32 + (chunk - 256)) * 1024 + ch) = h;
        else if (n == 127) *(f32x4*)(kout() + O_PLRU + ((size_t)l * 2 + (chunk >> 7)) * 1024 + ch) = h;
    }
}

#define MFMA32(a, b, cc) __builtin_amdgcn_mfma_f32_32x32x16_bf16((a), (b), (cc), 0, 0, 0)
typedef short s16x4 __attribute__((ext_vector_type(4)));
template <int MODE, class Src>
DI void attn_item(LAS unsigned char* lds, const Src& src, const bf16_t* Qp  , bf16_t* Op  , int nband, int jj0, float sink_l2, const LAS float* tbl, int qbase, int tid) {
    constexpr int NT = MODE ? 4 : 1, NL = 2 * NT;
    const int lane = tid & 63, w = __builtin_amdgcn_readfirstlane(tid >> 6), r = lane & 31, h = lane >> 5;
    const int hl = MODE ? (w >> 1) : 0;
    const int lq = lane >> 4, chp = lane & 15;
#define ATT_ISSUE(jj_, isV_) do { _Pragma("unroll") for (int i_ = 0; i_ < NL; ++i_) { \
        const int t_ = MODE ? (w >> 1) : 0, rowb_ = MODE ? ((w & 1) * 32 + 4 * i_) : (8 * w + 4 * i_); \
        const int row_ = rowb_ + lq, ch_ = chp ^ ((lq << 2) | ((rowb_ >> 2) & 3)); \
        const bf16_t* base_; int st_; src.get((jj_), t_, (isV_), base_, st_); \
        __builtin_amdgcn_global_load_lds((const unsigned*)(base_ + (size_t)row_ * st_ + ch_ * 8), (LAS unsigned*)(lds + ((isV_) ? 65536 : 0) + t_ * 16384 + rowb_ * 256), 16, 0, 0); } } while (0)
    bf16x8 qf[8];
#pragma unroll
    for (int ks = 0; ks < 8; ++ks) qf[ks] = *(const bf16x8*)(Qp + (size_t)r * ZLD + ks * 16 + h * 8);
    f32x16 o[4];
#pragma unroll
    for (int db = 0; db < 4; ++db)
#pragma unroll
        for (int i = 0; i < 16; ++i) o[db][i] = 0.f;
    float mrun = MODE == 0 ? sink_l2 : -1e30f, lrun = MODE == 0 ? 1.f : 0.f;
    const float sc = 0.08838834764831845f * LOG2E;
    const LAS unsigned char* Kt = lds + hl * 16384 + 256 * r;
    const int kx = 16 * (h ^ (((r & 3) << 2) | ((r >> 2) & 3)));
    const int blk = (lane >> 4) & 1, q = (lane & 15) >> 2, p = lane & 3;
    const LAS unsigned char* Vt = lds + 65536 + hl * 16384 + 256 * (4 * h + q) + 8 * (p & 1);
    const int vlo = 2 * blk + (p >> 1);
    ATT_ISSUE(jj0, false); ATT_ISSUE(jj0, true);
    for (int jj = jj0; jj < nband; ++jj) {
        const bool last = (jj == nband - 1);
        if (MODE) asm volatile("s_waitcnt vmcnt(8)" ::: "memory"); else asm volatile("s_waitcnt vmcnt(2)" ::: "memory");
        __builtin_amdgcn_s_barrier(); asm volatile("" ::: "memory");
        f32x16 s[2];
#pragma unroll
        for (int kb = 0; kb < 2; ++kb) {
#pragma unroll
            for (int i = 0; i < 16; ++i) s[kb][i] = 0.f;
#pragma unroll
            for (int ks = 0; ks < 8; ++ks) { const bf16x8 kf = *(const LAS bf16x8*)(Kt + 8192 * kb + ((32 * ks) ^ kx)); s[kb] = MFMA32(kf, qf[ks], s[kb]); }
        }
        asm volatile("s_waitcnt lgkmcnt(0)" ::: "memory"); __builtin_amdgcn_s_barrier(); asm volatile("" ::: "memory");
        if (!last) ATT_ISSUE(jj + 1, false);
        const bool cb = MODE == 0 || jj <= 5; const float bc = (MODE == 1 && cb) ? tbl[256] : 0.f, esc = cb ? sc : 1.0f;
        if (!cb) {
#pragma unroll
            for (int kb = 0; kb < 2; ++kb) {
                const int dbase = qbase + r - kb * 32 - 4 * h + (8 - jj) * 64 + 128;
#pragma unroll
                for (int i = 0; i < 16; ++i) { int idx = dbase - ((i & 3) + 8 * (i >> 2)); idx = idx > 256 ? 256 : idx; idx = idx < 0 ? 0 : idx; s[kb][i] = s[kb][i] * sc + tbl[idx]; }
            }
        }
        float bm = fmaxf(s[0][0], s[1][0]);
#pragma unroll
        for (int i = 1; i < 16; ++i) bm = fmaxf(bm, fmaxf(s[0][i], s[1][i]));
        bm = bm * esc + bc;
        bm = fmaxf(bm, __shfl_xor(bm, 32));
        if (__builtin_amdgcn_ballot_w64(bm > mrun + 8.0f) != 0ull) {
            const float mnew = fmaxf(mrun, bm), alpha = __builtin_amdgcn_exp2f(mrun - mnew);
            lrun *= alpha; mrun = mnew;
#pragma unroll
            for (int db = 0; db < 4; ++db)
#pragma unroll
                for (int i = 0; i < 16; ++i) o[db][i] *= alpha;
        }
        float ps = 0.f; const float eoff = bc - mrun;
#pragma unroll
        for (int kb = 0; kb < 2; ++kb)
#pragma unroll
            for (int i = 0; i < 16; ++i) { s[kb][i] = __builtin_amdgcn_exp2f(__builtin_fmaf(s[kb][i], esc, eoff)); ps += s[kb][i]; }
        ps += __shfl_xor(ps, 32);
        lrun += ps;
        if (last) asm volatile("s_waitcnt vmcnt(0)" ::: "memory"); else { if (MODE) asm volatile("s_waitcnt vmcnt(8)" ::: "memory"); else asm volatile("s_waitcnt vmcnt(2)" ::: "memory"); }
        __builtin_amdgcn_s_barrier(); asm volatile("" ::: "memory");
#pragma unroll
        for (int kb = 0; kb < 2; ++kb)
#pragma unroll
            for (int st = 0; st < 2; ++st) {
                u32x4 pp; pp.x = pk2(s[kb][8 * st + 0], s[kb][8 * st + 1]); pp.y = pk2(s[kb][8 * st + 2], s[kb][8 * st + 3]); pp.z = pk2(s[kb][8 * st + 4], s[kb][8 * st + 5]); pp.w = pk2(s[kb][8 * st + 6], s[kb][8 * st + 7]);
                const bf16x8 pf = __builtin_bit_cast(bf16x8, pp);
#pragma unroll
                for (int db = 0; db < 4; ++db) {
                    s16x4 v2[2];
#pragma unroll
                    for (int t = 0; t < 2; ++t) {
                        const int f = (q << 2) | ((2 * t + h) & 3);
                        v2[t] = __builtin_amdgcn_ds_read_tr16_b64_v4i16((LAS s16x4*)(Vt + 256 * (32 * kb + 16 * st + 8 * t) + 16 * ((4 * db + vlo) ^ f)));
                    }
                    const bf16x8 vf = __builtin_shufflevector(v2[0], v2[1], 0, 1, 2, 3, 4, 5, 6, 7);
                    o[db] = MFMA32(vf, pf, o[db]);
                }
            }
        asm volatile("s_waitcnt lgkmcnt(0)" ::: "memory"); __builtin_amdgcn_s_barrier(); asm volatile("" ::: "memory");
        if (!last) ATT_ISSUE(jj + 1, true);
    }
#undef ATT_ISSUE
    const float inv = 1.0f / lrun;
#pragma unroll
    for (int db = 0; db < 4; ++db)
#pragma unroll
        for (int gp = 0; gp < 4; gp += 2) {
            u32x2 a, b;
            a.x = pk2(o[db][4 * gp] * inv, o[db][4 * gp + 1] * inv); a.y = pk2(o[db][4 * gp + 2] * inv, o[db][4 * gp + 3] * inv);
            b.x = pk2(o[db][4 * gp + 4] * inv, o[db][4 * gp + 5] * inv); b.y = pk2(o[db][4 * gp + 6] * inv, o[db][4 * gp + 7] * inv);
            const auto r0 = __builtin_amdgcn_permlane32_swap(a.x, b.x, false, false); const auto r1 = __builtin_amdgcn_permlane32_swap(a.y, b.y, false, false);
            u32x4 w; w.x = r0[0]; w.y = r1[0]; w.z = r0[1]; w.w = r1[1];
            *(u32x4*)(Op + (size_t)r * 3072 + db * 32 + 8 * gp + 8 * h) = w;
        }
}
DI void attn_quad(LAS unsigned char* lds, const bf16_t* Z, bf16_t* BR, int c0  , int head, const LAS float* tbl, int tid) {
    const int lane = tid & 63, w = __builtin_amdgcn_readfirstlane(tid >> 6), r = lane & 31, h = lane >> 5;
    const int qc = w >> 1, qh = w & 1;
    const int lq = lane >> 4, chp = lane & 15;
    const int n0 = c0 & 127, j0 = n0 < 8 ? 8 - n0 : 0;
    const bf16_t* Qp = Z + (size_t)((c0 + qc) * 64 + qh * 32) * ZLD + C_QC + head * 128;
    bf16_t* Op = BR + (size_t)((c0 + qc) * 64 + qh * 32) * 3072 + 2048 + head * 128;
#define AQ_ISSUE(j_) do { const bf16_t* kb_ = Z + (size_t)(c0 - 8 + (j_)) * 64 * ZLD + C_KC + head * 128; LAS unsigned char* st_ = lds + ((j_) & 3) * 32768; \
        _Pragma("unroll") for (int i_ = 0; i_ < 2; ++i_) { const int rowb_ = 8 * w + 4 * i_, row_ = rowb_ + lq, ch_ = chp ^ ((lq << 2) | ((rowb_ >> 2) & 3)); \
            __builtin_amdgcn_global_load_lds((const unsigned*)(kb_ + (size_t)row_ * ZLD + ch_ * 8), (LAS unsigned*)(st_ + rowb_ * 256), 16, 0, 0); \
            __builtin_amdgcn_global_load_lds((const unsigned*)(kb_ + (C_VC - C_KC) + (size_t)row_ * ZLD + ch_ * 8), (LAS unsigned*)(st_ + 16384 + rowb_ * 256), 16, 0, 0); } } while (0)
    bf16x8 qf[8];
#pragma unroll
    for (int ks = 0; ks < 8; ++ks) qf[ks] = *(const bf16x8*)(Qp + (size_t)r * ZLD + ks * 16 + h * 8);
    f32x16 o[4];
#pragma unroll
    for (int db = 0; db < 4; ++db)
#pragma unroll
        for (int i = 0; i < 16; ++i) o[db][i] = 0.f;
    float mrun = -1e30f, lrun = 0.f;
    const float sc = 0.08838834764831845f * LOG2E;
    const int kx = 16 * (h ^ (((r & 3) << 2) | ((r >> 2) & 3)));
    const int blk = (lane >> 4) & 1, q = (lane & 15) >> 2, p = lane & 3;
    const int vlo = 2 * blk + (p >> 1);
    const int qbase = qh * 32;
    AQ_ISSUE(j0); if (j0 + 1 < 12) AQ_ISSUE(j0 + 1); if (j0 + 2 < 12) AQ_ISSUE(j0 + 2);
    for (int j = j0; j < 12; ++j) {
        if (j + 2 < 12) asm volatile("s_waitcnt vmcnt(8)" ::: "memory"); else if (j + 1 < 12) asm volatile("s_waitcnt vmcnt(4)" ::: "memory"); else asm volatile("s_waitcnt vmcnt(0)" ::: "memory");
        asm volatile("s_waitcnt lgkmcnt(0)" ::: "memory"); __builtin_amdgcn_s_barrier(); asm volatile("" ::: "memory");
        if (j + 3 < 12) AQ_ISSUE(j + 3);
        const int jj = j - qc;
        if (jj < 0 || jj > 8) continue;
        const LAS unsigned char* Kt = lds + (j & 3) * 32768 + 256 * r;
        const LAS unsigned char* Vt = lds + (j & 3) * 32768 + 16384 + 256 * (4 * h + q) + 8 * (p & 1);
        f32x16 s[2];
#pragma unroll
        for (int kb = 0; kb < 2; ++kb) {
#pragma unroll
            for (int i = 0; i < 16; ++i) s[kb][i] = 0.f;
#pragma unroll
            for (int ks = 0; ks < 8; ++ks) { const bf16x8 kf = *(const LAS bf16x8*)(Kt + 8192 * kb + ((32 * ks) ^ kx)); s[kb] = MFMA32(kf, qf[ks], s[kb]); }
        }
        const bool cb = jj <= 5; const float bc = cb ? tbl[256] : 0.f, esc = cb ? sc : 1.0f;
        if (!cb) {
#pragma unroll
            for (int kb = 0; kb < 2; ++kb) {
                const int dbase = qbase + r - kb * 32 - 4 * h + (8 - jj) * 64 + 128;
#pragma unroll
                for (int i = 0; i < 16; ++i) { int idx = dbase - ((i & 3) + 8 * (i >> 2)); idx = idx > 256 ? 256 : idx; idx = idx < 0 ? 0 : idx; s[kb][i] = s[kb][i] * sc + tbl[idx]; }
            }
        }
        float bm = fmaxf(s[0][0], s[1][0]);
#pragma unroll
        for (int i = 1; i < 16; ++i) bm = fmaxf(bm, fmaxf(s[0][i], s[1][i]));
        bm = bm * esc + bc;
        bm = fmaxf(bm, __shfl_xor(bm, 32));
        if (__builtin_amdgcn_ballot_w64(bm > mrun + 8.0f) != 0ull) {
            const float mnew = fmaxf(mrun, bm), alpha = __builtin_amdgcn_exp2f(mrun - mnew);
            lrun *= alpha; mrun = mnew;
#pragma unroll
            for (int db = 0; db < 4; ++db)
#pragma unroll
                for (int i = 0; i < 16; ++i) o[db][i] *= alpha;
        }
        float ps = 0.f; const float eoff = bc - mrun;
#pragma unroll
        for (int kb = 0; kb < 2; ++kb)
#pragma unroll
            for (int i = 0; i < 16; ++i) { s[kb][i] = __builtin_amdgcn_exp2f(__builtin_fmaf(s[kb][i], esc, eoff)); ps += s[kb][i]; }
        ps += __shfl_xor(ps, 32);
        lrun += ps;
#pragma unroll
        for (int kb = 0; kb < 2; ++kb)
#pragma unroll
            for (int st = 0; st < 2; ++st) {
                u32x4 pp; pp.x = pk2(s[kb][8 * st + 0], s[kb][8 * st + 1]); pp.y = pk2(s[kb][8 * st + 2], s[kb][8 * st + 3]); pp.z = pk2(s[kb][8 * st + 4], s[kb][8 * st + 5]); pp.w = pk2(s[kb][8 * st + 6], s[kb][8 * st + 7]);
                const bf16x8 pf = __builtin_bit_cast(bf16x8, pp);
#pragma unroll
                for (int db = 0; db < 4; ++db) {
                    s16x4 v2[2];
#pragma unroll
                    for (int t = 0; t < 2; ++t) {
                        const int f = (q << 2) | ((2 * t + h) & 3);
                        v2[t] = __builtin_amdgcn_ds_read_tr16_b64_v4i16((LAS s16x4*)(Vt + 256 * (32 * kb + 16 * st + 8 * t) + 16 * ((4 * db + vlo) ^ f)));
                    }
                    const bf16x8 vf = __builtin_shufflevector(v2[0], v2[1], 0, 1, 2, 3, 4, 5, 6, 7);
                    o[db] = MFMA32(vf, pf, o[db]);
                }
            }
    }
#undef AQ_ISSUE
    asm volatile("s_waitcnt lgkmcnt(0)" ::: "memory"); __builtin_amdgcn_s_barrier(); asm volatile("" ::: "memory");
    const float inv = 1.0f / lrun;
#pragma unroll
    for (int db = 0; db < 4; ++db)
#pragma unroll
        for (int gp = 0; gp < 4; gp += 2) {
            u32x2 a, b;
            a.x = pk2(o[db][4 * gp] * inv, o[db][4 * gp + 1] * inv); a.y = pk2(o[db][4 * gp + 2] * inv, o[db][4 * gp + 3] * inv);
            b.x = pk2(o[db][4 * gp + 4] * inv, o[db][4 * gp + 5] * inv); b.y = pk2(o[db][4 * gp + 6] * inv, o[db][4 * gp + 7] * inv);
            const auto r0 = __builtin_amdgcn_permlane32_swap(a.x, b.x, false, false); const auto r1 = __builtin_amdgcn_permlane32_swap(a.y, b.y, false, false);
            u32x4 w; w.x = r0[0]; w.y = r1[0]; w.z = r0[1]; w.w = r1[1];
            *(u32x4*)(Op + (size_t)r * 3072 + db * 32 + 8 * gp + 8 * h) = w;
        }
}
struct SrcSwa {
    const bf16_t* Z; const bf16_t* KcB; const bf16_t* VcB; int chunk, kv;
    DI void get(int jj, int t, bool isV, const bf16_t*& base, int& st) const {
        if (chunk < 256) { const int cc = chunk - 2 + jj; base = Z + (size_t)cc * 64 * ZLD + (isV ? C_VB : C_KB) + kv * 128; st = ZLD; return; }
        const int bs = chunk - 256;
        if (jj < 2) { base = (isV ? VcB : KcB) + (size_t)(bs * 128 + jj * 64) * 256 + kv * 128; st = 256; return; }
        base = Z + (size_t)chunk * 64 * ZLD + (isV ? C_VB : C_KB) + kv * 128; st = ZLD;
    }
};
struct SrcCb {
    const bf16_t* Z; const bf16_t* KcC; const bf16_t* VcC; int chunk, head0;
    DI void get(int jj, int t, bool isV, const bf16_t*& base, int& st) const {
        const int head = head0 + t;
        if (chunk < 256) { const int cc = chunk - 8 + jj; base = Z + (size_t)cc * 64 * ZLD + (isV ? C_VC : C_KC) + head * 128; st = ZLD; return; }
        const int bs = chunk - 256;
        if (jj < 8) { base = (isV ? VcC : KcC) + (size_t)(bs * 512 + jj * 64) * 1024 + head * 128; st = 1024; return; }
        base = Z + (size_t)chunk * 64 * ZLD + (isV ? C_VC : C_KC) + head * 128; st = ZLD;
    }
};

DI void copy_state(const Ctx& c, float* dst, int nb, int rows, int width, int row0, int bstride, int col) {
    const bf16_t* Z = (const bf16_t*)(kws() + WS_Z);
    const int w8 = width >> 3; const size_t total = (size_t)nb * rows * w8;
    for (size_t i = (size_t)c.bid * NTHR + c.tid; i < total; i += (size_t)c.G * NTHR) {
        const int e = (int)(i % w8); const size_t rt = i / w8; const int t = (int)(rt % rows), b = (int)(rt / rows);
        const u32x4 v = *(const u32x4*)(Z + (size_t)(row0 + b * bstride + t) * ZLD + col + 8 * e);
        f32x4* d = (f32x4*)(dst + ((size_t)(b * rows + t) * width + 8 * e));
        d[0] = (f32x4){bflo(v.x), bfhi(v.x), bflo(v.y), bfhi(v.y)}; d[1] = (f32x4){bflo(v.z), bfhi(v.z), bflo(v.w), bfhi(v.w)};
    }
}

DI void inproj_tail_combine(const Ctx& c) {
    const float* part = (const float*)(kws() + WS_PART); const float* rs = (const float*)(kws() + WS_RS); bf16_t* Z = (bf16_t*)(kws() + WS_Z);
    for (int i = c.bid * NTHR + c.tid; i < 16 * 8192; i += c.G * NTHR) {
        const int tile = i >> 13, e = i & 8191, r = e >> 5, c8 = (e & 31) * 8, row = 71 * 256 + r;
        const float* p = part + ((size_t)tile * 256 + r) * 256 + c8;
        f32x4 v0 = *(const f32x4*)p, v1 = *(const f32x4*)(p + 4);
#pragma unroll
        for (int ks = 1; ks < 8; ++ks) { v0 += *(const f32x4*)(p + (size_t)ks * 16 * 65536); v1 += *(const f32x4*)(p + (size_t)ks * 16 * 65536 + 4); }
        const float sc = rs[row];
#pragma unroll
        for (int j = 0; j < 4; ++j) { v0[j] = __builtin_amdgcn_rcpf(1.0f + __expf(-v0[j] * sc)); v1[j] = __builtin_amdgcn_rcpf(1.0f + __expf(-v1[j] * sc)); }
        const int fo = ((((((r >> 6) & 1) * 4 + ((c8 >> 5) & 3)) * 2 + (r >> 7)) * 4 + ((r >> 4) & 3)) * 64 + ((c8 >> 3) & 3) * 16 + (r & 15)) * 16 + (c8 >> 7) * 8;
        *(u32x2*)((unsigned char*)(kws() + WS_GATE) + ((size_t)71 * 24 + tile) * 65536 + fo) = pg8::packq8(v0, v1);
    }
}
DI void phase_postD(const Ctx& c) {
    const float* part = (const float*)(kws() + WS_PART); bf16_t* act = (bf16_t*)(kws() + WS_ACT2) + (size_t)MP * DM;
    const size_t total = (size_t)MS * DM / 8;
    for (size_t i = (size_t)c.bid * NTHR + c.tid; i < total; i += (size_t)c.G * NTHR) {
        const f32x4* p = (const f32x4*)part + 2 * i; const size_t st = (size_t)MS * DM / 4;
        const f32x4 v0 = p[0] + p[st] + p[2 * st], v1 = p[1] + p[st + 1] + p[2 * st + 1];
        ((u32x4*)act)[i] = pg8::pack8(v0, v1);
    }
}
DI void phase_postRes(const Ctx& c, const float* xinS  ) {
    const int gw = c.bid * NWAVES + c.wave, NGW = c.G * NWAVES;
    bf16_t* act = (bf16_t*)(kws() + WS_ACT); float* rs = (float*)(kws() + WS_RS); const float* part = (const float*)(kws() + WS_PART);
    for (int row = MP + gw; row < M; row += NGW) {
        const f32x4* pr = (const f32x4*)(part + (size_t)(row - MP) * DM) + c.lane; const size_t st = (size_t)MS * DM / 4;
        u32x2* ao = (u32x2*)(act + (size_t)row * DM) + c.lane;
        float s = 0.f;
#pragma unroll
        for (int j = 0; j < 8; ++j) {
            f32x4 xi;
            if (xinS) xi = ((const f32x4*)(xinS + (size_t)(row - MP) * DM) + c.lane)[64 * j];
            else { const u32x2 w = ao[64 * j]; xi = (f32x4){bflo(w.x), bfhi(w.x), bflo(w.y), bfhi(w.y)}; }
            const f32x4 v = xi + ((pr[64 * j] + pr[st + 64 * j]) + (pr[2 * st + 64 * j] + pr[3 * st + 64 * j]));
            u32x2 w; w.x = pk2(v[0], v[1]); w.y = pk2(v[2], v[3]); ao[64 * j] = w;
            s += (v[0] * v[0] + v[1] * v[1]) + (v[2] * v[2] + v[3] * v[3]);
        }
        s = wave_sum(s);
        if (c.lane == 0) rs[row] = 1.0f / sqrtf(s * (1.0f / DM) + EPS);
    }
    const float* ssq = (const float*)(kws() + WS_SSQ);
    for (int row = c.bid * NTHR + c.tid; row < MP; row += c.G * NTHR) {
        const f32x4* q = (const f32x4*)(ssq + (size_t)row * 32); float s = 0.f;
#pragma unroll
        for (int j = 0; j < 8; ++j) { const f32x4 v = q[j]; s += (v[0] + v[1]) + (v[2] + v[3]); }
        rs[row] = 1.0f / sqrtf(s * (1.0f / DM) + EPS);
    }
}

DI void phase_postRes_final(const Ctx& c) {
    const int gw = c.bid * NWAVES + c.wave, NGW = c.G * NWAVES;
    const bf16_t* act = (const bf16_t*)(kws() + WS_ACT); const float* part = (const float*)(kws() + WS_PART); const float* ssq = (const float*)(kws() + WS_SSQ);
    const f32x4* gp = (const f32x4*)kin<24>() + c.lane;
    f32x4 gv[8];
#pragma unroll
    for (int j = 0; j < 8; ++j) gv[j] = gp[64 * j];
    for (int row = MP + gw; row < M; row += NGW) {
        const f32x4* pr = (const f32x4*)(part + (size_t)(row - MP) * DM) + c.lane; const size_t st = (size_t)MS * DM / 4;
        const u32x2* ai = (const u32x2*)(act + (size_t)row * DM) + c.lane; f32x4* yr = (f32x4*)(kout() + (size_t)row * DM) + c.lane;
        f32x4 v[8]; float s = 0.f;
#pragma unroll
        for (int j = 0; j < 8; ++j) { const u32x2 w = ai[64 * j]; const f32x4 xi = {bflo(w.x), bfhi(w.x), bflo(w.y), bfhi(w.y)};
            v[j] = xi + ((pr[64 * j] + pr[st + 64 * j]) + (pr[2 * st + 64 * j] + pr[3 * st + 64 * j])); s += (v[j][0] * v[j][0] + v[j][1] * v[j][1]) + (v[j][2] * v[j][2] + v[j][3] * v[j][3]); }
        s = wave_sum(s); const float r = 1.0f / sqrtf(s * (1.0f / DM) + EPS);
#pragma unroll
        for (int j = 0; j < 8; ++j) yr[64 * j] = v[j] * r * gv[j];
    }
    for (int row = gw; row < MP; row += NGW) {
        float s = c.lane < 32 ? ssq[(size_t)row * 32 + c.lane] : 0.f; s = wave_sum(s); const float r = 1.0f / sqrtf(s * (1.0f / DM) + EPS);
        const u32x2* xr = (const u32x2*)(act + (size_t)row * DM) + c.lane; f32x4* yr = (f32x4*)(kout() + (size_t)row * DM) + c.lane;
#pragma unroll
        for (int j = 0; j < 8; ++j) { const u32x2 w = xr[64 * j]; yr[64 * j] = (f32x4){bflo(w.x), bfhi(w.x), bflo(w.y), bfhi(w.y)} * r * gv[j]; }
    }
}

struct Args { const float* in[25]; float* out; unsigned char* ws; int ph_lo, ph_hi; };
constexpr int PH_PER_LAYER = 11, PH_FINAL = 1 + DEPTH * PH_PER_LAYER, PH_COUNT = PH_FINAL + 1;

__global__ void __launch_bounds__(NTHR, 2) fwd_kernel(Args args) {
    extern __shared__ __attribute__((aligned(16))) unsigned char lds_raw[];
    LAS unsigned char* const lds = (LAS unsigned char*)lds_raw;
    volatile LAS unsigned* misc = (volatile LAS unsigned*)(lds + LDS_MISC);
    if (threadIdx.x < 4) misc[threadIdx.x] = 0u;
    __syncthreads();
    const int lo = args.ph_lo, hi = args.ph_hi;
    XcdBarrier bar; bar.bar = (unsigned*)(kws() + WS_BAR); bar.x = 0; bar.st = misc;
    if (hi - lo > 1) bar = xcd_barrier_post((unsigned*)(kws() + WS_BAR), misc);
#define IN(k) (lo <= (k) && (k) < hi)
#define SEAM(k) do { if ((k) + 1 < hi) { bar.bar = (unsigned*)(kws() + WS_BAR); xcd_barrier(bar); } } while (0)
#define WSP(T, off) ((T*)(kws() + (off)))
#ifndef PHMASK
#define PHMASK 0xFFFF
#endif
#define PHON(j) ((PHMASK >> (j)) & 1)
#ifndef PROBE_MASK
#define PROBE_MASK 0
#endif
#define REP(j) for (int rep_ = 0; rep_ < 1 + ((PROBE_MASK >> (j)) & 1); ++rep_)
    if (PHON(14) && IN(0)) { REP(14) { const Ctx c = make_ctx(lds); phase_prologue(c); phase_norm(c, kin<0>(), kin<1>() - (size_t)MP * DM); } SEAM(0); }

    for (int l = 0; l < DEPTH; ++l) {
        const int pb = 1 + l * PH_PER_LAYER;
        if (PHON(1) && IN(pb + 1)) {
            pg8::InprojOrder S{{WSP(bf16_t, WS_ACT), WSP(bf16_t, WS_W) + (size_t)l * WL_SIZE + WL_IN, DM, DM}, (int)gridDim.x, (int)blockIdx.x};
            pg8::EpiInproj E{WSP(bf16_t, WS_Z), WSP(float, WS_RS), WSP(float, WS_PART), WSP(unsigned char, WS_GATE)};
            REP(1) pg8::gemm_phase(lds, S, E);
            {
                const Ctx c = make_ctx(lds); const int extra = (3584 + 128) % c.G;
                if (extra == 0 || c.bid >= extra) phase_cacheconv(c, l, extra == 0 ? c.bid : c.bid - extra, extra == 0 ? c.G : c.G - extra);
            }
            SEAM(pb + 1);
        }
        if (PHON(2) && IN(pb + 2)) {
            const Ctx c = make_ctx(lds);
            inproj_tail_combine(c);
            REP(12) lru_local_phase(c, l);
            REP(13) for (int u = c.bid; u < (c.G >= 128 ? 512 : NCHUNK * 2); u += c.G) {
                const int chunk = u >> 1, kv = u & 1, head = kv * 4 + (c.wave >> 1), qh = c.wave & 1;
                const bf16_t* Z = WSP(bf16_t, WS_Z);
                SrcSwa src{Z, WSP(bf16_t, WS_KCB), WSP(bf16_t, WS_VTCB), chunk, kv};
                const int n = chunk & 127, jj0 = (chunk < 256 && n < 2) ? 2 - n : 0;
                attn_item<0>(c.lds, src, Z + (size_t)(chunk * 64 + qh * 32) * ZLD + C_QB + head * 128, WSP(bf16_t, WS_BR) + (size_t)(chunk * 64 + qh * 32) * 3072 + 1024 + head * 128, 3, jj0,
                             kin<17>()[l * 8 + head] * LOG2E, nullptr, 0, c.tid);
            }
            SEAM(pb + 2);
        }
        if (PHON(3) && IN(pb + 3)) {
            const Ctx c = make_ctx(lds);
            LAS float* tbl = (LAS float*)(c.lds + LDS_TBL);
            for (int i = c.tid; i < 8 * 257; i += NTHR) { const int hh = i / 257, e = i - hh * 257; tbl[hh * 260 + e] = kin<18>()[(size_t)l * 8 * 257 + i] * LOG2E; }
            __syncthreads();
            REP(3) {
            {
                const bf16_t* Z = WSP(bf16_t, WS_Z);
                for (int u = c.bid; u < 512; u += c.G) {
                    const int x = u & 7, k = u >> 3;
                    attn_quad(c.lds, Z, WSP(bf16_t, WS_BR), 4 * k, x, tbl + x * 260, c.tid);
                }
            }
            {
                const int nsmp = c.G >= 128 ? 64 : 0;
                if (c.bid < nsmp || nsmp == 0) {
                    for (int u = c.bid; u < 64; u += (nsmp ? nsmp : c.G)) {
                        const int hg = u & 1, chunk = 256 + (u >> 1), head = hg * 4 + (c.wave >> 1), qh = c.wave & 1;
                        const bf16_t* Z = WSP(bf16_t, WS_Z);
                        SrcCb src{Z, WSP(bf16_t, WS_KCC), WSP(bf16_t, WS_VTCC), chunk, hg * 4};
                        attn_item<1>(c.lds, src, Z + (size_t)(chunk * 64 + qh * 32) * ZLD + C_QC + head * 128, WSP(bf16_t, WS_BR) + (size_t)(chunk * 64 + qh * 32) * 3072 + 2048 + head * 128, 9, 0,
                                     0.f, tbl + head * 260, qh * 32, c.tid);
                    }
                    if (nsmp) {
                        const int u = 512 + c.bid, chunk = u >> 1, kv = u & 1, head = kv * 4 + (c.wave >> 1), qh = c.wave & 1;
                        const bf16_t* Z = WSP(bf16_t, WS_Z);
                        SrcSwa src{Z, WSP(bf16_t, WS_KCB), WSP(bf16_t, WS_VTCB), chunk, kv};
                        attn_item<0>(c.lds, src, Z + (size_t)(chunk * 64 + qh * 32) * ZLD + C_QB + head * 128, WSP(bf16_t, WS_BR) + (size_t)(chunk * 64 + qh * 32) * 3072 + 1024 + head * 128, 3, 0,
                                     kin<17>()[l * 8 + head] * LOG2E, nullptr, 0, c.tid);
                    }
                }
                if (c.bid >= nsmp) for (int u = c.bid - nsmp; u < NCHUNK * 2; u += c.G - nsmp) lru_fix_unit(c, l, u >> 1, u & 1);
            }
            copy_state(c, kout() + O_PCONV + (size_t)l * 2 * 3 * 1024, 2, 3, 1024, 8189, 8192, C_AX);
            copy_state(c, kout() + O_SCONV + (size_t)l * 32 * 3 * 1024, 32, 3, 1024, MP + 61, 64, C_AX);
            copy_state(c, kout() + O_PSWAK + (size_t)l * 2 * 128 * 256, 2, 128, 256, 8192 - 128, 8192, C_KB);
            copy_state(c, kout() + O_PSWAV + (size_t)l * 2 * 128 * 256, 2, 128, 256, 8192 - 128, 8192, C_VB);
            copy_state(c, kout() + O_PCBK + (size_t)l * 2 * 512 * 1024, 2, 512, 1024, 8192 - 512, 8192, C_KC);
            copy_state(c, kout() + O_PCBV + (size_t)l * 2 * 512 * 1024, 2, 512, 1024, 8192 - 512, 8192, C_VC);
            copy_state(c, kout() + O_SSWAK + (size_t)l * 32 * 64 * 256, 32, 64, 256, MP, 64, C_KB);
            copy_state(c, kout() + O_SSWAV + (size_t)l * 32 * 64 * 256, 32, 64, 256, MP, 64, C_VB);
            copy_state(c, kout() + O_SCBK + (size_t)l * 32 * 64 * 1024, 32, 64, 1024, MP, 64, C_KC);
            copy_state(c, kout() + O_SCBV + (size_t)l * 32 * 64 * 1024, 32, 64, 1024, MP, 64, C_VC);
            }
            SEAM(pb + 3);
        }
        if (PHON(4) && IN(pb + 4)) {
            pg8::SplitOrder S{{WSP(bf16_t, WS_BR), WSP(bf16_t, WS_W) + (size_t)l * WL_SIZE + WL_BR, 3 * BW, 3 * BW}, (int)gridDim.x, (int)blockIdx.x, 3 * BW / 64, 3, BW / 64};
            pg8::EpiD E{WSP(unsigned char, WS_GATE), WSP(bf16_t, WS_ACT2), WSP(float, WS_PART)};
            pg8::gemm_phase(lds, S, E);
            SEAM(pb + 4);
        }
        if (PHON(5) && IN(pb + 5)) { const Ctx c = make_ctx(lds); phase_postD(c); SEAM(pb + 5); }
        if (PHON(6) && IN(pb + 6)) {
            pg8::SplitOrder S{{WSP(bf16_t, WS_ACT2), WSP(bf16_t, WS_W) + (size_t)l * WL_SIZE + WL_OUT, DM, DM}, (int)gridDim.x, (int)blockIdx.x, DM / 64, 4, DM / 256};
            if (l == 0) { pg8::EpiRes<true> E{kin<0>(), WSP(bf16_t, WS_ACT), WSP(float, WS_SSQ), WSP(float, WS_PART)}; pg8::gemm_phase(lds, S, E); }
            else { pg8::EpiRes<false> E{nullptr, WSP(bf16_t, WS_ACT), WSP(float, WS_SSQ), WSP(float, WS_PART)}; pg8::gemm_phase(lds, S, E); }
            SEAM(pb + 6);
        }
        if (PHON(7) && IN(pb + 7)) { const Ctx c = make_ctx(lds); phase_postRes(c, l == 0 ? kin<1>() : nullptr); SEAM(pb + 7); }
        if (PHON(8) && IN(pb + 8)) {
            pg8::FullOrder S{{WSP(bf16_t, WS_ACT), WSP(bf16_t, WS_W) + (size_t)l * WL_SIZE + WL_UP, DM, DM}, M / 256, DFF / 256, (int)gridDim.x, (int)blockIdx.x, DM / 64};
            pg8::EpiUp E{WSP(bf16_t, WS_Z)  , WSP(float, WS_RS)};
            REP(8) pg8::gemm_phase(lds, S, E);
            SEAM(pb + 8);
        }
        if (PHON(9) && IN(pb + 9)) {
            pg8::SplitOrder S{{WSP(bf16_t, WS_Z), WSP(bf16_t, WS_W) + (size_t)l * WL_SIZE + WL_DOWN, DFF, DFF}, (int)gridDim.x, (int)blockIdx.x, DFF / 64, 4, DFF / 256};
            pg8::EpiRes<false> E{nullptr, WSP(bf16_t, WS_ACT), WSP(float, WS_SSQ), WSP(float, WS_PART)};
            pg8::gemm_phase(lds, S, E);
            SEAM(pb + 9);
        }
        if (PHON(10) && IN(pb + 10)) { const Ctx c = make_ctx(lds); if (l == DEPTH - 1) phase_postRes_final(c); else { phase_postRes(c, nullptr); SEAM(pb + 10); } }
    }
#undef IN
#undef SEAM
}

#ifndef N_LAUNCH_MODE
#define N_LAUNCH_MODE 1
#endif
extern "C" void kernel_launch(void* const* d_in, const int* in_sizes, int n_in, void* d_out, int out_size, void* d_ws, size_t ws_size, hipStream_t stream) {
    static int grid = 0;
    if (grid == 0) {
        if (n_in != 25 || (size_t)out_size != O_END || ws_size < WS_END) { fprintf(stderr, "kernel_launch: unexpected sizes (n_in %d out %d ws %zu need %zu)\n", n_in, out_size, ws_size, (size_t)WS_END); grid = -1; return; }
        int dev = 0, cus = 0, per_cu = 0;
        if (hipGetDevice(&dev) != hipSuccess || hipDeviceGetAttribute(&cus, hipDeviceAttributeMultiprocessorCount, dev) != hipSuccess) { grid = -1; return; }
        if (hipFuncSetAttribute((const void*)fwd_kernel, hipFuncAttributeMaxDynamicSharedMemorySize, LDS_BYTES) != hipSuccess) { fprintf(stderr, "kernel_launch: hipFuncSetAttribute failed\n"); grid = -1; return; }
        if (hipOccupancyMaxActiveBlocksPerMultiprocessor(&per_cu, (const void*)fwd_kernel, NTHR, LDS_BYTES) != hipSuccess || per_cu < 1) { fprintf(stderr, "kernel_launch: occupancy query says %d\n", per_cu); (void)hipGetLastError(); grid = -1; return; }
        grid = cus;
    }
    if (grid < 0) return;
    (void)hipMemsetAsync((char*)d_ws + WS_BAR, 0, 16384, stream);
    Args a{};
    for (int i = 0; i < 25; ++i) a.in[i] = (const float*)d_in[i];
    a.out = (float*)d_out; a.ws = (unsigned char*)d_ws;
#if N_LAUNCH_MODE == 1
    a.ph_lo = 0; a.ph_hi = PH_COUNT;
    hipLaunchKernelGGL(fwd_kernel, dim3(grid), dim3(NTHR), LDS_BYTES, stream, a);
#else
    for (int p = 0; p < PH_COUNT; ++p) { a.ph_lo = p; a.ph_hi = p + 1; hipLaunchKernelGGL(fwd_kernel, dim3(grid), dim3(NTHR), LDS_BYTES, stream, a); }
#endif
}
```
